# Optimizing an MI355X kernel written in HIP

```python
import math
import jax, jax.numpy as jnp
from jax import lax
import numpy as np

D_MODEL = 2048
BATCH = 4
SEQ = 8192
DEPTH = 4

N_BRANCH = 4
BRANCH_WIDTH = 512
EPS = 1e-6
N_MOD = 6
DA_HEADS = 4
DA_QK_DIM = 64
DA_V_DIM = 128
Q_BLOCK = 128
N_BUCKETS = 32
MAX_DISTANCE = 128
ML_HEADS = 4
ML_DIM = 128
ML_CONV = 4
GLA_HEADS = 4
GLA_DK = 64
GLA_DV = 128
GLA_RANK = 16
GLA_TAU = 16.0
CHUNK = 64
S5_CH = 16
S5_GROUPS = BRANCH_WIDTH // S5_CH
S5_STATE = 64
FFN_HIDDEN = -(-(8 * D_MODEL) // (3 * 256)) * 256

DA_QK_W = DA_HEADS * 2 * DA_QK_DIM
DA_V_W = DA_HEADS * DA_V_DIM
ML_W = ML_HEADS * ML_DIM
GLA_K_W = GLA_HEADS * GLA_DK
GLA_V_W = GLA_HEADS * GLA_DV
IN_SPLITS = (DA_QK_W, DA_QK_W, DA_V_W,
             ML_W, ML_W, ML_W, ML_W, ML_HEADS, ML_HEADS,
             GLA_K_W, GLA_K_W, GLA_V_W, GLA_V_W, GLA_RANK,
             BRANCH_WIDTH)
IN_WIDTH = sum(IN_SPLITS)

kernel_name = 'hybrid_gated_parallel_mixer_trunk'


def _rms(x, gain=None):
    xf = x.astype(jnp.float32)
    y = xf * lax.rsqrt(jnp.mean(xf * xf, axis=-1, keepdims=True) + EPS)
    if gain is not None:
        y = y * gain.astype(jnp.float32)
    return y.astype(x.dtype)


def _t5_bucket(rel):
    n = jnp.maximum(-rel, 0)
    exact = N_BUCKETS // 2
    nf = jnp.maximum(n, 1).astype(jnp.float32)
    large = exact + (jnp.log(nf / exact) / math.log(MAX_DISTANCE / exact)
                     * (N_BUCKETS - exact)).astype(jnp.int32)
    return jnp.where(n < exact, n, jnp.minimum(large, N_BUCKETS - 1))


def _causal_conv(x, w):
    k, s = w.shape[0], x.shape[1]
    xp = jnp.pad(x, ((0, 0), (k - 1, 0), (0, 0)))
    y = xp[:, 0:s] * w[0]
    for j in range(1, k):
        y = y + xp[:, j:j + s] * w[j]
    return y


def _to_chunks(t, nc):
    t = t.reshape((t.shape[0], nc, CHUNK) + t.shape[2:])
    return jnp.moveaxis(jnp.swapaxes(t, 2, 3), 1, 0)


def _from_chunks(t):
    t = jnp.swapaxes(jnp.moveaxis(t, 0, 1), 2, 3)
    return t.reshape((t.shape[0], t.shape[1] * t.shape[2], -1))


def _diff_attention(q, k, v, lam, lam_init, rel_bias):
    B, S = q.shape[:2]
    q = q.reshape(B, S, DA_HEADS, 2, DA_QK_DIM).transpose(3, 0, 2, 1, 4)
    k = k.reshape(B, S, DA_HEADS, 2, DA_QK_DIM).transpose(3, 0, 2, 1, 4)
    v = v.reshape(B, S, DA_HEADS, DA_V_DIM).transpose(0, 2, 1, 3)
    kpos = jnp.arange(S)
    scale = DA_QK_DIM ** -0.5

    def block(i):
        start = i * Q_BLOCK
        qb = lax.dynamic_slice_in_dim(q, start, Q_BLOCK, axis=3)
        rel = kpos[None, :] - (start + jnp.arange(Q_BLOCK))[:, None]
        bias = jnp.transpose(rel_bias[_t5_bucket(rel)], (2, 0, 1))
        logits = jnp.einsum('mbhqd,mbhkd->mbhqk', qb, k) * scale + bias
        logits = jnp.where(rel <= 0, logits, -jnp.inf)
        p = jax.nn.softmax(logits, axis=-1)
        return jnp.einsum('bhqk,bhkd->bhqd', p[0] - lam * p[1], v)

    o = lax.map(block, jnp.arange(S // Q_BLOCK))
    o = o.transpose(1, 0, 3, 2, 4).reshape(B, S, DA_HEADS, DA_V_DIM)
    return (_rms(o) * (1.0 - lam_init)).reshape(B, S, DA_V_W)


def _mlstm(q, k, v, ig, lf):
    B, S = q.shape[:2]
    nc = S // CHUNK
    causal = jnp.tril(jnp.ones((CHUNK, CHUNK), bool))

    def step(carry, xs):
        C, n, m = carry
        qc, kc, vc, ic, lfc = xs
        b = jnp.cumsum(lfc, axis=-1)
        Dm = jnp.where(causal, b[..., :, None] - b[..., None, :] + ic[..., None, :], -jnp.inf)
        inter = b + m[..., None]
        m_t = jnp.maximum(inter, jnp.max(Dm, axis=-1))
        s = jnp.einsum('bhtd,bhjd->bhtj', qc, kc) * jnp.exp(Dm - m_t[..., None])
        a = jnp.exp(inter - m_t)
        num = a[..., None] * jnp.einsum('bhtd,bhde->bhte', qc, C) + jnp.einsum('bhtj,bhje->bhte', s, vc)
        den = a * jnp.einsum('bhtd,bhd->bht', qc, n) + jnp.sum(s, axis=-1)
        h = num / jnp.maximum(jnp.abs(den), jnp.exp(-m_t))[..., None]
        m_new = m_t[..., -1]
        a_state = jnp.exp(b[..., -1] + m - m_new)
        wj = jnp.exp(b[..., -1:] - b + ic - m_new[..., None])
        C = a_state[..., None, None] * C + jnp.einsum('bhj,bhjd,bhje->bhde', wj, kc, vc)
        n = a_state[..., None] * n + jnp.einsum('bhj,bhjd->bhd', wj, kc)
        return (C, n, m_new), h

    init = (jnp.zeros((B, ML_HEADS, ML_DIM, ML_DIM), jnp.float32),
            jnp.zeros((B, ML_HEADS, ML_DIM), jnp.float32),
            jnp.zeros((B, ML_HEADS), jnp.float32))
    xs = (_to_chunks(q, nc), _to_chunks(k, nc), _to_chunks(v, nc), _to_chunks(ig, nc), _to_chunks(lf, nc))
    _, h = lax.scan(step, init, xs)
    return _from_chunks(h)


def _gla(q, k, v, la):
    B, S = q.shape[:2]
    nc = S // CHUNK
    causal = jnp.tril(jnp.ones((CHUNK, CHUNK), bool))[:, :, None]

    def step(St, xs):
        qc, kc, vc, lac = xs
        bc = jnp.cumsum(lac, axis=2)
        inter = jnp.einsum('bhtd,bhde->bhte', qc * jnp.exp(bc), St)
        decay = jnp.exp(jnp.where(causal, bc[:, :, :, None, :] - bc[:, :, None, :, :], -jnp.inf))
        att = jnp.einsum('bhtd,bhjd,bhtjd->bhtj', qc, kc, decay)
        o = inter + jnp.einsum('bhtj,bhje->bhte', att, vc)
        last = bc[:, :, -1:, :]
        St = jnp.exp(last[:, :, 0])[..., None] * St + jnp.einsum('bhjd,bhje->bhde', kc * jnp.exp(last - bc), vc)
        return St, o

    init = jnp.zeros((B, GLA_HEADS, GLA_DK, GLA_DV), jnp.float32)
    xs = (_to_chunks(q, nc), _to_chunks(k, nc), _to_chunks(v, nc), _to_chunks(la, nc))
    _, o = lax.scan(step, init, xs)
    return _from_chunks(o).reshape(B, S, GLA_HEADS, GLA_DV)


def _s5(u, a_re, a_im, log_dt, b_re, b_im, c_re, c_im, d_skip):
    f32 = jnp.float32
    a_re, a_im = a_re.astype(f32), a_im.astype(f32)
    dt = jnp.exp(log_dt.astype(f32))[:, None]
    mag = jnp.exp(dt * a_re)
    ab_re, ab_im = mag * jnp.cos(dt * a_im), mag * jnp.sin(dt * a_im)
    nr, ni = ab_re - 1.0, ab_im
    den = a_re * a_re + a_im * a_im
    f_re = (nr * a_re + ni * a_im) / den
    f_im = (ni * a_re - nr * a_im) / den
    b_re, b_im = b_re.astype(f32), b_im.astype(f32)
    bb_re = f_re[..., None] * b_re - f_im[..., None] * b_im
    bb_im = f_re[..., None] * b_im + f_im[..., None] * b_re
    c_re, c_im, d_skip = c_re.astype(f32), c_im.astype(f32), d_skip.astype(f32)

    def combine(e1, e2):
        a1r, a1i, b1r, b1i = e1
        a2r, a2i, b2r, b2i = e2
        return (a2r * a1r - a2i * a1i, a2r * a1i + a2i * a1r,
                a2r * b1r - a2i * b1i + b2r, a2r * b1i + a2i * b1r + b2i)

    def one_seq(us):
        bu_re = jnp.einsum('sgc,gpc->sgp', us, bb_re)
        bu_im = jnp.einsum('sgc,gpc->sgp', us, bb_im)
        ar = jnp.broadcast_to(ab_re, bu_re.shape)
        ai = jnp.broadcast_to(ab_im, bu_re.shape)
        _, _, xr, xi = lax.associative_scan(combine, (ar, ai, bu_re, bu_im), axis=0)
        return (jnp.einsum('sgp,gcp->sgc', xr, c_re) - jnp.einsum('sgp,gcp->sgc', xi, c_im)
                + d_skip * us)

    return lax.map(one_seq, u)


def setup_inputs(seed: int = 0) -> dict:
    key = jax.random.key(seed)
    ks = jax.random.split(key, 32)
    f32 = jnp.float32

    def nrm(k, shape, scale):
        return jax.random.normal(k, shape, f32) * scale

    L, D, W, G, P, C = DEPTH, D_MODEL, BRANCH_WIDTH, S5_GROUPS, S5_STATE, S5_CH
    return {
        'x': nrm(ks[0], (BATCH, SEQ, D), 1.0),
        'c': nrm(ks[1], (BATCH, D), 1.0),
        'ada_w': nrm(ks[2], (L, D, N_MOD * D), 0.5 * D ** -0.5),
        'ada_b': nrm(ks[3], (L, N_MOD * D), 0.01),
        'norm_g': 1.0 + nrm(ks[4], (L, 4, D), 0.01),
        'w_in': nrm(ks[5], (L, D, IN_WIDTH), D ** -0.5),
        'rel_bias': nrm(ks[6], (N_BUCKETS, DA_HEADS), 0.5),
        'diff_lambda': nrm(ks[7], (L, 4, DA_QK_DIM), 0.1),
        'ml_conv': nrm(ks[8], (L, ML_CONV, 2 * ML_W), ML_CONV ** -0.5),
        'ml_gate_b': jnp.stack([nrm(ks[9], (L, ML_HEADS), 0.1),
                                jnp.linspace(3.0, 6.0, ML_HEADS, dtype=f32)[None, :]
                                + nrm(ks[10], (L, ML_HEADS), 0.1)], axis=1),
        'gla_wa2': nrm(ks[11], (L, GLA_RANK, GLA_K_W), GLA_RANK ** -0.5),
        'gla_ba': nrm(ks[12], (L, GLA_K_W), 0.1),
        's5_a_re': -0.5 + nrm(ks[13], (L, G, P), 0.01),
        's5_a_im': math.pi * jnp.arange(P, dtype=f32) + nrm(ks[14], (L, G, P), 0.01),
        's5_log_dt': jax.random.uniform(ks[15], (L, G), f32, math.log(1e-3), math.log(1e-1)),
        's5_b_re': nrm(ks[16], (L, G, P, C), (2 * C) ** -0.5),
        's5_b_im': nrm(ks[17], (L, G, P, C), (2 * C) ** -0.5),
        's5_c_re': nrm(ks[18], (L, G, C, P), (2 * P) ** -0.5),
        's5_c_im': nrm(ks[19], (L, G, C, P), (2 * P) ** -0.5),
        's5_d': nrm(ks[20], (L, G, C), 1.0),
        's5_glu_w': nrm(ks[21], (L, W, W), W ** -0.5),
        's5_glu_b': nrm(ks[22], (L, W), 0.01),
        'w_branch': nrm(ks[23], (L, N_BRANCH, W, D), W ** -0.5),
        'w_gate': nrm(ks[24], (L, N_BRANCH, D, D), D ** -0.5),
        'b_gate': nrm(ks[25], (L, N_BRANCH, D), 0.01),
        'w_out': nrm(ks[26], (L, D, D), D ** -0.5),
        'ffn_w_in': nrm(ks[27], (L, D, 2 * FFN_HIDDEN), D ** -0.5),
        'ffn_w_out': nrm(ks[28], (L, FFN_HIDDEN, D), FFN_HIDDEN ** -0.5),
    }


def reference(x, c, ada_w, ada_b, norm_g, w_in, rel_bias, diff_lambda, ml_conv, ml_gate_b,
              gla_wa2, gla_ba, s5_a_re, s5_a_im, s5_log_dt, s5_b_re, s5_b_im, s5_c_re, s5_c_im,
              s5_d, s5_glu_w, s5_glu_b, w_branch, w_gate, b_gate, w_out, ffn_w_in, ffn_w_out):
    B, S, _ = x.shape
    f32 = jnp.float32
    split_points = [int(p) for p in np.cumsum(IN_SPLITS)[:-1]]
    cs = jax.nn.silu(c)
    rel_bias32 = rel_bias.astype(f32)
    for l in range(DEPTH):
        mod = (cs @ ada_w[l] + ada_b[l]).reshape(B, N_MOD, D_MODEL)[:, :, None, :]
        shift_m, scale_m, gate_m, shift_f, scale_f, gate_f = (mod[:, i] for i in range(N_MOD))

        h = _rms(x, norm_g[l, 0]) * (1.0 + scale_m) + shift_m
        proj = (h @ w_in[l]).astype(f32)
        (da_q, da_k, da_v, ml_q, ml_k, ml_v, ml_o, ml_i, ml_f,
         gl_q, gl_k, gl_v, gl_r, gl_a, s5_u) = jnp.split(proj, split_points, axis=-1)

        lam_init = 0.8 - 0.6 * math.exp(-0.3 * l)
        lp = diff_lambda[l].astype(f32)
        lam = jnp.exp(jnp.sum(lp[0] * lp[1])) - jnp.exp(jnp.sum(lp[2] * lp[3])) + lam_init
        o_a = _diff_attention(da_q, da_k, da_v, lam, lam_init, rel_bias32)

        qk = jax.nn.silu(_causal_conv(jnp.concatenate([ml_q, ml_k], axis=-1), ml_conv[l].astype(f32)))
        mq, mk = jnp.split(qk, 2, axis=-1)
        gb = ml_gate_b[l].astype(f32)
        hm = _mlstm(mq.reshape(B, S, ML_HEADS, ML_DIM),
                    mk.reshape(B, S, ML_HEADS, ML_DIM) * ML_DIM ** -0.5,
                    ml_v.reshape(B, S, ML_HEADS, ML_DIM),
                    ml_i + gb[0], jax.nn.log_sigmoid(ml_f + gb[1]))
        o_b = jax.nn.sigmoid(ml_o) * hm

        la = jax.nn.log_sigmoid(gl_a @ gla_wa2[l].astype(f32) + gla_ba[l].astype(f32)) / GLA_TAU
        og = _gla(gl_q.reshape(B, S, GLA_HEADS, GLA_DK) * GLA_DK ** -0.5,
                  gl_k.reshape(B, S, GLA_HEADS, GLA_DK),
                  gl_v.reshape(B, S, GLA_HEADS, GLA_DV),
                  la.reshape(B, S, GLA_HEADS, GLA_DK))
        o_c = _rms(og).reshape(B, S, GLA_V_W) * jax.nn.silu(gl_r)

        y = _s5(s5_u.reshape(B, S, S5_GROUPS, S5_CH), s5_a_re[l], s5_a_im[l], s5_log_dt[l],
                s5_b_re[l], s5_b_im[l], s5_c_re[l], s5_c_im[l], s5_d[l]).reshape(B, S, BRANCH_WIDTH)
        z = jax.nn.gelu(y)
        o_d = z * jax.nn.sigmoid(z @ s5_glu_w[l].astype(f32) + s5_glu_b[l].astype(f32))

        branches = (o_a, o_b, o_c, o_d)
        merged = [jax.nn.sigmoid(h @ w_gate[l, i] + b_gate[l, i]) * (branches[i].astype(h.dtype) @ w_branch[l, i])
                  for i in range(N_BRANCH)]
        mix = (merged[0] + merged[1] + merged[2] + merged[3]) @ w_out[l]
        x = x + (gate_m * _rms(mix, norm_g[l, 1])).astype(x.dtype)

        h = _rms(x, norm_g[l, 2]) * (1.0 + scale_f) + shift_f
        a, g = jnp.split(h @ ffn_w_in[l], 2, axis=-1)
        x = x + (gate_f * _rms((jax.nn.silu(a) * g) @ ffn_w_out[l], norm_g[l, 3])).astype(x.dtype)
    return x
```

```cpp
#define ONE_LAUNCH 0
#include <hip/hip_runtime.h>
#include <cstdio>
#include <cstdint>
typedef unsigned short bf16_t;
typedef short bf16x8 __attribute__((ext_vector_type(8)));
typedef short s16x4 __attribute__((ext_vector_type(4)));
typedef float f32x4 __attribute__((ext_vector_type(4)));
typedef float f32x16 __attribute__((ext_vector_type(16)));
typedef unsigned u32x4 __attribute__((ext_vector_type(4)));
typedef unsigned u32x2 __attribute__((ext_vector_type(2)));

#ifdef HOST_EMU
#include <cmath>
#include <cstring>
#include <cstdint>
#include <pthread.h>
#define LAS
#define GAS
#define DEV static inline
#define GLOBAL_FN
struct EmuWave { pthread_barrier_t bar; float fa[64][8], fb[64][8]; uintptr_t addr[64]; float v[64]; };
struct EmuBlock { pthread_barrier_t bar; EmuWave wv[8]; };
extern EmuBlock* g_blk;
extern thread_local int emu_tid;
extern thread_local int emu_bid;
#define THREAD_IDX emu_tid
#define OPAQUE_TID emu_tid
DEV int opq(int x) { return x; }
#define BLOCK_IDX emu_bid
DEV void sync_threads() { pthread_barrier_wait(&g_blk->bar); }
DEV void wave_bar() { pthread_barrier_wait(&g_blk->wv[emu_tid >> 6].bar); }
DEV float bf2f(bf16_t b) { unsigned u = (unsigned)b << 16; float f; memcpy(&f, &u, 4); return f; }
DEV bf16_t f2bf(float f) { unsigned u; memcpy(&u, &f, 4); return (bf16_t)((u + 0x7fffu + ((u >> 16) & 1u)) >> 16); }
DEV f32x16 mfma32(bf16x8 a, bf16x8 b, f32x16 c) {
  EmuWave& w = g_blk->wv[emu_tid >> 6]; const int l = emu_tid & 63;
  for (int j = 0; j < 8; ++j) { w.fa[l][j] = bf2f((bf16_t)a[j]); w.fb[l][j] = bf2f((bf16_t)b[j]); }
  wave_bar();
  const int col = l & 31, hi = l >> 5;
  for (int i = 0; i < 16; ++i) { const int row = (i & 3) + 8 * (i >> 2) + 4 * hi; float s = c[i];
    for (int k = 0; k < 16; ++k) s += w.fa[row + 32 * (k >> 3)][k & 7] * w.fb[col + 32 * (k >> 3)][k & 7];
    c[i] = s; }
  wave_bar();
  return c;
}
DEV f32x4 mfma16(bf16x8 a, bf16x8 b, f32x4 c) {
  EmuWave& w = g_blk->wv[emu_tid >> 6]; const int l = emu_tid & 63;
  for (int j = 0; j < 8; ++j) { w.fa[l][j] = bf2f((bf16_t)a[j]); w.fb[l][j] = bf2f((bf16_t)b[j]); }
  wave_bar();
  const int col = l & 15, g = l >> 4;
  for (int i = 0; i < 4; ++i) { const int row = 4 * g + i; float s = c[i];
    for (int k = 0; k < 32; ++k) s += w.fa[row + 16 * (k >> 3)][k & 7] * w.fb[col + 16 * (k >> 3)][k & 7];
    c[i] = s; }
  wave_bar();
  return c;
}
DEV s16x4 lds_tr(const char* p) {
  EmuWave& w = g_blk->wv[emu_tid >> 6]; const int l = emu_tid & 63;
  w.addr[l] = (uintptr_t)p; wave_bar();
  const int g = l >> 4, i = l & 15; s16x4 r;
  for (int q = 0; q < 4; ++q) { const char* src = (const char*)w.addr[16 * g + 4 * q + (i >> 2)] + 2 * (i & 3); short s; memcpy(&s, src, 2); r[q] = s; }
  wave_bar();
  return r;
}
DEV float shfl_xor_f(float v, int m) { EmuWave& w = g_blk->wv[emu_tid >> 6]; const int l = emu_tid & 63; w.v[l] = v; wave_bar(); float r = w.v[l ^ m]; wave_bar(); return r; }
DEV float shfl_up_f(float v, int d) { EmuWave& w = g_blk->wv[emu_tid >> 6]; const int l = emu_tid & 63; w.v[l] = v; wave_bar(); float r = (l >= d) ? w.v[l - d] : v; wave_bar(); return r; }
DEV float shfl_idx_f(float v, int s) { EmuWave& w = g_blk->wv[emu_tid >> 6]; const int l = emu_tid & 63; w.v[l] = v; wave_bar(); float r = w.v[s]; wave_bar(); return r; }
DEV float fast_exp2(float x) { return exp2f(x); }
DEV float fast_rcp(float x) { return 1.0f / x; }
DEV float fast_rsq(float x) { return 1.0f / sqrtf(x); }
DEV int rfl(int x) { return x; }
DEV void wave_sync() { wave_bar(); }
DEV void sched_fence() {}
DEV const char* uptr(const void* q) { return (const char*)q; }
#define __expf expf
#else
#include <hip/hip_runtime.h>
#define LAS __attribute__((address_space(3)))
#define GAS __attribute__((address_space(1)))
#define DEV __device__ __forceinline__
#define THREAD_IDX ((int)threadIdx.x)
DEV int opaque_tid_() { int t = (int)threadIdx.x; asm volatile("" : "+v"(t)); return t; }
#define OPAQUE_TID opaque_tid_()
DEV int opq(int x) { asm volatile("" : "+v"(x)); return x; }
#define BLOCK_IDX ((int)blockIdx.x)
DEV void sync_threads() { __syncthreads(); }
DEV float bf2f(bf16_t b) { return __uint_as_float((unsigned)b << 16); }
DEV bf16_t f2bf(float f) { unsigned u = __float_as_uint(f); return (bf16_t)((u + 0x7fffu + ((u >> 16) & 1u)) >> 16); }
DEV f32x16 mfma32(bf16x8 a, bf16x8 b, f32x16 c) { return __builtin_amdgcn_mfma_f32_32x32x16_bf16(a, b, c, 0, 0, 0); }
DEV f32x4 mfma16(bf16x8 a, bf16x8 b, f32x4 c) { return __builtin_amdgcn_mfma_f32_16x16x32_bf16(a, b, c, 0, 0, 0); }
typedef short v4i16_t __attribute__((ext_vector_type(4)));
DEV s16x4 lds_tr(const LAS char* p) { return __builtin_bit_cast(s16x4, __builtin_amdgcn_ds_read_tr16_b64_v4i16((LAS v4i16_t*)p)); }
DEV float shfl_xor_f(float v, int m) { return __shfl_xor(v, m); }
DEV float shfl_up_f(float v, int d) { return __shfl_up(v, d); }
DEV float shfl_idx_f(float v, int s) { return __shfl(v, s); }
DEV float fast_exp2(float x) { return __builtin_amdgcn_exp2f(x); }
DEV float fast_rcp(float x) { return __builtin_amdgcn_rcpf(x); }
DEV float fast_rsq(float x) { return __builtin_amdgcn_rsqf(x); }
DEV int rfl(int x) { return __builtin_amdgcn_readfirstlane(x); }
DEV void wave_sync() { asm volatile("s_waitcnt lgkmcnt(0)" ::: "memory"); }
DEV void sched_fence() { __builtin_amdgcn_sched_barrier(0); }
DEV const GAS char* uptr(const void* q) { const unsigned long long v = (unsigned long long)q; const unsigned lo = __builtin_amdgcn_readfirstlane((unsigned)v), hi = __builtin_amdgcn_readfirstlane((unsigned)(v >> 32)); return (const GAS char*)(((unsigned long long)hi << 32) | lo); }
#endif
typedef LAS char* LDSP;
DEV unsigned pk2(float lo, float hi) { return (unsigned)f2bf(lo) | ((unsigned)f2bf(hi) << 16); }
DEV int crow(int i, int hi) { return (i & 3) + 8 * (i >> 2) + 4 * hi; }
DEV unsigned offb(unsigned row, unsigned ch) { return 256u * row + 16u * (ch ^ (((row & 3u) << 2) | ((row >> 2) & 3u))); }
DEV bf16x8 lds_ld8(LDSP p) { return *(const LAS bf16x8*)p; }
DEV bf16x8 frag_row(LDSP tile, int rb, int ks, int lane) { return lds_ld8(tile + offb(rb + (lane & 31), 2 * ks + (lane >> 5))); }
DEV bf16x8 frag_tr(LDSP tile, int cb, int ks, int lane, bool perm) {
  const int h2 = lane >> 5, blk = (lane >> 4) & 1, q = (lane & 15) >> 2, p = lane & 3;
  const int r0 = perm ? (16 * ks + 4 * h2) : (16 * ks + 8 * h2), dr = perm ? 8 : 4;
  const unsigned ch = 4 * cb + 2 * blk + (p >> 1), bo = 8 * (p & 1);
  const s16x4 a = lds_tr(tile + offb(r0 + q, ch) + bo), b = lds_tr(tile + offb(r0 + dr + q, ch) + bo);
  return (bf16x8){a[0], a[1], a[2], a[3], b[0], b[1], b[2], b[3]};
}
DEV bf16x8 acc_frag(const f32x16& x, int s) {
  u32x4 w; w.x = pk2(x[8 * s + 0], x[8 * s + 1]); w.y = pk2(x[8 * s + 2], x[8 * s + 3]); w.z = pk2(x[8 * s + 4], x[8 * s + 5]); w.w = pk2(x[8 * s + 6], x[8 * s + 7]);
  return __builtin_bit_cast(bf16x8, w);
}
#ifndef SEQ
#define SEQ 8192
#endif
#ifndef BATCH
#define BATCH 4
#endif
constexpr int M_TOK = BATCH * SEQ, PW = 5632, OW = 2048, NCH = SEQ / 64;
constexpr int C_DAQ = 0, C_DAK = 512, C_DAV = 1024, C_MLQ = 1536, C_MLK = 2048, C_MLV = 2560, C_MLO = 3072, C_GLQ = 3584, C_GLK = 3840, C_GLV = 4096, C_GLR = 4608, C_S5U = 5120;
constexpr int NW_MLI = 0, NW_MLF = 4, NW_GLA = 8, NWP = 32;
constexpr float LOG2E = 1.4426950408889634f, RMS_EPS = 1e-6f;
#define NEG_INF (-__builtin_inff())

DEV float sigmoidf_(float x) { return fast_rcp(1.0f + fast_exp2(-x * LOG2E)); }
DEV float log_sigmoidf_(float x) {
  const float ax = x < 0.f ? -x : x; return (x < 0.f ? x : 0.f) - log1pf(__expf(-ax)); }
DEV float wave_sum_f(float v) { for (int o = 1; o < 64; o <<= 1) v += shfl_xor_f(v, o); return v; }

DEV void attn_unit(LDSP lds, const LAS float* biasT, const bf16_t* __restrict__ proj, bf16_t* __restrict__ oall, float lam, float lam_init, int b, int h, int qb) {
  const int tid = OPAQUE_TID, lane = tid & 63, wave = rfl(tid >> 6), l31 = lane & 31, h2 = lane >> 5;
  const int mp = wave >> 2, wq = wave & 3, q0 = qb * 128, r0 = q0 + 32 * wq;
  const size_t rowbase = (size_t)b * SEQ;
  bf16x8 qf[4];
  { const bf16_t* qp = proj + (rowbase + r0 + l31) * PW + C_DAQ + h * 128 + mp * 64 + 8 * h2;
#pragma unroll
    for (int ks = 0; ks < 4; ++ks) qf[ks] = *(const bf16x8*)(qp + 16 * ks); }
  f32x16 o[4];
#pragma unroll
  for (int c = 0; c < 4; ++c)
#pragma unroll
    for (int i = 0; i < 16; ++i) o[c][i] = 0.f;
  float mrun = NEG_INF, lpart = 0.f;
  const int nt = 2 * qb + 2, tlast = (r0 + 31) >> 6;
  const float scale2 = 0.125f * LOG2E;
  const LAS float* bt = biasT + h * 128;
  u32x4 rk[2], rv[2];
  const bf16_t* gk = proj + rowbase * PW + C_DAK + h * 128; const bf16_t* gv = proj + rowbase * PW + C_DAV + h * 128;
#define ATT_LOAD(t) do { _Pragma("unroll") for (int i = 0; i < 2; ++i) { const int id = tid + 512 * i, row = id >> 4, ch = id & 15; \
    rk[i] = *(const u32x4*)(gk + (size_t)(64 * (t) + row) * PW + ch * 8); rv[i] = *(const u32x4*)(gv + (size_t)(64 * (t) + row) * PW + ch * 8); } } while (0)
#define ATT_STORE(buf) do { _Pragma("unroll") for (int i = 0; i < 2; ++i) { const int id = tid + 512 * i, row = id >> 4, ch = id & 15; \
    *(LAS u32x4*)(lds + (buf) * 16384 + offb(row, ch)) = rk[i]; *(LAS u32x4*)(lds + 32768 + (buf) * 16384 + offb(row, ch)) = rv[i]; } } while (0)
  ATT_LOAD(0); ATT_STORE(0); sync_threads();
  for (int t = 0; t < nt; ++t) {
    if (t + 1 < nt) ATT_LOAD(t + 1);
    if (t <= tlast) {
      LDSP Kt = lds + (t & 1) * 16384, Vt = lds + 32768 + (t & 1) * 16384;
      f32x16 p[2];
#pragma unroll
      for (int kb = 0; kb < 2; ++kb) {
#pragma unroll
        for (int i = 0; i < 16; ++i) p[kb][i] = 0.f;
#pragma unroll
        for (int ks = 0; ks < 4; ++ks) p[kb] = mfma32(frag_row(Kt, 32 * kb, 4 * mp + ks, lane), qf[ks], p[kb]);
      }
      const int qabs = r0 + l31, j0 = 64 * t;
      const bool far = (r0 - (j0 + 63)) >= 127;
      const float bfar = bt[127];
      float mx = NEG_INF;
#pragma unroll
      for (int kb = 0; kb < 2; ++kb)
#pragma unroll
        for (int i = 0; i < 16; ++i) {
          const int dist = qabs - (j0 + 32 * kb + crow(i, h2));
          float bv = bfar; if (!far) bv = bt[dist < 0 ? 0 : (dist > 127 ? 127 : dist)];
          float s = p[kb][i] * scale2 + bv; if (dist < 0) s = NEG_INF;
          p[kb][i] = s; mx = fmaxf(mx, s);
        }
      mx = fmaxf(mx, shfl_xor_f(mx, 32));
      const float mnew = fmaxf(mrun, mx), alpha = fast_exp2(mrun - mnew);
      mrun = mnew;
      float rs = 0.f;
#pragma unroll
      for (int kb = 0; kb < 2; ++kb)
#pragma unroll
        for (int i = 0; i < 16; ++i) { const float e = fast_exp2(p[kb][i] - mnew); p[kb][i] = e; rs += e; }
      lpart = lpart * alpha + rs;
#pragma unroll
      for (int c = 0; c < 4; ++c)
#pragma unroll
        for (int i = 0; i < 16; ++i) o[c][i] *= alpha;
#pragma unroll
      for (int ks = 0; ks < 4; ++ks) {
        const bf16x8 pf = acc_frag(p[ks >> 1], ks & 1);
#pragma unroll
        for (int c = 0; c < 4; ++c) o[c] = mfma32(frag_tr(Vt, c, ks, lane, true), pf, o[c]);
      }
    }
    if (t + 1 < nt) ATT_STORE((t + 1) & 1);
    sync_threads();
  }
#undef ATT_LOAD
#undef ATT_STORE
  { const float ltot = lpart + shfl_xor_f(lpart, 32), inv = 1.0f / ltot;
#pragma unroll
    for (int c = 0; c < 4; ++c)
#pragma unroll
      for (int i = 0; i < 16; ++i) o[c][i] *= inv; }
  LAS float* X = (LAS float*)lds;
  if (mp == 1) {
#pragma unroll
    for (int c = 0; c < 4; ++c)
#pragma unroll
      for (int i = 0; i < 16; ++i) X[((wq * 4 + c) * 16 + i) * 64 + lane] = o[c][i];
  }
  sync_threads();
  if (mp == 0) {
    float ss = 0.f;
#pragma unroll
    for (int c = 0; c < 4; ++c)
#pragma unroll
      for (int i = 0; i < 16; ++i) { const float d = o[c][i] - lam * X[((wq * 4 + c) * 16 + i) * 64 + lane]; o[c][i] = d; ss += d * d; }
    ss += shfl_xor_f(ss, 32);
    const float r = (1.0f - lam_init) / sqrtf(ss * (1.0f / 128.0f) + RMS_EPS);
    bf16_t* op = oall + (rowbase + r0 + l31) * OW + 0 + h * 128 + 4 * h2;
#pragma unroll
    for (int c = 0; c < 4; ++c)
#pragma unroll
      for (int g = 0; g < 4; ++g) { u32x2 w; w.x = pk2(o[c][4 * g] * r, o[c][4 * g + 1] * r); w.y = pk2(o[c][4 * g + 2] * r, o[c][4 * g + 3] * r);
        *(u32x2*)(op + 32 * c + 8 * g) = w; }
  }
  sync_threads();
}

DEV void mlstm_item(LDSP lds, const bf16_t* __restrict__ proj, const float* __restrict__ narrow, const float* __restrict__ convw  , const float* __restrict__ gateb  ,
                    bf16_t* __restrict__ oall, int b, int h) {
  const int tid0 = OPAQUE_TID, wave = rfl(tid0 >> 6);
#define ML_LANES() const int tid = opq(tid0), lane = tid & 63, l31 = lane & 31, h2 = lane >> 5; (void)l31; (void)h2; (void)lane
  LDSP Qt = lds, Kt = lds + 16384, Vt = lds + 32768, KWt = lds + 49152, Ct = lds + 65536;
  LAS float* F = (LAS float*)(lds + 106496);
  LAS float *U = F, *Mv = F + 64, *AT = F + 128, *EM = F + 192, *WJ = F + 256, *QN = F + 320, *SC = F + 384, *NV = F + 392, *CW = F + 520;
  const size_t rowbase = (size_t)b * SEQ;
  { ML_LANES();
    for (int i = tid; i < 40960 / 4; i += 512) ((LAS unsigned*)Ct)[i] = 0u;
    if (tid < 128) NV[tid] = 0.f;
    for (int i = tid; i < 1024; i += 512) { const int j = i >> 8, r = i & 255; CW[i] = convw[j * 1024 + (r >> 7) * 512 + h * 128 + (r & 127)]; }
  }
  const float gb0 = gateb[h], gb1 = gateb[4 + h];
  f32x16 cst[2];
#pragma unroll
  for (int x = 0; x < 2; ++x)
#pragma unroll
    for (int i = 0; i < 16; ++i) cst[x][i] = 0.f;
  float mprev = 0.f;
  const int eb = wave & 3, tb = wave >> 2;
  sync_threads();
  for (int ch = 0; ch < NCH; ++ch) {
    const size_t t0 = rowbase + (size_t)ch * 64;
    const GAS char* pbase = uptr(proj + (t0 - 3) * PW);
    { ML_LANES();
      if (tid < 256) {
        const int which = (tid >> 7) & 1, dch = tid & 15, tg = (tid & 127) >> 4;
        const int colbase = (which ? C_MLK : C_MLQ) + h * 128 + dch * 8;
        float cw[4][8];
#pragma unroll
        for (int j = 0; j < 4; ++j) { const f32x4 a = *(const LAS f32x4*)(CW + j * 256 + which * 128 + dch * 8), c = *(const LAS f32x4*)(CW + j * 256 + which * 128 + dch * 8 + 4);
          cw[j][0] = a[0]; cw[j][1] = a[1]; cw[j][2] = a[2]; cw[j][3] = a[3]; cw[j][4] = c[0]; cw[j][5] = c[1]; cw[j][6] = c[2]; cw[j][7] = c[3]; }
        float win[3][8];
        unsigned voff = (unsigned)((tg * 8) * PW + colbase) * 2u;
#pragma unroll
        for (int r = 0; r < 3; ++r) { const int tt = ch * 64 + tg * 8 - 3 + r; bf16x8 v = (bf16x8){0, 0, 0, 0, 0, 0, 0, 0};
          if (tt >= 0) v = *(const GAS bf16x8*)(pbase + voff);
          voff += PW * 2;
#pragma unroll
          for (int d = 0; d < 8; ++d) win[r][d] = bf2f((bf16_t)v[d]); }
        const float osc = which ? 0.08838834764831845f : 1.0f;
        LDSP dstT = which ? Kt : Qt;
#pragma unroll 2
        for (int r = 0; r < 8; ++r) {
          const bf16x8 v = *(const GAS bf16x8*)(pbase + voff);
          voff += PW * 2;
          float cur[8], y[8];
#pragma unroll
          for (int d = 0; d < 8; ++d) { cur[d] = bf2f((bf16_t)v[d]); const float a = cw[0][d] * win[0][d] + cw[1][d] * win[1][d] + cw[2][d] * win[2][d] + cw[3][d] * cur[d];
            y[d] = a * sigmoidf_(a) * osc; win[0][d] = win[1][d]; win[1][d] = win[2][d]; win[2][d] = cur[d]; }
          u32x4 w; w.x = pk2(y[0], y[1]); w.y = pk2(y[2], y[3]); w.z = pk2(y[4], y[5]); w.w = pk2(y[6], y[7]);
          *(LAS u32x4*)(dstT + offb(tg * 8 + r, dch)) = w;
        }
      } else {
        const int t2 = tid - 256;
#pragma unroll
        for (int i = 0; i < 4; ++i) { const int id = t2 + 256 * i, row = id >> 4, c16 = id & 15;
          *(LAS u32x4*)(Vt + offb(row, c16)) = *(const GAS u32x4*)(pbase + (unsigned)((row + 3) * PW + C_MLV + h * 128 + c16 * 8) * 2u); }
      }
      if (wave == 0) {
        const GAS char* nb = uptr(narrow + t0 * NWP);
        const float ig = *(const GAS float*)(nb + (unsigned)(lane * NWP + NW_MLI + h) * 4u) + gb0;
        const float lf = log_sigmoidf_(*(const GAS float*)(nb + (unsigned)(lane * NWP + NW_MLF + h) * 4u) + gb1);
        float bsum = lf;
#pragma unroll
        for (int d = 1; d < 64; d <<= 1) { const float o_ = shfl_up_f(bsum, d); if (lane >= d) bsum += o_; }
        const float u = ig - bsum; float pm = u;
#pragma unroll
        for (int d = 1; d < 64; d <<= 1) { const float o_ = shfl_up_f(pm, d); if (lane >= d) pm = fmaxf(pm, o_); }
        const float Mt = fmaxf(mprev, pm);
        const float Mlast = shfl_idx_f(Mt, 63), blast = shfl_idx_f(bsum, 63);
        U[lane] = u; Mv[lane] = Mt; AT[lane] = __expf(mprev - Mt); EM[lane] = __expf(-(bsum + Mt)); WJ[lane] = __expf(u - Mlast);
        if (lane == 0) SC[0] = __expf(mprev - Mlast);
        mprev = blast + Mlast;
      }
    }
    sync_threads();
    { ML_LANES();
#pragma unroll
      for (int i = 0; i < 2; ++i) { const int id = tid + 512 * i, row = id >> 4, c16 = id & 15; const float wj = WJ[row];
        const bf16x8 v = lds_ld8(Kt + offb(row, c16)); u32x4 w;
        w.x = pk2(bf2f((bf16_t)v[0]) * wj, bf2f((bf16_t)v[1]) * wj); w.y = pk2(bf2f((bf16_t)v[2]) * wj, bf2f((bf16_t)v[3]) * wj);
        w.z = pk2(bf2f((bf16_t)v[4]) * wj, bf2f((bf16_t)v[5]) * wj); w.w = pk2(bf2f((bf16_t)v[6]) * wj, bf2f((bf16_t)v[7]) * wj);
        *(LAS u32x4*)(KWt + offb(row, c16)) = w; }
    }
    sync_threads();
    if (eb == 0) {
      ML_LANES();
      f32x16 qn;
#pragma unroll
      for (int i = 0; i < 16; ++i) qn[i] = 0.f;
#pragma unroll
      for (int ks = 0; ks < 8; ++ks) qn = mfma32(frag_row(Ct, 128, ks, lane), frag_row(Qt, 32 * tb, ks, lane), qn);
      if (h2 == 0) QN[32 * tb + l31] = qn[0];
    }
    f32x16 acc;
    { ML_LANES();
#pragma unroll
      for (int i = 0; i < 16; ++i) acc[i] = 0.f;
#pragma unroll
      for (int ks = 0; ks < 8; ++ks) acc = mfma32(frag_row(Ct, 32 * eb, ks, lane), frag_row(Qt, 32 * tb, ks, lane), acc);
    }
    float rsum = 0.f;
#pragma unroll
    for (int jb = 0; jb < 2; ++jb) {
      if (jb <= tb) {
        ML_LANES();
        const int tl = 32 * tb + l31; const float Mt = Mv[tl];
        if (jb == 0) { const float at = AT[tl];
#pragma unroll
          for (int i = 0; i < 16; ++i) acc[i] *= at; }
        f32x16 s;
#pragma unroll
        for (int i = 0; i < 16; ++i) s[i] = 0.f;
#pragma unroll
        for (int ks = 0; ks < 8; ++ks) s = mfma32(frag_row(Kt, 32 * jb, ks, lane), frag_row(Qt, 32 * tb, ks, lane), s);
#pragma unroll
        for (int i = 0; i < 16; ++i) { const int j = 32 * jb + crow(i, h2); const float w = (j <= tl) ? __expf(U[j] - Mt) : 0.f; s[i] *= w; rsum += s[i]; }
#pragma unroll
        for (int s2 = 0; s2 < 2; ++s2) acc = mfma32(frag_tr(Vt, eb, 2 * jb + s2, lane, true), acc_frag(s, s2), acc);
      }
    }
    rsum += shfl_xor_f(rsum, 32);
    sync_threads();
    { ML_LANES();
      const int tl = 32 * tb + l31;
      const float den = AT[tl] * QN[tl] + rsum; const float dd = fmaxf(fabsf(den), EM[tl]); const float inv = 1.0f / dd;
      const GAS char* og = pbase + (unsigned)((tl + 3) * PW + C_MLO + h * 128 + 32 * eb + 4 * h2) * 2u; GAS char* op = (GAS char*)uptr(oall + t0 * OW) + (unsigned)(tl * OW + 512 + h * 128 + 32 * eb + 4 * h2) * 2u;
#pragma unroll
      for (int g = 0; g < 4; ++g) { const u32x2 gv2 = *(const GAS u32x2*)(og + 16 * g);
        const float g0 = sigmoidf_(bf2f((bf16_t)(gv2.x & 0xffff))), g1 = sigmoidf_(bf2f((bf16_t)(gv2.x >> 16))), g2 = sigmoidf_(bf2f((bf16_t)(gv2.y & 0xffff))), g3 = sigmoidf_(bf2f((bf16_t)(gv2.y >> 16)));
        u32x2 w; w.x = pk2(acc[4 * g] * inv * g0, acc[4 * g + 1] * inv * g1); w.y = pk2(acc[4 * g + 2] * inv * g2, acc[4 * g + 3] * inv * g3);
        *(GAS u32x2*)(op + 16 * g) = w; }
    }
    { ML_LANES();
      const float ast = SC[0]; const int db = wave >> 1;
#pragma unroll
      for (int x = 0; x < 2; ++x)
#pragma unroll
        for (int i = 0; i < 16; ++i) cst[x][i] *= ast;
#pragma unroll
      for (int ks = 0; ks < 4; ++ks) { const bf16x8 af = frag_tr(KWt, db, ks, lane, false);
#pragma unroll
        for (int x = 0; x < 2; ++x) cst[x] = mfma32(af, frag_tr(Vt, 2 * (wave & 1) + x, ks, lane, false), cst[x]); }
#pragma unroll
      for (int x = 0; x < 2; ++x) { const int e = 32 * (2 * (wave & 1) + x) + l31;
#pragma unroll
        for (int g = 0; g < 4; ++g) { const int d = 32 * db + 8 * g + 4 * h2; u32x2 w; w.x = pk2(cst[x][4 * g], cst[x][4 * g + 1]); w.y = pk2(cst[x][4 * g + 2], cst[x][4 * g + 3]);
          *(LAS u32x2*)(Ct + offb(e, d >> 3) + (d & 7) * 2) = w; } }
      if (tid < 128) { float s = 0.f;
        for (int j = 0; j < 64; ++j) s += bf2f(*(const LAS bf16_t*)(KWt + offb(j, tid >> 3) + (tid & 7) * 2));
        const float nn = ast * NV[tid] + s; NV[tid] = nn; *(LAS bf16_t*)(Ct + offb(128, tid >> 3) + (tid & 7) * 2) = f2bf(nn); }
    }
    sync_threads();
  }
#undef ML_LANES
}

constexpr int ST_PITCH = 144;
DEV void gla_item(LDSP lds, const bf16_t* __restrict__ proj, const float* __restrict__ narrow, const float* __restrict__ wa2  , const float* __restrict__ ba  ,
                  bf16_t* __restrict__ oall, int b, int h) {
  const int tid = OPAQUE_TID, lane = tid & 63, wave = rfl(tid >> 6), l31 = lane & 31, h2 = lane >> 5;
  LDSP QKt = lds, KWt = lds + 16384, Vt = lds + 32768, St = lds + 49152;
  LAS float* F = (LAS float*)(lds + 69632);
  LAS float *GA = F, *TOT = F + 1024, *EL = F + 1536, *SS = F + 1600;
  const size_t rowbase = (size_t)b * SEQ;
  for (int i = tid; i < 128 * ST_PITCH / 4; i += 512) ((LAS unsigned*)St)[i] = 0u;
  for (int i = tid; i < 16384 / 4; i += 512) ((LAS unsigned*)KWt)[i] = 0u;
  const int d = tid & 63, tg = tid >> 6;
  float wcol[16];
#pragma unroll
  for (int r = 0; r < 16; ++r) wcol[r] = wa2[r * 256 + h * 64 + d];
  const float bad = ba[h * 64 + d];
  f32x16 sst;
#pragma unroll
  for (int i = 0; i < 16; ++i) sst[i] = 0.f;
  const int eb = wave & 3, tb = wave >> 2;
  sync_threads();
  for (int ch = 0; ch < NCH; ++ch) {
    const size_t t0 = rowbase + (size_t)ch * 64;
    { const int id = tid * 2, row = id >> 4, c = id & 15; const float* gp = narrow + (t0 + row) * NWP + NW_GLA + c; GA[id] = gp[0]; GA[id + 1] = gp[1]; }
#pragma unroll
    for (int i = 0; i < 2; ++i) { const int id = tid + 512 * i, row = id >> 4, c16 = id & 15;
      *(LAS u32x4*)(Vt + offb(row, c16)) = *(const u32x4*)(proj + (t0 + row) * PW + C_GLV + h * 128 + c16 * 8); }
    sync_threads();
    float bc[8], tot = 0.f;
#pragma unroll
    for (int r = 0; r < 8; ++r) { const int t = 8 * tg + r; float z = bad;
#pragma unroll
      for (int k = 0; k < 16; ++k) z += GA[t * 16 + k] * wcol[k];
      tot += log_sigmoidf_(z) * 0.0625f; bc[r] = tot; }
    TOT[tg * 64 + d] = tot;
    sync_threads();
    float off = 0.f, last = 0.f;
#pragma unroll
    for (int g = 0; g < 8; ++g) { const float v = TOT[g * 64 + d]; if (g < tg) off += v; last += v; }
    if (tg == 0) EL[d] = __expf(last);
#pragma unroll
    for (int r = 0; r < 8; ++r) { const int t = 8 * tg + r; const float bcv = bc[r] + off;
      const float qv = bf2f(proj[(t0 + t) * PW + C_GLQ + h * 64 + d]) * 0.125f * __expf(bcv);
      const float kraw = bf2f(proj[(t0 + t) * PW + C_GLK + h * 64 + d]);
      *(LAS bf16_t*)(QKt + offb(t, d >> 3) + (d & 7) * 2) = f2bf(qv);
      *(LAS bf16_t*)(QKt + offb(t, 8 + (d >> 3)) + (d & 7) * 2) = f2bf(kraw * __expf(-bcv));
      *(LAS bf16_t*)(KWt + offb(t, d >> 3) + (d & 7) * 2) = f2bf(kraw * __expf(last - bcv)); }
    sync_threads();
    f32x16 acc;
#pragma unroll
    for (int i = 0; i < 16; ++i) acc[i] = 0.f;
#pragma unroll
    for (int ks = 0; ks < 4; ++ks) acc = mfma32(lds_ld8(St + (32 * eb + l31) * ST_PITCH + (16 * ks + 8 * h2) * 2), frag_row(QKt, 32 * tb, ks, lane), acc);
    const int tl = 32 * tb + l31;
#pragma unroll
    for (int jb = 0; jb < 2; ++jb) {
      if (jb <= tb) {
        f32x16 s;
#pragma unroll
        for (int i = 0; i < 16; ++i) s[i] = 0.f;
#pragma unroll
        for (int ks = 0; ks < 4; ++ks) s = mfma32(frag_row(QKt, 32 * jb, 4 + ks, lane), frag_row(QKt, 32 * tb, ks, lane), s);
#pragma unroll
        for (int i = 0; i < 16; ++i) { const int j = 32 * jb + crow(i, h2); if (j > tl) s[i] = 0.f; }
#pragma unroll
        for (int s2 = 0; s2 < 2; ++s2) acc = mfma32(frag_tr(Vt, eb, 2 * jb + s2, lane, true), acc_frag(s, s2), acc);
      }
    }
    float ss = 0.f;
#pragma unroll
    for (int i = 0; i < 16; ++i) ss += acc[i] * acc[i];
    ss += shfl_xor_f(ss, 32);
    if (h2 == 0) SS[eb * 64 + tl] = ss;
    sync_threads();
    {
      const float tot2 = SS[tl] + SS[64 + tl] + SS[128 + tl] + SS[192 + tl]; const float r = 1.0f / sqrtf(tot2 * (1.0f / 128.0f) + RMS_EPS);
      const size_t row = t0 + tl; const bf16_t* gr = proj + row * PW + C_GLR + h * 128 + 32 * eb + 4 * h2; bf16_t* op = oall + row * OW + 1024 + h * 128 + 32 * eb + 4 * h2;
#pragma unroll
      for (int g = 0; g < 4; ++g) { const u32x2 gv2 = *(const u32x2*)(gr + 8 * g);
        const float r0 = bf2f((bf16_t)(gv2.x & 0xffff)), r1 = bf2f((bf16_t)(gv2.x >> 16)), r2 = bf2f((bf16_t)(gv2.y & 0xffff)), r3 = bf2f((bf16_t)(gv2.y >> 16));
        u32x2 w; w.x = pk2(acc[4 * g] * r * r0 * sigmoidf_(r0), acc[4 * g + 1] * r * r1 * sigmoidf_(r1)); w.y = pk2(acc[4 * g + 2] * r * r2 * sigmoidf_(r2), acc[4 * g + 3] * r * r3 * sigmoidf_(r3));
        *(u32x2*)(op + 8 * g) = w; }
    }
    { const int db = wave >> 2;
#pragma unroll
      for (int i = 0; i < 16; ++i) sst[i] *= EL[32 * db + crow(i, h2)];
#pragma unroll
      for (int ks = 0; ks < 4; ++ks) sst = mfma32(frag_tr(KWt, db, ks, lane, false), frag_tr(Vt, eb, ks, lane, false), sst);
      const int e = 32 * eb + l31;
#pragma unroll
      for (int g = 0; g < 4; ++g) { const int dd = 32 * db + 8 * g + 4 * h2; u32x2 w; w.x = pk2(sst[4 * g], sst[4 * g + 1]); w.y = pk2(sst[4 * g + 2], sst[4 * g + 3]);
        *(LAS u32x2*)(St + e * ST_PITCH + dd * 2) = w; } }
    sync_threads();
  }
}

constexpr int S5_WAVE_LDS = 12800, XS_PITCH = 272;
DEV float gelu_tanh_(float y) { const float u = 0.7978845608028654f * (y + 0.044715f * y * y * y); const float e = fast_exp2(2.0f * LOG2E * u); const float th = 1.0f - 2.0f * fast_rcp(e + 1.0f); return 0.5f * y * (1.0f + th); }
DEV void s5_wave(LDSP wl, const bf16_t* __restrict__ proj, const float* __restrict__ AB, const bf16_t* __restrict__ BT, const bf16_t* __restrict__ CT, const float* __restrict__ dskip  ,
                 bf16_t* __restrict__ zout  , int b, int g) {
  const int lane = OPAQUE_TID & 63, l15 = lane & 15, kg = lane >> 4;
  LAS float* BU = (LAS float*)wl; LDSP XS = wl + 8192;
  const float are = AB[(g * 64 + lane) * 2], aim = AB[(g * 64 + lane) * 2 + 1];
  bf16x8 bfr[8], cfr[4]; const bf16x8 zero8 = (bf16x8){0, 0, 0, 0, 0, 0, 0, 0};
#pragma unroll
  for (int nb = 0; nb < 8; ++nb) bfr[nb] = (kg < 2) ? *(const bf16x8*)(BT + ((size_t)g * 128 + 16 * nb + l15) * 16 + 8 * kg) : zero8;
#pragma unroll
  for (int ks = 0; ks < 4; ++ks) cfr[ks] = *(const bf16x8*)(CT + ((size_t)g * 16 + l15) * 128 + 32 * ks + 8 * kg);
  const float dsk = dskip[g * 16 + l15];
  float xr = 0.f, xi = 0.f;
  const size_t rowbase = (size_t)b * SEQ;
  for (int t0 = 0; t0 < SEQ; t0 += 16) {
    const bf16_t* up = proj + (rowbase + t0) * PW + C_S5U + g * 16;
    const bf16x8 ua = (kg < 2) ? *(const bf16x8*)(up + (size_t)l15 * PW + 8 * kg) : zero8;
#pragma unroll
    for (int nb = 0; nb < 8; ++nb) { f32x4 c4 = (f32x4){0.f, 0.f, 0.f, 0.f}; c4 = mfma16(ua, bfr[nb], c4);
#pragma unroll
      for (int i = 0; i < 4; ++i) BU[(4 * kg + i) * 128 + 16 * nb + l15] = c4[i]; }
    wave_sync();
#pragma unroll
    for (int j = 0; j < 16; ++j) { const float br = BU[j * 128 + lane], bi = BU[j * 128 + 64 + lane];
      const float nr = are * xr - aim * xi + br, ni = are * xi + aim * xr + bi; xr = nr; xi = ni;
      *(LAS bf16_t*)(XS + j * XS_PITCH + lane * 2) = f2bf(xr); *(LAS bf16_t*)(XS + j * XS_PITCH + (64 + lane) * 2) = f2bf(xi); }
    wave_sync();
    f32x4 y4 = (f32x4){0.f, 0.f, 0.f, 0.f};
#pragma unroll
    for (int ks = 0; ks < 4; ++ks) y4 = mfma16(lds_ld8(XS + l15 * XS_PITCH + (32 * ks + 8 * kg) * 2), cfr[ks], y4);
#pragma unroll
    for (int i = 0; i < 4; ++i) { const size_t row = rowbase + t0 + 4 * kg + i; const float uu = bf2f(proj[row * PW + C_S5U + g * 16 + l15]);
      zout[row * 512 + g * 16 + l15] = f2bf(gelu_tanh_(y4[i] + dsk * uu)); }
  }
}
DEV void s5_prep_item(int idx, const float* a_re, const float* a_im, const float* log_dt, const float* b_re, const float* b_im, const float* c_re, const float* c_im,
                      float* AB, bf16_t* BT, bf16_t* CT) {
  const int g = idx >> 6, p = idx & 63;
  const float are = a_re[idx], aim = a_im[idx], dt = expf(log_dt[g]);
  const float mag = expf(dt * are), abr = mag * cosf(dt * aim), abi = mag * sinf(dt * aim);
  const float nr = abr - 1.0f, ni = abi, den = are * are + aim * aim;
  const float fr = (nr * are + ni * aim) / den, fi = (ni * are - nr * aim) / den;
  AB[idx * 2] = abr; AB[idx * 2 + 1] = abi;
  for (int c = 0; c < 16; ++c) {
    const float br = b_re[(size_t)idx * 16 + c], bi = b_im[(size_t)idx * 16 + c];
    BT[((size_t)g * 128 + p) * 16 + c] = f2bf(fr * br - fi * bi); BT[((size_t)g * 128 + 64 + p) * 16 + c] = f2bf(fr * bi + fi * br);
    CT[((size_t)g * 16 + c) * 128 + p] = f2bf(c_re[((size_t)g * 16 + c) * 64 + p]); CT[((size_t)g * 16 + c) * 128 + 64 + p] = f2bf(-c_im[((size_t)g * 16 + c) * 64 + p]);
  }
}
namespace pg8 {
#define PG8_LAS __attribute__((address_space(3)))
typedef unsigned short bf16_t;
typedef short bf16x8 __attribute__((ext_vector_type(8)));
typedef float f32x4 __attribute__((ext_vector_type(4)));
typedef unsigned u32x4 __attribute__((ext_vector_type(4)));
constexpr int BM = 256, BK = 64, HALF = 128, HTB = HALF * BK * 2  , STAGE_BYTES = 8 * HTB, NXCD = 8, WGM = 8;

__host__ __device__ __forceinline__ int lds_byte(int r, int c) { const int st = (r >> 4) * 2 + (c >> 5), rr = r & 15, cc = c & 31, ob = rr * 64 + cc * 2; return st * 1024 + (ob ^ (((ob >> 9) & 1) << 5)); }
__host__ __device__ __forceinline__ void stage_rc(int b, int& R, int& C) { const int st = b / 1024, sb = b % 1024, swz = sb ^ (((sb >> 9) & 1) << 5); R = (st >> 1) * 16 + swz / 64; C = (st & 1) * 32 + (swz % 64) / 2; }
__host__ __device__ __forceinline__ int perm32(int rho) { const int n = rho >> 4, i = rho & 15; return 8 * (i >> 2) + 4 * n + (i & 3); }

struct Unit { int pm, pn, acol, z; };
struct Gemm { const bf16_t* A; const bf16_t* Bt; int K, lda, ldb; };
typedef float f32x2 __attribute__((ext_vector_type(2)));
__device__ __forceinline__ unsigned cvt_pk_bf16(float lo, float hi) { unsigned r; asm volatile("v_cvt_pk_bf16_f32 %0, %1, %2" : "=v"(r) : "v"(lo), "v"(hi)); return r; }
template <class Epi, class Sched, bool ALIGN_EPI = false, bool SP2 = false>
__device__ __forceinline__ void gemm_phase(PG8_LAS unsigned char* lds, const Gemm g, const Sched& S, const Epi& E) {
    const int tid = OPAQUE_TID, wid = __builtin_amdgcn_readfirstlane(tid >> 6), lane = tid & 63, wr = wid >> 2, wc = wid & 3, fr = lane & 15, fq = lane >> 4;
    const int K = g.K, nt = K / BK;
    unsigned voffA[2], voffB[2];
#pragma unroll
    for (int i = 0; i < 2; ++i) { int R, C; stage_rc(tid * 16 + i * 8192, R, C); const int Rb = Epi::PERM ? ((R & ~31) + perm32(R & 31)) : R;
        voffA[i] = (unsigned)(R * g.lda + C) * 2u; voffB[i] = (unsigned)(Rb * g.ldb + C) * 2u; }
    const size_t kstep = (size_t)(BK * 2);
    const size_t hstepA = (size_t)HALF * g.lda * 2, hstepB = (size_t)HALF * g.ldb * 2;
    const size_t tstepA = 2 * hstepA, tstepB = 2 * hstepB;
    const unsigned ldsw = (unsigned)wid * 1024u;
    const int aoff = lds_byte(wr * 64 + fr, fq * 8), boff = lds_byte(wc * 32 + fr, fq * 8);
#define PG8_SA(b, h) (((b) * 2 + (h)) * HTB)
#define PG8_SB(b, h) ((4 + (b) * 2 + (h)) * HTB)
#define PG8_STAGE(bufoff, gbase, voff) do { _Pragma("unroll") for (int _i = 0; _i < 2; ++_i) \
        __builtin_amdgcn_global_load_lds((const unsigned*)((const char*)(gbase) + (voff)[_i]), (PG8_LAS unsigned*)(lds + (bufoff) + ldsw + _i * 8192), 16, 0, 0); } while (0)
#define PG8_LDA(dst, b, h) do { _Pragma("unroll") for (int m = 0; m < 4; ++m) _Pragma("unroll") for (int k = 0; k < 2; ++k) dst[m][k] = *(const PG8_LAS bf16x8*)(lds + PG8_SA(b, h) + aoff + m * 2048 + k * 1024); } while (0)
#define PG8_LDB(dst, b, h) do { _Pragma("unroll") for (int n = 0; n < 2; ++n) _Pragma("unroll") for (int k = 0; k < 2; ++k) dst[n][k] = *(const PG8_LAS bf16x8*)(lds + PG8_SB(b, h) + boff + n * 2048 + k * 1024); } while (0)
#define PG8_MMA(ai, bj, At, Bt) do { __builtin_amdgcn_s_setprio(1); _Pragma("unroll") for (int m = 0; m < 4; ++m) _Pragma("unroll") for (int n = 0; n < 2; ++n) _Pragma("unroll") for (int k = 0; k < 2; ++k) \
        acc[ai][bj][m][n] = __builtin_amdgcn_mfma_f32_16x16x32_bf16(Bt[n][k], At[m][k], acc[ai][bj][m][n], 0, 0, 0); __builtin_amdgcn_s_setprio(0); } while (0)
#define PG8_WAIT_V(n) asm volatile("s_waitcnt vmcnt(" #n ")" ::: "memory")
#define PG8_WAIT_L(n) asm volatile("s_waitcnt lgkmcnt(" #n ")" ::: "memory")
#define PG8_BAR __builtin_amdgcn_s_barrier()
#define PG8_SCHED __builtin_amdgcn_sched_barrier(0)
    Unit cur, nxt; int ui = 0;
    if (!S.next(0, cur)) return;
    f32x4 acc[2][2][4][2];
#pragma unroll
    for (int a = 0; a < 2; ++a)
#pragma unroll
        for (int b = 0; b < 2; ++b)
#pragma unroll
            for (int m = 0; m < 4; ++m)
#pragma unroll
                for (int n = 0; n < 2; ++n) acc[a][b][m][n] = (f32x4){0.f, 0.f, 0.f, 0.f};
    bf16x8 At[4][2], B0[2][2], B1[2][2];
    const char* cA = (const char*)g.A + (size_t)cur.pm * tstepA + (size_t)cur.acol * 2; const char* cB = (const char*)g.Bt + (size_t)cur.pn * tstepB;
    S.a_ready(cur);
    if constexpr (SP2) {
        PG8_STAGE(PG8_SB(0, 0), cB, voffB); PG8_STAGE(PG8_SB(0, 1), cB + hstepB, voffB); PG8_STAGE(PG8_SA(0, 0), cA, voffA); PG8_STAGE(PG8_SA(0, 1), cA + hstepA, voffA);
        if (wr == 1) PG8_BAR;
        PG8_WAIT_V(2); PG8_BAR;
        PG8_STAGE(PG8_SB(1, 0), cB + kstep, voffB); PG8_STAGE(PG8_SA(1, 0), cA + kstep, voffA); PG8_STAGE(PG8_SB(1, 1), cB + hstepB + kstep, voffB);
        PG8_WAIT_V(6); PG8_BAR;
    } else {
        PG8_STAGE(PG8_SB(0, 0), cB, voffB); PG8_STAGE(PG8_SA(0, 0), cA, voffA); PG8_STAGE(PG8_SB(0, 1), cB + hstepB, voffB); PG8_STAGE(PG8_SA(0, 1), cA + hstepA, voffA);
        if (wr == 1) PG8_BAR;
        PG8_WAIT_V(4); PG8_BAR;
        PG8_STAGE(PG8_SB(1, 0), cB + kstep, voffB); PG8_STAGE(PG8_SA(1, 0), cA + kstep, voffA); PG8_STAGE(PG8_SB(1, 1), cB + hstepB + kstep, voffB);
        PG8_WAIT_V(6); PG8_BAR;
    }
    for (;;) {
        const bool has_next = S.next(ui + 1, nxt);
        const char* nA = has_next ? (const char*)g.A + (size_t)nxt.pm * tstepA + (size_t)nxt.acol * 2 : cA; const char* nB = has_next ? (const char*)g.Bt + (size_t)nxt.pn * tstepB : cB;
        for (int t = 0; t < nt; t += 2) {
            const bool last = (t == nt - 2);
            const char* a1 = cA + (size_t)(t + 1) * kstep;
            const char* a2 = last ? nA : cA + (size_t)(t + 2) * kstep; const char* b2 = last ? nB : cB + (size_t)(t + 2) * kstep;
            const char* a3 = a2 + kstep; const char* b3 = b2 + kstep;
            if (last && has_next) S.a_ready(nxt);
            if constexpr (SP2) {
            PG8_LDB(B0, 0, 0); PG8_LDB(B1, 0, 1); PG8_SCHED; PG8_LDA(At, 0, 0); PG8_STAGE(PG8_SA(1, 1), a1 + hstepA, voffA);
            PG8_WAIT_V(8); PG8_WAIT_L(0); PG8_BAR; PG8_MMA(0, 0, At, B0); PG8_MMA(0, 1, At, B1); PG8_BAR; PG8_SCHED;
            PG8_LDA(At, 0, 1); PG8_STAGE(PG8_SB(0, 0), b2, voffB); PG8_STAGE(PG8_SB(0, 1), b2 + hstepB, voffB); PG8_STAGE(PG8_SA(0, 0), a2, voffA);
            PG8_WAIT_V(8); PG8_WAIT_L(0); PG8_BAR; PG8_MMA(1, 0, At, B0); PG8_MMA(1, 1, At, B1); PG8_BAR; PG8_SCHED;
            PG8_LDB(B0, 1, 0); PG8_LDB(B1, 1, 1); PG8_SCHED; PG8_LDA(At, 1, 0); PG8_STAGE(PG8_SA(0, 1), a2 + hstepA, voffA);
            PG8_WAIT_V(8); PG8_WAIT_L(0); PG8_BAR; PG8_MMA(0, 0, At, B0); PG8_MMA(0, 1, At, B1); PG8_BAR; PG8_SCHED;
            PG8_LDA(At, 1, 1); PG8_STAGE(PG8_SB(1, 0), b3, voffB); PG8_STAGE(PG8_SB(1, 1), b3 + hstepB, voffB); PG8_STAGE(PG8_SA(1, 0), a3, voffA);
            PG8_WAIT_V(8); PG8_WAIT_L(0); PG8_BAR; PG8_MMA(1, 0, At, B0); PG8_MMA(1, 1, At, B1); PG8_BAR; PG8_SCHED;
            } else {
            PG8_LDB(B0, 0, 0); PG8_SCHED; PG8_LDA(At, 0, 0); PG8_STAGE(PG8_SA(1, 1), a1 + hstepA, voffA);
            PG8_WAIT_L(8); PG8_BAR; PG8_WAIT_L(0); PG8_MMA(0, 0, At, B0); PG8_BAR; PG8_SCHED;
            PG8_LDB(B1, 0, 1); PG8_STAGE(PG8_SB(0, 0), b2, voffB);
            PG8_BAR; PG8_WAIT_L(0); PG8_MMA(0, 1, At, B1); PG8_BAR;
            PG8_LDA(At, 0, 1); PG8_STAGE(PG8_SA(0, 0), a2, voffA);
            PG8_BAR; PG8_WAIT_L(0); PG8_MMA(1, 0, At, B0); PG8_BAR; PG8_SCHED;
            PG8_STAGE(PG8_SB(0, 1), b2 + hstepB, voffB);
            PG8_WAIT_V(6); PG8_BAR; PG8_MMA(1, 1, At, B1); PG8_BAR;
            PG8_LDB(B0, 1, 0); PG8_SCHED; PG8_LDA(At, 1, 0); PG8_STAGE(PG8_SA(0, 1), a2 + hstepA, voffA);
            PG8_WAIT_L(8); PG8_BAR; PG8_WAIT_L(0); PG8_MMA(0, 0, At, B0); PG8_BAR; PG8_SCHED;
            PG8_LDB(B1, 1, 1); PG8_STAGE(PG8_SB(1, 0), b3, voffB);
            PG8_BAR; PG8_WAIT_L(0); PG8_MMA(0, 1, At, B1); PG8_BAR;
            PG8_LDA(At, 1, 1); PG8_STAGE(PG8_SA(1, 0), a3, voffA);
            PG8_BAR; PG8_WAIT_L(0); PG8_MMA(1, 0, At, B0); PG8_BAR; PG8_SCHED;
            PG8_STAGE(PG8_SB(1, 1), b3 + hstepB, voffB);
            PG8_WAIT_V(6); PG8_BAR; PG8_MMA(1, 1, At, B1); PG8_BAR;
            }
        }
        if constexpr (ALIGN_EPI) { if (wr == 0) PG8_BAR; }
        if constexpr (!Epi::AFTER_DRAIN) { E(acc, cur, wr, wc, fr, fq); S.done(cur); }
        if (!has_next) break;
#pragma unroll
        for (int a = 0; a < 2; ++a)
#pragma unroll
            for (int b = 0; b < 2; ++b)
#pragma unroll
                for (int m = 0; m < 4; ++m)
#pragma unroll
                    for (int n = 0; n < 2; ++n) acc[a][b][m][n] = (f32x4){0.f, 0.f, 0.f, 0.f};
        cur = nxt; cA = nA; cB = nB; ++ui;
        if constexpr (ALIGN_EPI) { if (wr == 1) PG8_BAR; }
    }
    PG8_WAIT_V(0);
    if constexpr (!ALIGN_EPI) { if (wr == 0) PG8_BAR; }
    PG8_BAR;
    if constexpr (Epi::AFTER_DRAIN) { E.fused(acc, cur, wr, wc, fr, fq, lds, wid, lane); S.done(cur); }
#undef PG8_SA
#undef PG8_SB
#undef PG8_STAGE
#undef PG8_LDA
#undef PG8_LDB
#undef PG8_MMA
#undef PG8_WAIT_V
#undef PG8_WAIT_L
#undef PG8_BAR
#undef PG8_SCHED
}
}
constexpr int DM = 2048, NLAYER = 4, FFH = 5632, NPROJ = 5888, NMT = M_TOK / 256;
constexpr size_t MiB = 1u << 20;
constexpr size_t WS_CTL = 0, CTL_ZERO_BYTES = 1 * MiB;
constexpr size_t WS_MODP = 1 * MiB, WS_S5T = 8 * MiB, WS_WGLU = 9 * MiB, WS_WIN = 10 * MiB, WS_WG = 33 * MiB, WS_WB = 65 * MiB, WS_WOUT = 73 * MiB, WS_WFI = 81 * MiB, WS_WFO = 125 * MiB;
constexpr size_t WS_NAR = 147 * MiB, WS_Z = 151 * MiB, WS_H = 183 * MiB, WS_OALL = 311 * MiB, WS_PROJ = 439 * MiB, WS_P = 791 * MiB, WS_GSCR = 1303 * MiB, WS_END = 1367 * MiB;
constexpr size_t WS_MERGED = WS_PROJ, WS_MIXB = WS_PROJ + 128 * MiB, WS_Y = WS_PROJ, WS_HID = WS_P;
static_assert(WS_WIN + (size_t)NPROJ * DM * 2 <= WS_WG && WS_WFI + (size_t)2 * FFH * DM * 2 <= WS_WFO && WS_WFO + (size_t)DM * FFH * 2 <= WS_NAR, "weight map");
static_assert(WS_NAR + (size_t)M_TOK * NWP * 4 <= WS_Z && WS_Z + (size_t)M_TOK * 512 * 2 <= WS_H && WS_H + (size_t)M_TOK * DM * 2 <= WS_OALL && WS_OALL + (size_t)M_TOK * DM * 2 <= WS_PROJ, "act map");
static_assert(WS_PROJ + (size_t)M_TOK * PW * 2 <= WS_P && WS_P + (size_t)4 * M_TOK * DM * 2 <= WS_GSCR && WS_HID + (size_t)M_TOK * FFH * 2 <= WS_GSCR && WS_GSCR + (size_t)256 * 262144 <= WS_END, "act map 2");
constexpr int KSPLIT = 8;
constexpr int CW_TMO = 0, CW_BAR = 4096, CW_Q = 16384;
constexpr int LDS_BYTES = 147456, LDS_MISC = 131072, LDS_BIAS = 131072 + 256;
constexpr int N_PHASES = 2 + 10 * NLAYER;

__device__ const unsigned char T5_BUCKET[128] = {0,1,2,3,4,5,6,7,8,9,10,11,12,13,14,15,16,16,16,17,17,18,18,18,19,19,19,20,20,20,20,21,21,21,21,22,22,22,22,22,23,23,23,23,23,23,24,24,24,24,24,24,25,25,25,25,25,25,25,26,26,26,26,26,26,26,26,27,27,27,27,27,27,27,27,27,27,28,28,28,28,28,28,28,28,28,28,29,29,29,29,29,29,29,29,29,29,29,29,30,30,30,30,30,30,30,30,30,30,30,30,30,30,31,31,31,31,31,31,31,31,31,31,31,31,31,31,31};

#define XB_TMO      128
#define XB_XCNT(j)  (256  + 64 * (j))
#define XB_XSUB(j)  (1280 + 64 * (j))
#define XB_XGEN(j)  (2304 + 64 * (j))
#define XB_TOP      3328
#define XB_TOPGEN   3392
#define XCD_BAR_WORDS 3456
#define XB_SPIN_CAP (1u << 22)
__device__ __forceinline__ unsigned xb_ld(unsigned* p)              { return __hip_atomic_load(p, __ATOMIC_RELAXED, __HIP_MEMORY_SCOPE_AGENT); }
__device__ __forceinline__ unsigned xb_add(unsigned* p, unsigned v) { return __hip_atomic_fetch_add(p, v, __ATOMIC_RELAXED, __HIP_MEMORY_SCOPE_AGENT); }
__device__ __forceinline__ unsigned xb_xcc_id() { return (unsigned)__builtin_amdgcn_s_getreg((3 << 11) | 20) & 0xFu; }
#define XB_SPIN(cond, bar) do { unsigned _sp = 0; while (cond) { __builtin_amdgcn_s_sleep(1); \
    if ((++_sp & 255u) == 0u) { if (xb_ld(&(bar)[XB_TMO])) break; if (_sp > XB_SPIN_CAP) { atomicAdd(&(bar)[XB_TMO], 1u); break; } } } } while (0)
struct XcdBarrier { unsigned* bar; unsigned x; volatile LAS unsigned* st; };
__device__ __forceinline__ XcdBarrier xcd_barrier_post(unsigned* bar, volatile LAS unsigned* st) {
    XcdBarrier b; b.bar = bar; b.x = xb_xcc_id(); b.st = st;
    if (threadIdx.x == 0) (void)xb_add(&bar[XB_XCNT(b.x)], 1u);
    return b;
}
__device__ __forceinline__ void xcd_barrier_complete(unsigned* bar, unsigned x, unsigned& nloc, unsigned& nx) {
    const unsigned G = gridDim.x * gridDim.y * gridDim.z;
    unsigned sum, cnt, mine, sp = 0u;
    for (;;) {
        sum = 0u; cnt = 0u; mine = 0u;
#pragma unroll
        for (unsigned j = 0; j < 16; ++j) { const unsigned c = xb_ld(&bar[XB_XCNT(j)]); sum += c; cnt += (c > 0u) ? 1u : 0u; mine = (j == x) ? c : mine; }
        if (sum == G) break;
        __builtin_amdgcn_s_sleep(1);
        if ((++sp & 255u) == 0u) { if (xb_ld(&bar[XB_TMO])) break; if (sp > XB_SPIN_CAP) { atomicAdd(&bar[XB_TMO], 1u); break; } }
    }
    nloc = mine > 0u ? mine : 1u; nx = cnt > 0u ? cnt : 1u;
}
__device__ __forceinline__ void xcd_barrier(const XcdBarrier& b) {
    asm volatile("s_waitcnt vmcnt(0)" ::: "memory");
    __syncthreads();
    if (threadIdx.x == 0) {
        unsigned* bar = b.bar;
        __builtin_amdgcn_s_waitcnt(0);
        unsigned nloc = b.st[0], nx = b.st[1];
        if (nloc == 0u) { xcd_barrier_complete(bar, b.x, nloc, nx); b.st[0] = nloc; b.st[1] = nx; }
        const unsigned old = xb_add(&bar[XB_XSUB(b.x)], 1u);
        const unsigned gen = old / nloc;
        if (old + 1u == (gen + 1u) * nloc) {
            __builtin_amdgcn_fence(__ATOMIC_RELEASE, "agent");
            asm volatile("s_waitcnt vmcnt(0)" ::: "memory");
            const unsigned og = xb_add(&bar[XB_TOP], 1u);
            const unsigned tg = og / nx;
            if (og + 1u == (tg + 1u) * nx) xb_add(&bar[XB_TOPGEN], 1u);
            else XB_SPIN(xb_ld(&bar[XB_TOPGEN]) == tg, bar);
            __builtin_amdgcn_fence(__ATOMIC_ACQUIRE, "agent");
            xb_add(&bar[XB_XGEN(b.x)], 1u);
            asm volatile("s_waitcnt vmcnt(0)" ::: "memory");
        } else {
            XB_SPIN(xb_ld(&bar[XB_XGEN(b.x)]) == gen, bar);
            __builtin_amdgcn_fence(__ATOMIC_ACQUIRE, "agent");
            asm volatile("s_waitcnt vmcnt(0)" ::: "memory");
        }
    }
    __syncthreads();
}

namespace pg8 {
__device__ __forceinline__ void tile_map(int nM, int nN, int L, int& pm, int& pn) {
    const int nwg = nM * nN; int wgid = L;
    { const int q = nwg / NXCD, r = nwg % NXCD, xcd = wgid % NXCD, off = wgid / NXCD; wgid = (xcd < r ? xcd * (q + 1) : r * (q + 1) + (xcd - r) * q) + off; }
    const int nig = WGM * nN, gid = wgid / nig, fm = gid * WGM, gsz = (nM - fm) < WGM ? (nM - fm) : WGM;
    pm = fm + ((wgid % nig) % gsz); pn = (wgid % nig) / gsz;
}
struct SchedPlain { int nM, nN, G, c;
    __device__ __forceinline__ bool next(int i, Unit& u) const { const long L = (long)i * G + c; if (L >= (long)nM * nN) return false; tile_map(nM, nN, (int)L, u.pm, u.pn); u.acol = 0; u.z = 0; return true; }
    __device__ __forceinline__ void a_ready(const Unit&) const {} __device__ __forceinline__ void done(const Unit&) const {} };
struct SchedP { int nM, G, c;
    __device__ __forceinline__ bool next(int i, Unit& u) const { const long L = (long)i * G + c; const int per = nM * 8; if (L >= 4L * per) return false; const int z = (int)(L / per); int pm, pn; tile_map(nM, 8, (int)(L % per), pm, pn);
        u.pm = pm; u.pn = z * 8 + pn; u.acol = 512 * z; u.z = z; return true; }
    __device__ __forceinline__ void a_ready(const Unit&) const {} __device__ __forceinline__ void done(const Unit&) const {} };
struct SchedGate { int nM, G, c;
    __device__ __forceinline__ bool next(int i, Unit& u) const { const long T = (long)(i >> 2) * G + c; if (T >= (long)nM * 8) return false; int pm, pn; tile_map(nM, 8, (int)T, pm, pn); const int z = i & 3;
        u.pm = pm; u.pn = z * 8 + pn; u.acol = 0; u.z = z; return true; }
    __device__ __forceinline__ void a_ready(const Unit&) const {} __device__ __forceinline__ void done(const Unit&) const {} };

__device__ __forceinline__ u32x4 pack8(const f32x4& a, const f32x4& b) { u32x4 w; w.x = cvt_pk_bf16(a[0], a[1]); w.y = cvt_pk_bf16(a[2], a[3]); w.z = cvt_pk_bf16(b[0], b[1]); w.w = cvt_pk_bf16(b[2], b[3]); return w; }
__device__ __forceinline__ void unpack8(const u32x4& w, f32x4& a, f32x4& b) {
    a[0] = __uint_as_float(w.x << 16); a[1] = __uint_as_float(w.x & 0xffff0000u); a[2] = __uint_as_float(w.y << 16); a[3] = __uint_as_float(w.y & 0xffff0000u);
    b[0] = __uint_as_float(w.z << 16); b[1] = __uint_as_float(w.z & 0xffff0000u); b[2] = __uint_as_float(w.w << 16); b[3] = __uint_as_float(w.w & 0xffff0000u); }
__device__ __forceinline__ float sigm(float x) { return __builtin_amdgcn_rcpf(1.0f + __builtin_amdgcn_exp2f(-1.4426950408889634f * x)); }

struct EpiPlain {
    static constexpr bool PERM = true, AFTER_DRAIN = false;
    bf16_t* O; int ldc; int colmask; size_t zstride;
    __device__ __forceinline__ void operator()(const f32x4 (&acc)[2][2][4][2], const Unit& u, int wr_, int wc_, int fr_, int fq_) const {
        const int tid = OPAQUE_TID, wid_ = __builtin_amdgcn_readfirstlane(tid >> 6), wr = wid_ >> 2, wc = wid_ & 3, fr = tid & 15, fq = (tid & 63) >> 4;
        const int row0 = u.pm * BM + wr * 64 + fr, col0 = (u.pn & colmask) * BM + wc * 32 + 8 * fq; bf16_t* base = O + (size_t)u.z * zstride;
#pragma unroll
        for (int ai = 0; ai < 2; ++ai)
#pragma unroll
            for (int m = 0; m < 4; ++m) { bf16_t* rowp = base + (size_t)(row0 + ai * HALF + m * 16) * ldc + col0;
#pragma unroll
                for (int bj = 0; bj < 2; ++bj) *(u32x4*)(rowp + bj * HALF) = pack8(acc[ai][bj][m][0], acc[ai][bj][m][1]); }
    }
};
struct EpiProj {
    static constexpr bool PERM = true, AFTER_DRAIN = false;
    bf16_t* P; float* NAR;
    __device__ __forceinline__ void operator()(const f32x4 (&acc)[2][2][4][2], const Unit& u, int wr_, int wc_, int fr_, int fq_) const {
        const int tid = OPAQUE_TID, wid_ = __builtin_amdgcn_readfirstlane(tid >> 6), wr = wid_ >> 2, wc = wid_ & 3, fr = tid & 15, fq = (tid & 63) >> 4;
        const int row0 = u.pm * BM + wr * 64 + fr;
        if (u.pn < 22) { const int col0 = u.pn * BM + wc * 32 + 8 * fq;
#pragma unroll
            for (int ai = 0; ai < 2; ++ai)
#pragma unroll
                for (int m = 0; m < 4; ++m) { bf16_t* rowp = P + (size_t)(row0 + ai * HALF + m * 16) * PW + col0;
#pragma unroll
                    for (int bj = 0; bj < 2; ++bj) *(u32x4*)(rowp + bj * HALF) = pack8(acc[ai][bj][m][0], acc[ai][bj][m][1]); }
        } else if (wc == 0 && fq < 3) {
#pragma unroll
            for (int ai = 0; ai < 2; ++ai)
#pragma unroll
                for (int m = 0; m < 4; ++m) { float* np = NAR + (size_t)(row0 + ai * HALF + m * 16) * NWP + 8 * fq; *(f32x4*)np = acc[ai][0][m][0]; *(f32x4*)(np + 4) = acc[ai][0][m][1]; }
        }
    }
};
struct EpiGlu {
    static constexpr bool PERM = true, AFTER_DRAIN = false;
    const bf16_t* Z; const float* bias; bf16_t* O;
    __device__ __forceinline__ void operator()(const f32x4 (&acc)[2][2][4][2], const Unit& u, int wr_, int wc_, int fr_, int fq_) const {
        const int tid = OPAQUE_TID, wid_ = __builtin_amdgcn_readfirstlane(tid >> 6), wr = wid_ >> 2, wc = wid_ & 3, fr = tid & 15, fq = (tid & 63) >> 4;
        const int row0 = u.pm * BM + wr * 64 + fr, col0 = u.pn * BM + wc * 32 + 8 * fq;
#pragma unroll
        for (int bj = 0; bj < 2; ++bj) { const int c = col0 + bj * HALF; const f32x4 b0 = *(const f32x4*)(bias + c), b1 = *(const f32x4*)(bias + c + 4);
#pragma unroll
            for (int ai = 0; ai < 2; ++ai)
#pragma unroll
                for (int m = 0; m < 4; ++m) { const size_t row = (size_t)(row0 + ai * HALF + m * 16); f32x4 z0, z1; unpack8(*(const u32x4*)(Z + row * 512 + c), z0, z1);
                    f32x4 v0 = acc[ai][bj][m][0] + b0, v1 = acc[ai][bj][m][1] + b1;
#pragma unroll
                    for (int j = 0; j < 4; ++j) { v0[j] = z0[j] * sigm(v0[j]); v1[j] = z1[j] * sigm(v1[j]); }
                    *(u32x4*)(O + row * OW + 1536 + c) = pack8(v0, v1); } }
    }
};
struct EpiGate {
    static constexpr bool PERM = true, AFTER_DRAIN = false;
    const bf16_t* P; const float* bias; bf16_t* scr; bf16_t* MG;
    __device__ __forceinline__ void operator()(const f32x4 (&acc)[2][2][4][2], const Unit& u, int wr_, int wc_, int fr_, int fq_) const {
        const int tid = OPAQUE_TID, wid_ = __builtin_amdgcn_readfirstlane(tid >> 6), wr = wid_ >> 2, wc = wid_ & 3, fr = tid & 15, fq = (tid & 63) >> 4;
        const int z = u.z, row0 = u.pm * BM + wr * 64 + fr, col0 = (u.pn & 7) * BM + wc * 32 + 8 * fq;
        const GAS char* Pz = uptr(P + (size_t)z * M_TOK * DM + (size_t)(u.pm * BM) * DM); const float* bz = bias + z * DM; GAS char* MGp = (GAS char*)uptr(MG + (size_t)(u.pm * BM) * DM);
        const unsigned voff = (unsigned)((wr * 64 + fr) * DM + col0) * 2u;
#pragma unroll
        for (int bj = 0; bj < 2; ++bj) { const int c = col0 + bj * HALF; const f32x4 b0 = *(const f32x4*)(bz + c), b1 = *(const f32x4*)(bz + c + 4);
#pragma unroll
            for (int qh = 0; qh < 2; ++qh) {
                u32x4 pv[4], sv[4];
#pragma unroll
                for (int qq = 0; qq < 4; ++qq) { const int q = qh * 4 + qq, ai = q >> 2, m = q & 3; pv[qq] = *(const GAS u32x4*)(Pz + voff + (unsigned)((ai * HALF + m * 16) * DM + bj * HALF) * 2u);
                    if (z > 0) sv[qq] = *(const u32x4*)(scr + ((size_t)(q * 2 + bj) * 512 + tid) * 8); }
#pragma unroll
                for (int qq = 0; qq < 4; ++qq) { const int q = qh * 4 + qq, ai = q >> 2, m = q & 3; f32x4 p0, p1; unpack8(pv[qq], p0, p1);
                    f32x4 v0 = acc[ai][bj][m][0] + b0, v1 = acc[ai][bj][m][1] + b1;
#pragma unroll
                    for (int j = 0; j < 4; ++j) { v0[j] = p0[j] * sigm(v0[j]); v1[j] = p1[j] * sigm(v1[j]); }
                    if (z > 0) { f32x4 s0, s1; unpack8(sv[qq], s0, s1); v0 += s0; v1 += s1; }
                    if (z < 3) *(u32x4*)(scr + ((size_t)(q * 2 + bj) * 512 + tid) * 8) = pack8(v0, v1);
                    else *(GAS u32x4*)(MGp + voff + (unsigned)((ai * HALF + m * 16) * DM + bj * HALF) * 2u) = pack8(v0, v1); }
                asm volatile("" ::: "memory");
            }
        }
    }
};
struct EpiSwiglu {
    static constexpr bool PERM = true, AFTER_DRAIN = false;
    bf16_t* Hd;
    __device__ __forceinline__ void operator()(const f32x4 (&acc)[2][2][4][2], const Unit& u, int wr_, int wc_, int fr_, int fq_) const {
        const int tid = OPAQUE_TID, wid_ = __builtin_amdgcn_readfirstlane(tid >> 6), wr = wid_ >> 2, wc = wid_ & 3, fr = tid & 15, fq = (tid & 63) >> 4;
        const int row0 = u.pm * BM + wr * 64 + fr, col0 = u.pn * HALF + wc * 32 + 8 * fq;
#pragma unroll
        for (int ai = 0; ai < 2; ++ai)
#pragma unroll
            for (int m = 0; m < 4; ++m) { f32x4 v0, v1;
#pragma unroll
                for (int j = 0; j < 4; ++j) { const float a0 = acc[ai][0][m][0][j], a1 = acc[ai][0][m][1][j]; v0[j] = a0 * sigm(a0) * acc[ai][1][m][0][j]; v1[j] = a1 * sigm(a1) * acc[ai][1][m][1][j]; }
                *(u32x4*)(Hd + (size_t)(row0 + ai * HALF + m * 16) * FFH + col0) = pack8(v0, v1); }
    }
};
}

struct Args { const float* in[28]; float* out; unsigned char* ws; int ph_lo, ph_hi; };
enum { I_X = 0, I_C, I_ADAW, I_ADAB, I_NORMG, I_WIN, I_RELB, I_DLAM, I_MLCONV, I_MLGB, I_GLAWA2, I_GLABA, I_S5ARE, I_S5AIM, I_S5DT, I_S5BRE, I_S5BIM, I_S5CRE, I_S5CIM, I_S5D, I_GLUW, I_GLUB, I_WBR, I_WGATE, I_BGATE, I_WOUT, I_FFIN, I_FFOUT };

typedef const __attribute__((address_space(4))) unsigned char* kaptr_t;
__device__ __forceinline__ kaptr_t ka_base() { kaptr_t p = (kaptr_t)__builtin_amdgcn_kernarg_segment_ptr(); asm volatile("" : "+s"(p)); return p; }
__device__ __forceinline__ const float* INP(int i) { return *(const float* const __attribute__((address_space(4)))*)(ka_base() + 8 * i); }
__device__ __forceinline__ float* OUTP() { return *(float* const __attribute__((address_space(4)))*)(ka_base() + 224); }
__device__ __forceinline__ unsigned char* WSB() { return *(unsigned char* const __attribute__((address_space(4)))*)(ka_base() + 232); }
static_assert(sizeof(Args) == 248, "Args layout");
template <class RowMap>
__device__ __forceinline__ void conv_item(const float* __restrict__ W, int K, int N, bf16_t* __restrict__ WT, int ldk, int koff, const RowMap& rm, LAS float* scr, int item, int lane) {
    const int nblk = (N + 31) / 32, kb = item / nblk, nb = item % nblk, k0 = 64 * kb, n0 = 32 * nb; const int nn = n0 + (lane & 31); const bool okn = nn < N;
#pragma unroll 8
    for (int i = 0; i < 32; ++i) { const int kk = 2 * i + (lane >> 5); scr[kk * 33 + (lane & 31)] = okn ? W[(size_t)(k0 + kk) * N + nn] : 0.f; }
    asm volatile("s_waitcnt lgkmcnt(0)" ::: "memory");
    const int c = lane & 7;
#pragma unroll
    for (int j = 0; j < 4; ++j) { const int n = (lane >> 3) + 8 * j; const LAS float* s = scr + (8 * c) * 33 + n;
        u32x4 o; o.x = pk2(s[0 * 33], s[1 * 33]); o.y = pk2(s[2 * 33], s[3 * 33]); o.z = pk2(s[4 * 33], s[5 * 33]); o.w = pk2(s[6 * 33], s[7 * 33]);
        if (n0 + n < N) *(u32x4*)(WT + (size_t)rm(n0 + n) * ldk + koff + k0 + 8 * c) = o; }
    asm volatile("s_waitcnt lgkmcnt(0)" ::: "memory");
}
struct RmIdent { int off; __device__ __forceinline__ int operator()(int n) const { return off + n; } };
struct RmWin { __device__ __forceinline__ int operator()(int n) const { return n < 3584 ? n : (n < 3592 ? 5632 + (n - 3584) : (n < 5128 ? n - 8 : (n < 5144 ? 5640 + (n - 5128) : n - 24))); } };
struct RmFfi { __device__ __forceinline__ int operator()(int n) const { const int g = n >= FFH, j = g ? n - FFH : n; return (j >> 7) * 256 + g * 128 + (j & 127); } };

__device__ __forceinline__ void convert_layer(int l, LDSP lds, int wg, int G) {
    const int tid_ = OPAQUE_TID, lane = tid_ & 63, gw = wg * 8 + (tid_ >> 6), NGW = G * 8, gtid = wg * 512 + tid_, NT = G * 512;
    unsigned char* ws = WSB();
    LAS float* scr = (LAS float*)(lds + (tid_ >> 6) * 16384);
    bf16_t* Win = (bf16_t*)(ws + WS_WIN); bf16_t* Wg = (bf16_t*)(ws + WS_WG); bf16_t* Wb = (bf16_t*)(ws + WS_WB); bf16_t* Wo = (bf16_t*)(ws + WS_WOUT); bf16_t* Wfi = (bf16_t*)(ws + WS_WFI); bf16_t* Wfo = (bf16_t*)(ws + WS_WFO); bf16_t* Wglu = (bf16_t*)(ws + WS_WGLU);
    constexpr int I_IN = 32 * 177, I_G1 = 32 * 64, I_G = 4 * I_G1, I_B1 = 8 * 64, I_B = 4 * I_B1, I_O = 32 * 64, I_FI = 32 * 352, I_FO = 88 * 64, I_GL = 8 * 16;
    constexpr int NIT = I_IN + I_G + I_B + I_O + I_FI + I_FO + I_GL;
    for (int it = gw; it < NIT; it += NGW) {
        int r = it;
        if (r < I_IN) { conv_item(INP(I_WIN) + (size_t)l * DM * 5656, DM, 5656, Win, DM, 0, RmWin{}, scr, r, lane); continue; } r -= I_IN;
        if (r < I_G) { const int z = r / I_G1; conv_item(INP(I_WGATE) + ((size_t)l * 4 + z) * DM * DM, DM, DM, Wg, DM, 0, RmIdent{z * DM}, scr, r % I_G1, lane); continue; } r -= I_G;
        if (r < I_B) { const int z = r / I_B1; conv_item(INP(I_WBR) + ((size_t)l * 4 + z) * 512 * DM, 512, DM, Wb, 512, 0, RmIdent{z * DM}, scr, r % I_B1, lane); continue; } r -= I_B;
        if (r < I_O) { conv_item(INP(I_WOUT) + (size_t)l * DM * DM, DM, DM, Wo, DM, 0, RmIdent{0}, scr, r, lane); continue; } r -= I_O;
        if (r < I_FI) { conv_item(INP(I_FFIN) + (size_t)l * DM * 2 * FFH, DM, 2 * FFH, Wfi, DM, 0, RmFfi{}, scr, r, lane); continue; } r -= I_FI;
        if (r < I_FO) { conv_item(INP(I_FFOUT) + (size_t)l * FFH * DM, FFH, DM, Wfo, FFH, 0, RmIdent{0}, scr, r, lane); continue; } r -= I_FO;
        conv_item(INP(I_GLUW) + (size_t)l * 512 * 512, 512, 512, Wglu, 512, 0, RmIdent{0}, scr, r, lane);
    }
    for (int i = gtid; i < 232 * 256; i += NT) ((u32x4*)(Win + (size_t)5656 * DM))[i] = (u32x4){0u, 0u, 0u, 0u};
    if (gtid < 2048) s5_prep_item(gtid, INP(I_S5ARE) + l * 2048, INP(I_S5AIM) + l * 2048, INP(I_S5DT) + l * 32, INP(I_S5BRE) + (size_t)l * 32768, INP(I_S5BIM) + (size_t)l * 32768,
                                  INP(I_S5CRE) + (size_t)l * 32768, INP(I_S5CIM) + (size_t)l * 32768, (float*)(ws + WS_S5T), (bf16_t*)(ws + WS_S5T + 65536), (bf16_t*)(ws + WS_S5T + 65536 + 262144));
}

__device__ __forceinline__ void mod_partials(LDSP lds, int wg, int G) {
    LAS float* cs = (LAS float*)lds;
    const int tid = OPAQUE_TID;
    for (int it = wg; it < KSPLIT * NLAYER * 6; it += G) {
        const int ks = it / (NLAYER * 6), l = (it / 6) % NLAYER, cg = it % 6;
        __syncthreads();
        for (int i = tid; i < BATCH * 256; i += 512) { const int b = i >> 8, k = ks * 256 + (i & 255); const float c = INP(I_C)[b * DM + k]; cs[i] = c * sigmoidf_(c); }
        __syncthreads();
        const float* wp = INP(I_ADAW) + ((size_t)l * DM + ks * 256) * (6 * DM) + cg * DM + 4 * tid;
        f32x4 s[BATCH];
#pragma unroll
        for (int b = 0; b < BATCH; ++b) s[b] = (f32x4){0.f, 0.f, 0.f, 0.f};
#pragma unroll 4
        for (int k = 0; k < 256; ++k) { const f32x4 w = *(const f32x4*)(wp + (size_t)k * (6 * DM));
#pragma unroll
            for (int b = 0; b < BATCH; ++b) s[b] += w * cs[b * 256 + k]; }
        float* mp = (float*)(WSB() + WS_MODP);
#pragma unroll
        for (int b = 0; b < BATCH; ++b) *(f32x4*)(mp + (((size_t)ks * NLAYER + l) * BATCH + b) * (6 * DM) + cg * DM + 4 * tid) = s[b];
    }
}
__device__ __forceinline__ f32x4 mod_vec(int l, int b, int idx, int tid) {
    f32x4 s = *(const f32x4*)(INP(I_ADAB) + (size_t)l * 6 * DM + idx * DM + 4 * tid);
    const float* mp = (const float*)(WSB() + WS_MODP);
#pragma unroll
    for (int ks = 0; ks < KSPLIT; ++ks) s += *(const f32x4*)(mp + (((size_t)ks * NLAYER + l) * BATCH + b) * (6 * DM) + idx * DM + 4 * tid);
    return s;
}
__device__ __forceinline__ void norm_phase(LDSP lds, int wg, int G, const float* xin, float* xout, const bf16_t* ysrc, int l_res, int i_gate, int i_ga, bf16_t* hout, int l_h, int i_scale, int i_shift, int i_gb) {
    LAS f32x4* VA = (LAS f32x4*)lds; LAS f32x4* VB = (LAS f32x4*)(lds + 8192); LAS f32x4* VC = (LAS f32x4*)(lds + 16384);
    const int tid = OPAQUE_TID, lane = tid & 63, wave = tid >> 6;
    for (int chunk = wg; chunk < M_TOK / 128; chunk += G) {
        const int b = (chunk * 128) / SEQ;
        __syncthreads();
        if (ysrc) VA[tid] = mod_vec(l_res, b, i_gate, tid) * *(const f32x4*)(INP(I_NORMG) + ((size_t)l_res * 4 + i_ga) * DM + 4 * tid);
        if (hout) { VB[tid] = (mod_vec(l_h, b, i_scale, tid) + 1.0f) * *(const f32x4*)(INP(I_NORMG) + ((size_t)l_h * 4 + i_gb) * DM + 4 * tid); VC[tid] = mod_vec(l_h, b, i_shift, tid); }
        __syncthreads();
        for (int r = wave; r < 128; r += 8) {
            const size_t row = (size_t)chunk * 128 + r;
            f32x4 x[8];
#pragma unroll
            for (int j = 0; j < 8; ++j) x[j] = *((const f32x4*)(xin + row * DM) + lane + 64 * j);
            if (ysrc) {
                f32x4 y[8]; float ss = 0.f;
#pragma unroll
                for (int j = 0; j < 8; ++j) { const u32x2 w = *((const u32x2*)(ysrc + row * DM) + lane + 64 * j);
                    y[j][0] = __uint_as_float(w.x << 16); y[j][1] = __uint_as_float(w.x & 0xffff0000u); y[j][2] = __uint_as_float(w.y << 16); y[j][3] = __uint_as_float(w.y & 0xffff0000u);
                    ss += (y[j][0] * y[j][0] + y[j][1] * y[j][1]) + (y[j][2] * y[j][2] + y[j][3] * y[j][3]); }
                ss = wave_sum_f(ss); const float rn = 1.0f / sqrtf(ss * (1.0f / DM) + RMS_EPS);
#pragma unroll
                for (int j = 0; j < 8; ++j) { x[j] += y[j] * rn * VA[lane + 64 * j]; *((f32x4*)(xout + row * DM) + lane + 64 * j) = x[j]; }
            }
            if (hout) {
                float ss = 0.f;
#pragma unroll
                for (int j = 0; j < 8; ++j) ss += (x[j][0] * x[j][0] + x[j][1] * x[j][1]) + (x[j][2] * x[j][2] + x[j][3] * x[j][3]);
                ss = wave_sum_f(ss); const float rn = 1.0f / sqrtf(ss * (1.0f / DM) + RMS_EPS);
#pragma unroll
                for (int j = 0; j < 8; ++j) { const f32x4 hv = x[j] * rn * VB[lane + 64 * j] + VC[lane + 64 * j]; u32x2 w; w.x = pk2(hv[0], hv[1]); w.y = pk2(hv[2], hv[3]);
                    *((u32x2*)(hout + row * DM) + lane + 64 * j) = w; }
            }
        }
    }
}

#ifndef MX_ML
#define MX_ML 1
#endif
#ifndef MX_GLA
#define MX_GLA 1
#endif
#ifndef MX_S5
#define MX_S5 1
#endif
#ifndef MX_ATT
#define MX_ATT 1
#endif
#ifndef PH_G1
#define PH_G1 1
#endif
#ifndef PH_MIX
#define PH_MIX 1
#endif
#ifndef PH_G2
#define PH_G2 1
#endif
#ifndef PH_G3
#define PH_G3 1
#endif
#ifndef PH_G4
#define PH_G4 1
#endif
#ifndef PH_G5
#define PH_G5 1
#endif
#ifndef PH_N2
#define PH_N2 1
#endif
#ifndef PH_G6
#define PH_G6 1
#endif
#ifndef PH_G7
#define PH_G7 1
#endif
#ifndef PH_N3
#define PH_N3 1
#endif
__global__ void __launch_bounds__(512, 2) fwd_kernel(Args a) {
    extern __shared__ __attribute__((aligned(16))) unsigned char lds_raw[];
    LDSP lds = (LDSP)lds_raw;
    const int G = gridDim.x, wg = blockIdx.x;
#define ws WSB()
#define ctl ((unsigned*)(WSB() + WS_CTL))
    volatile LAS unsigned* MISC = (volatile LAS unsigned*)(lds + LDS_MISC);
    if (threadIdx.x < 64) MISC[threadIdx.x] = 0u;
    __syncthreads();
    XcdBarrier bar = xcd_barrier_post(ctl + CW_BAR, MISC);
    const int lo = a.ph_lo, hi = a.ph_hi;
    int ph = 0;
#define IN(k) (lo <= (k) && (k) < hi)
#define SEAM(k) do { if (IN(k) && IN((k) + 1)) xcd_barrier(bar); } while (0)
#define Hb ((bf16_t*)(ws + WS_H))
#define PROJ ((bf16_t*)(ws + WS_PROJ))
#define NAR ((float*)(ws + WS_NAR))
#define OALL ((bf16_t*)(ws + WS_OALL))
#define Zb ((bf16_t*)(ws + WS_Z))
#define Pb ((bf16_t*)(ws + WS_P))
#define MG ((bf16_t*)(ws + WS_MERGED))
#define MIXB ((bf16_t*)(ws + WS_MIXB))
#define Yb ((bf16_t*)(ws + WS_Y))
#define HID ((bf16_t*)(ws + WS_HID))

    if (IN(ph)) { mod_partials(lds, wg, G); __syncthreads(); convert_layer(0, lds, wg, G); }
    SEAM(ph); ++ph;
    if (IN(ph)) norm_phase(lds, wg, G, INP(I_X), nullptr, nullptr, 0, 0, 0, Hb, 0, 1, 0, 0);
    SEAM(ph); ++ph;

    for (int l = 0; l < NLAYER; ++l) {
        if (IN(ph) && PH_G1) { pg8::Gemm g{Hb, (const bf16_t*)(ws + WS_WIN), DM, DM, DM}; pg8::SchedPlain S{NMT, NPROJ / 256, G, wg}; pg8::EpiProj E{PROJ, NAR};
            pg8::gemm_phase<pg8::EpiProj, pg8::SchedPlain, true, true>((PG8_LAS unsigned char*)lds, g, S, E); }
        SEAM(ph); ++ph;
        if (IN(ph) && PH_MIX) {
            const int tid = OPAQUE_TID, lane = tid & 63, wave = __builtin_amdgcn_readfirstlane(tid >> 6);
            LAS float* biasT = (LAS float*)(lds + LDS_BIAS);
            if (tid < 512) { const int h = tid >> 7, d = tid & 127; biasT[tid] = INP(I_RELB)[T5_BUCKET[d] * 4 + h] * LOG2E; }
            const float* dl = INP(I_DLAM) + l * 256;
            const float s1 = wave_sum_f(dl[lane] * dl[64 + lane]), s2 = wave_sum_f(dl[128 + lane] * dl[192 + lane]);
            const float lam_init = 0.8f - 0.6f * __expf(-0.3f * (float)l), lam = __expf(s1) - __expf(s2) + lam_init;
            __syncthreads();
            if (MX_ML && wg < 16) mlstm_item(lds, PROJ, NAR, INP(I_MLCONV) + l * 4096, INP(I_MLGB) + l * 8, OALL, wg >> 2, wg & 3);
            else if (MX_GLA && wg < 32) gla_item(lds, PROJ, NAR, INP(I_GLAWA2) + l * 4096, INP(I_GLABA) + l * 256, OALL, (wg - 16) >> 2, (wg - 16) & 3);
            else if (MX_S5 && wg < 48) { const int pair = (wg - 32) * 8 + wave; s5_wave(lds + wave * S5_WAVE_LDS, PROJ, (const float*)(ws + WS_S5T), (const bf16_t*)(ws + WS_S5T + 65536), (const bf16_t*)(ws + WS_S5T + 65536 + 262144),
                                                                         INP(I_S5D) + l * 512, Zb, pair >> 5, pair & 31); }
            __syncthreads();
            for (;;) {
                if (tid == 0) MISC[16] = __hip_atomic_fetch_add(ctl + CW_Q + 64 * l, 1u, __ATOMIC_RELAXED, __HIP_MEMORY_SCOPE_AGENT);
                __syncthreads();
                const unsigned item = MISC[16];
                if (item >= (unsigned)(BATCH * 4 * (SEQ / 128))) break;
                const int qb = (SEQ / 128 - 1) - (int)(item / (BATCH * 4)), bh = (int)(item % (BATCH * 4));
                if (MX_ATT) attn_unit(lds, biasT, PROJ, OALL, lam, lam_init, bh >> 2, bh & 3, qb);
            }
        }
        SEAM(ph); ++ph;
        if (IN(ph) && PH_G2) { pg8::Gemm g{Zb, (const bf16_t*)(ws + WS_WGLU), 512, 512, 512}; pg8::SchedPlain S{NMT, 2, G, wg}; pg8::EpiGlu E{Zb, INP(I_GLUB) + l * 512, OALL};
            pg8::gemm_phase<pg8::EpiGlu, pg8::SchedPlain, true, true>((PG8_LAS unsigned char*)lds, g, S, E); }
        SEAM(ph); ++ph;
        if (IN(ph) && PH_G3) { pg8::Gemm g{OALL, (const bf16_t*)(ws + WS_WB), 512, DM, 512}; pg8::SchedP S{NMT, G, wg}; pg8::EpiPlain E{Pb, DM, 7, (size_t)M_TOK * DM};
            pg8::gemm_phase<pg8::EpiPlain, pg8::SchedP, true, true>((PG8_LAS unsigned char*)lds, g, S, E); }
        SEAM(ph); ++ph;
        if (IN(ph) && PH_G4) { pg8::Gemm g{Hb, (const bf16_t*)(ws + WS_WG), DM, DM, DM}; pg8::SchedGate S{NMT, G, wg}; pg8::EpiGate E{Pb, INP(I_BGATE) + (size_t)l * 4 * DM, (bf16_t*)(ws + WS_GSCR) + (size_t)wg * 65536, MG};
            pg8::gemm_phase<pg8::EpiGate, pg8::SchedGate, true, true>((PG8_LAS unsigned char*)lds, g, S, E); }
        SEAM(ph); ++ph;
        if (IN(ph) && PH_G5) { pg8::Gemm g{MG, (const bf16_t*)(ws + WS_WOUT), DM, DM, DM}; pg8::SchedPlain S{NMT, 8, G, wg}; pg8::EpiPlain E{MIXB, DM, 0xffff, 0};
            pg8::gemm_phase<pg8::EpiPlain, pg8::SchedPlain, true, true>((PG8_LAS unsigned char*)lds, g, S, E); }
        SEAM(ph); ++ph;
        if (IN(ph) && PH_N2) norm_phase(lds, wg, G, l == 0 ? INP(I_X) : OUTP(), OUTP(), MIXB, l, 2, 1, Hb, l, 4, 3, 2);
        SEAM(ph); ++ph;
        if (IN(ph) && PH_G6) { pg8::Gemm g{Hb, (const bf16_t*)(ws + WS_WFI), DM, DM, DM}; pg8::SchedPlain S{NMT, 2 * FFH / 256, G, wg}; pg8::EpiSwiglu E{HID};
            pg8::gemm_phase<pg8::EpiSwiglu, pg8::SchedPlain, true, true>((PG8_LAS unsigned char*)lds, g, S, E); }
        SEAM(ph); ++ph;
        if (IN(ph) && PH_G7) { pg8::Gemm g{HID, (const bf16_t*)(ws + WS_WFO), FFH, FFH, FFH}; pg8::SchedPlain S{NMT, 8, G, wg}; pg8::EpiPlain E{Yb, DM, 0xffff, 0};
            pg8::gemm_phase<pg8::EpiPlain, pg8::SchedPlain, true, true>((PG8_LAS unsigned char*)lds, g, S, E); }
        SEAM(ph); ++ph;
        if (IN(ph) && PH_N3) { norm_phase(lds, wg, G, OUTP(), OUTP(), Yb, l, 5, 3, (l + 1 < NLAYER) ? Hb : nullptr, l + 1, 1, 0, 0);
            if (l + 1 < NLAYER) { __syncthreads(); convert_layer(l + 1, lds, wg, G); } }
        SEAM(ph); ++ph;
    }
#undef IN
#undef SEAM
#undef ws
#undef ctl
#undef Hb
#undef PROJ
#undef NAR
#undef OALL
#undef Zb
#undef Pb
#undef MG
#undef MIXB
#undef Yb
#undef HID
}

#ifndef ONE_LAUNCH
#define ONE_LAUNCH 1
#endif
extern "C" void kernel_launch(void* const* d_in, const int* in_sizes, int n_in, void* d_out, int out_size, void* d_ws, size_t ws_size, hipStream_t stream) {
    static int grid = 0;
    if (grid == 0) {
        if (n_in != 28 || in_sizes[0] != M_TOK * DM || out_size != M_TOK * DM || ws_size < WS_END) { fprintf(stderr, "kernel_launch: unexpected shapes/workspace (n_in %d, ws %zu < %zu)\n", n_in, ws_size, (size_t)WS_END); grid = -1; return; }
        int dev = 0, cus = 0, per_cu = 0;
        if (hipGetDevice(&dev) != hipSuccess || hipDeviceGetAttribute(&cus, hipDeviceAttributeMultiprocessorCount, dev) != hipSuccess) { grid = -1; return; }
        if (hipFuncSetAttribute((const void*)fwd_kernel, hipFuncAttributeMaxDynamicSharedMemorySize, LDS_BYTES) != hipSuccess) { fprintf(stderr, "kernel_launch: hipFuncSetAttribute failed\n"); grid = -1; return; }
        if (hipOccupancyMaxActiveBlocksPerMultiprocessor(&per_cu, (const void*)fwd_kernel, 512, LDS_BYTES) != hipSuccess || per_cu < 1) fprintf(stderr, "kernel_launch: occupancy query says %d\n", per_cu);
        (void)hipGetLastError();
        grid = cus;
        if (grid > 256) grid = 256;
    }
    if (grid < 0) return;
    if (hipMemsetAsync((char*)d_ws + WS_CTL, 0, CTL_ZERO_BYTES, stream) != hipSuccess) return;
    Args a{};
    for (int i = 0; i < 28; ++i) a.in[i] = (const float*)d_in[i];
    a.out = (float*)d_out; a.ws = (unsigned char*)d_ws;
#if ONE_LAUNCH
    a.ph_lo = 0; a.ph_hi = N_PHASES;
    hipLaunchKernelGGL(fwd_kernel, dim3(grid), dim3(512), LDS_BYTES, stream, a);
#else
    for (int p = 0; p < N_PHASES; ++p) { a.ph_lo = p; a.ph_hi = p + 1; hipLaunchKernelGGL(fwd_kernel, dim3(grid), dim3(512), LDS_BYTES, stream, a); }
#endif
}
```

```cpp
#define ONE_LAUNCH 1
#include <hip/hip_runtime.h>
#include <cstdio>
#include <cstdint>
typedef unsigned short bf16_t;
typedef short bf16x8 __attribute__((ext_vector_type(8)));
typedef short s16x4 __attribute__((ext_vector_type(4)));
typedef float f32x4 __attribute__((ext_vector_type(4)));
typedef float f32x16 __attribute__((ext_vector_type(16)));
typedef unsigned u32x4 __attribute__((ext_vector_type(4)));
typedef unsigned u32x2 __attribute__((ext_vector_type(2)));

#ifdef HOST_EMU
#include <cmath>
#include <cstring>
#include <cstdint>
#include <pthread.h>
#define LAS
#define GAS
#define DEV static inline
#define GLOBAL_FN
struct EmuWave { pthread_barrier_t bar; float fa[64][8], fb[64][8]; uintptr_t addr[64]; float v[64]; };
struct EmuBlock { pthread_barrier_t bar; EmuWave wv[8]; };
extern EmuBlock* g_blk;
extern thread_local int emu_tid;
extern thread_local int emu_bid;
#define THREAD_IDX emu_tid
#define OPAQUE_TID emu_tid
DEV int opq(int x) { return x; }
#define BLOCK_IDX emu_bid
DEV void sync_threads() { pthread_barrier_wait(&g_blk->bar); }
DEV void wave_bar() { pthread_barrier_wait(&g_blk->wv[emu_tid >> 6].bar); }
DEV float bf2f(bf16_t b) { unsigned u = (unsigned)b << 16; float f; memcpy(&f, &u, 4); return f; }
DEV bf16_t f2bf(float f) { unsigned u; memcpy(&u, &f, 4); return (bf16_t)((u + 0x7fffu + ((u >> 16) & 1u)) >> 16); }
DEV f32x16 mfma32(bf16x8 a, bf16x8 b, f32x16 c) {
  EmuWave& w = g_blk->wv[emu_tid >> 6]; const int l = emu_tid & 63;
  for (int j = 0; j < 8; ++j) { w.fa[l][j] = bf2f((bf16_t)a[j]); w.fb[l][j] = bf2f((bf16_t)b[j]); }
  wave_bar();
  const int col = l & 31, hi = l >> 5;
  for (int i = 0; i < 16; ++i) { const int row = (i & 3) + 8 * (i >> 2) + 4 * hi; float s = c[i];
    for (int k = 0; k < 16; ++k) s += w.fa[row + 32 * (k >> 3)][k & 7] * w.fb[col + 32 * (k >> 3)][k & 7];
    c[i] = s; }
  wave_bar();
  return c;
}
DEV f32x4 mfma16(bf16x8 a, bf16x8 b, f32x4 c) {
  EmuWave& w = g_blk->wv[emu_tid >> 6]; const int l = emu_tid & 63;
  for (int j = 0; j < 8; ++j) { w.fa[l][j] = bf2f((bf16_t)a[j]); w.fb[l][j] = bf2f((bf16_t)b[j]); }
  wave_bar();
  const int col = l & 15, g = l >> 4;
  for (int i = 0; i < 4; ++i) { const int row = 4 * g + i; float s = c[i];
    for (int k = 0; k < 32; ++k) s += w.fa[row + 16 * (k >> 3)][k & 7] * w.fb[col + 16 * (k >> 3)][k & 7];
    c[i] = s; }
  wave_bar();
  return c;
}
DEV s16x4 lds_tr(const char* p) {
  EmuWave& w = g_blk->wv[emu_tid >> 6]; const int l = emu_tid & 63;
  w.addr[l] = (uintptr_t)p; wave_bar();
  const int g = l >> 4, i = l & 15; s16x4 r;
  for (int q = 0; q < 4; ++q) { const char* src = (const char*)w.addr[16 * g + 4 * q + (i >> 2)] + 2 * (i & 3); short s; memcpy(&s, src, 2); r[q] = s; }
  wave_bar();
  return r;
}
DEV float shfl_xor_f(float v, int m) { EmuWave& w = g_blk->wv[emu_tid >> 6]; const int l = emu_tid & 63; w.v[l] = v; wave_bar(); float r = w.v[l ^ m]; wave_bar(); return r; }
DEV float shfl_up_f(float v, int d) { EmuWave& w = g_blk->wv[emu_tid >> 6]; const int l = emu_tid & 63; w.v[l] = v; wave_bar(); float r = (l >= d) ? w.v[l - d] : v; wave_bar(); return r; }
DEV float shfl_idx_f(float v, int s) { EmuWave& w = g_blk->wv[emu_tid >> 6]; const int l = emu_tid & 63; w.v[l] = v; wave_bar(); float r = w.v[s]; wave_bar(); return r; }
DEV float fast_exp2(float x) { return exp2f(x); }
DEV float fast_rcp(float x) { return 1.0f / x; }
DEV float fast_rsq(float x) { return 1.0f / sqrtf(x); }
DEV int rfl(int x) { return x; }
DEV void wave_sync() { wave_bar(); }
DEV void sched_fence() {}
DEV const char* uptr(const void* q) { return (const char*)q; }
#define __expf expf
#else
#include <hip/hip_runtime.h>
#define LAS __attribute__((address_space(3)))
#define GAS __attribute__((address_space(1)))
#define DEV __device__ __forceinline__
#define THREAD_IDX ((int)threadIdx.x)
DEV int opaque_tid_() { int t = (int)threadIdx.x; asm volatile("" : "+v"(t)); return t; }
#define OPAQUE_TID opaque_tid_()
DEV int opq(int x) { asm volatile("" : "+v"(x)); return x; }
#define BLOCK_IDX ((int)blockIdx.x)
DEV void sync_threads() { __syncthreads(); }
DEV float bf2f(bf16_t b) { return __uint_as_float((unsigned)b << 16); }
DEV bf16_t f2bf(float f) { unsigned u = __float_as_uint(f); return (bf16_t)((u + 0x7fffu + ((u >> 16) & 1u)) >> 16); }
DEV f32x16 mfma32(bf16x8 a, bf16x8 b, f32x16 c) { return __builtin_amdgcn_mfma_f32_32x32x16_bf16(a, b, c, 0, 0, 0); }
DEV f32x4 mfma16(bf16x8 a, bf16x8 b, f32x4 c) { return __builtin_amdgcn_mfma_f32_16x16x32_bf16(a, b, c, 0, 0, 0); }
typedef short v4i16_t __attribute__((ext_vector_type(4)));
DEV s16x4 lds_tr(const LAS char* p) { return __builtin_bit_cast(s16x4, __builtin_amdgcn_ds_read_tr16_b64_v4i16((LAS v4i16_t*)p)); }
DEV float shfl_xor_f(float v, int m) { return __shfl_xor(v, m); }
DEV float shfl_up_f(float v, int d) { return __shfl_up(v, d); }
DEV float shfl_idx_f(float v, int s) { return __shfl(v, s); }
DEV float fast_exp2(float x) { return __builtin_amdgcn_exp2f(x); }
DEV float fast_rcp(float x) { return __builtin_amdgcn_rcpf(x); }
DEV float fast_rsq(float x) { return __builtin_amdgcn_rsqf(x); }
DEV int rfl(int x) { return __builtin_amdgcn_readfirstlane(x); }
DEV void wave_sync() { asm volatile("s_waitcnt lgkmcnt(0)" ::: "memory"); }
DEV void sched_fence() { __builtin_amdgcn_sched_barrier(0); }
DEV const GAS char* uptr(const void* q) { const unsigned long long v = (unsigned long long)q; const unsigned lo = __builtin_amdgcn_readfirstlane((unsigned)v), hi = __builtin_amdgcn_readfirstlane((unsigned)(v >> 32)); return (const GAS char*)(((unsigned long long)hi << 32) | lo); }
#endif
typedef LAS char* LDSP;
DEV unsigned pk2(float lo, float hi) { return (unsigned)f2bf(lo) | ((unsigned)f2bf(hi) << 16); }
DEV int crow(int i, int hi) { return (i & 3) + 8 * (i >> 2) + 4 * hi; }
DEV unsigned offb(unsigned row, unsigned ch) { return 256u * row + 16u * (ch ^ (((row & 3u) << 2) | ((row >> 2) & 3u))); }
DEV bf16x8 lds_ld8(LDSP p) { return *(const LAS bf16x8*)p; }
DEV bf16x8 frag_row(LDSP tile, int rb, int ks, int lane) { return lds_ld8(tile + offb(rb + (lane & 31), 2 * ks + (lane >> 5))); }
DEV bf16x8 frag_tr(LDSP tile, int cb, int ks, int lane, bool perm) {
  const int h2 = lane >> 5, blk = (lane >> 4) & 1, q = (lane & 15) >> 2, p = lane & 3;
  const int r0 = perm ? (16 * ks + 4 * h2) : (16 * ks + 8 * h2), dr = perm ? 8 : 4;
  const unsigned ch = 4 * cb + 2 * blk + (p >> 1), bo = 8 * (p & 1);
  const s16x4 a = lds_tr(tile + offb(r0 + q, ch) + bo), b = lds_tr(tile + offb(r0 + dr + q, ch) + bo);
  return (bf16x8){a[0], a[1], a[2], a[3], b[0], b[1], b[2], b[3]};
}
DEV bf16x8 acc_frag(const f32x16& x, int s) {
  u32x4 w; w.x = pk2(x[8 * s + 0], x[8 * s + 1]); w.y = pk2(x[8 * s + 2], x[8 * s + 3]); w.z = pk2(x[8 * s + 4], x[8 * s + 5]); w.w = pk2(x[8 * s + 6], x[8 * s + 7]);
  return __builtin_bit_cast(bf16x8, w);
}
#ifndef SEQ
#define SEQ 8192
#endif
#ifndef BATCH
#define BATCH 4
#endif
constexpr int M_TOK = BATCH * SEQ, PW = 5632, OW = 2048, NCH = SEQ / 64;
constexpr int C_DAQ = 0, C_DAK = 512, C_DAV = 1024, C_MLQ = 1536, C_MLK = 2048, C_MLV = 2560, C_MLO = 3072, C_GLQ = 3584, C_GLK = 3840, C_GLV = 4096, C_GLR = 4608, C_S5U = 5120;
constexpr int NW_MLI = 0, NW_MLF = 4, NW_GLA = 8, NWP = 32;
constexpr float LOG2E = 1.4426950408889634f, RMS_EPS = 1e-6f;
#define NEG_INF (-__builtin_inff())

DEV float sigmoidf_(float x) { return fast_rcp(1.0f + fast_exp2(-x * LOG2E)); }
DEV float log_sigmoidf_(float x) {
  const float ax = x < 0.f ? -x : x; return (x < 0.f ? x : 0.f) - log1pf(__expf(-ax)); }
DEV float wave_sum_f(float v) { for (int o = 1; o < 64; o <<= 1) v += shfl_xor_f(v, o); return v; }

DEV void attn_unit(LDSP lds, const LAS float* biasT, const bf16_t* __restrict__ proj, bf16_t* __restrict__ oall, float lam, float lam_init, int b, int h, int qb) {
  const int tid = OPAQUE_TID, lane = tid & 63, wave = rfl(tid >> 6), l31 = lane & 31, h2 = lane >> 5;
  const int mp = wave >> 2, wq = wave & 3, q0 = qb * 128, r0 = q0 + 32 * wq;
  const size_t rowbase = (size_t)b * SEQ;
  bf16x8 qf[4];
  { const bf16_t* qp = proj + (rowbase + r0 + l31) * PW + C_DAQ + h * 128 + mp * 64 + 8 * h2;
#pragma unroll
    for (int ks = 0; ks < 4; ++ks) qf[ks] = *(const bf16x8*)(qp + 16 * ks); }
  f32x16 o[4];
#pragma unroll
  for (int c = 0; c < 4; ++c)
#pragma unroll
    for (int i = 0; i < 16; ++i) o[c][i] = 0.f;
  float mrun = NEG_INF, lpart = 0.f;
  const int nt = 2 * qb + 2, tlast = (r0 + 31) >> 6;
  const float scale2 = 0.125f * LOG2E;
  const LAS float* bt = biasT + h * 128;
  u32x4 rk[2], rv[2];
  const bf16_t* gk = proj + rowbase * PW + C_DAK + h * 128; const bf16_t* gv = proj + rowbase * PW + C_DAV + h * 128;
#define ATT_LOAD(t) do { _Pragma("unroll") for (int i = 0; i < 2; ++i) { const int id = tid + 512 * i, row = id >> 4, ch = id & 15; \
    rk[i] = *(const u32x4*)(gk + (size_t)(64 * (t) + row) * PW + ch * 8); rv[i] = *(const u32x4*)(gv + (size_t)(64 * (t) + row) * PW + ch * 8); } } while (0)
#define ATT_STORE(buf) do { _Pragma("unroll") for (int i = 0; i < 2; ++i) { const int id = tid + 512 * i, row = id >> 4, ch = id & 15; \
    *(LAS u32x4*)(lds + (buf) * 16384 + offb(row, ch)) = rk[i]; *(LAS u32x4*)(lds + 32768 + (buf) * 16384 + offb(row, ch)) = rv[i]; } } while (0)
  ATT_LOAD(0); ATT_STORE(0); sync_threads();
  for (int t = 0; t < nt; ++t) {
    if (t + 1 < nt) ATT_LOAD(t + 1);
    if (t <= tlast) {
      LDSP Kt = lds + (t & 1) * 16384, Vt = lds + 32768 + (t & 1) * 16384;
      f32x16 p[2];
#pragma unroll
      for (int kb = 0; kb < 2; ++kb) {
#pragma unroll
        for (int i = 0; i < 16; ++i) p[kb][i] = 0.f;
#pragma unroll
        for (int ks = 0; ks < 4; ++ks) p[kb] = mfma32(frag_row(Kt, 32 * kb, 4 * mp + ks, lane), qf[ks], p[kb]);
      }
      const int qabs = r0 + l31, j0 = 64 * t;
      const bool far = (r0 - (j0 + 63)) >= 127;
      const float bfar = bt[127];
      float mx = NEG_INF;
#pragma unroll
      for (int kb = 0; kb < 2; ++kb)
#pragma unroll
        for (int i = 0; i < 16; ++i) {
          const int dist = qabs - (j0 + 32 * kb + crow(i, h2));
          float bv = bfar; if (!far) bv = bt[dist < 0 ? 0 : (dist > 127 ? 127 : dist)];
          float s = p[kb][i] * scale2 + bv; if (dist < 0) s = NEG_INF;
          p[kb][i] = s; mx = fmaxf(mx, s);
        }
      mx = fmaxf(mx, shfl_xor_f(mx, 32));
      const float mnew = fmaxf(mrun, mx), alpha = fast_exp2(mrun - mnew);
      mrun = mnew;
      float rs = 0.f;
#pragma unroll
      for (int kb = 0; kb < 2; ++kb)
#pragma unroll
        for (int i = 0; i < 16; ++i) { const float e = fast_exp2(p[kb][i] - mnew); p[kb][i] = e; rs += e; }
      lpart = lpart * alpha + rs;
#pragma unroll
      for (int c = 0; c < 4; ++c)
#pragma unroll
        for (int i = 0; i < 16; ++i) o[c][i] *= alpha;
#pragma unroll
      for (int ks = 0; ks < 4; ++ks) {
        const bf16x8 pf = acc_frag(p[ks >> 1], ks & 1);
#pragma unroll
        for (int c = 0; c < 4; ++c) o[c] = mfma32(frag_tr(Vt, c, ks, lane, true), pf, o[c]);
      }
    }
    if (t + 1 < nt) ATT_STORE((t + 1) & 1);
    sync_threads();
  }
#undef ATT_LOAD
#undef ATT_STORE
  { const float ltot = lpart + shfl_xor_f(lpart, 32), inv = 1.0f / ltot;
#pragma unroll
    for (int c = 0; c < 4; ++c)
#pragma unroll
      for (int i = 0; i < 16; ++i) o[c][i] *= inv; }
  LAS float* X = (LAS float*)lds;
  if (mp == 1) {
#pragma unroll
    for (int c = 0; c < 4; ++c)
#pragma unroll
      for (int i = 0; i < 16; ++i) X[((wq * 4 + c) * 16 + i) * 64 + lane] = o[c][i];
  }
  sync_threads();
  if (mp == 0) {
    float ss = 0.f;
#pragma unroll
    for (int c = 0; c < 4; ++c)
#pragma unroll
      for (int i = 0; i < 16; ++i) { const float d = o[c][i] - lam * X[((wq * 4 + c) * 16 + i) * 64 + lane]; o[c][i] = d; ss += d * d; }
    ss += shfl_xor_f(ss, 32);
    const float r = (1.0f - lam_init) / sqrtf(ss * (1.0f / 128.0f) + RMS_EPS);
    bf16_t* op = oall + (rowbase + r0 + l31) * OW + 0 + h * 128 + 4 * h2;
#pragma unroll
    for (int c = 0; c < 4; ++c)
#pragma unroll
      for (int g = 0; g < 4; ++g) { u32x2 w; w.x = pk2(o[c][4 * g] * r, o[c][4 * g + 1] * r); w.y = pk2(o[c][4 * g + 2] * r, o[c][4 * g + 3] * r);
        *(u32x2*)(op + 32 * c + 8 * g) = w; }
  }
  sync_threads();
}

DEV void mlstm_item(LDSP lds, const bf16_t* __restrict__ proj, const float* __restrict__ narrow, const float* __restrict__ convw  , const float* __restrict__ gateb  ,
                    bf16_t* __restrict__ oall, int b, int h) {
  const int tid0 = OPAQUE_TID, wave = rfl(tid0 >> 6);
#define ML_LANES() const int tid = opq(tid0), lane = tid & 63, l31 = lane & 31, h2 = lane >> 5; (void)l31; (void)h2; (void)lane
  LDSP Qt = lds, Kt = lds + 16384, Vt = lds + 32768, KWt = lds + 49152, Ct = lds + 65536;
  LAS float* F = (LAS float*)(lds + 106496);
  LAS float *U = F, *Mv = F + 64, *AT = F + 128, *EM = F + 192, *WJ = F + 256, *QN = F + 320, *SC = F + 384, *NV = F + 392, *CW = F + 520;
  const size_t rowbase = (size_t)b * SEQ;
  { ML_LANES();
    for (int i = tid; i < 40960 / 4; i += 512) ((LAS unsigned*)Ct)[i] = 0u;
    if (tid < 128) NV[tid] = 0.f;
    for (int i = tid; i < 1024; i += 512) { const int j = i >> 8, r = i & 255; CW[i] = convw[j * 1024 + (r >> 7) * 512 + h * 128 + (r & 127)]; }
  }
  const float gb0 = gateb[h], gb1 = gateb[4 + h];
  f32x16 cst[2];
#pragma unroll
  for (int x = 0; x < 2; ++x)
#pragma unroll
    for (int i = 0; i < 16; ++i) cst[x][i] = 0.f;
  float mprev = 0.f;
  const int eb = wave & 3, tb = wave >> 2;
  sync_threads();
  for (int ch = 0; ch < NCH; ++ch) {
    const size_t t0 = rowbase + (size_t)ch * 64;
    const GAS char* pbase = uptr(proj + (t0 - 3) * PW);
    { ML_LANES();
      if (tid < 256) {
        const int which = (tid >> 7) & 1, dch = tid & 15, tg = (tid & 127) >> 4;
        const int colbase = (which ? C_MLK : C_MLQ) + h * 128 + dch * 8;
        float cw[4][8];
#pragma unroll
        for (int j = 0; j < 4; ++j) { const f32x4 a = *(const LAS f32x4*)(CW + j * 256 + which * 128 + dch * 8), c = *(const LAS f32x4*)(CW + j * 256 + which * 128 + dch * 8 + 4);
          cw[j][0] = a[0]; cw[j][1] = a[1]; cw[j][2] = a[2]; cw[j][3] = a[3]; cw[j][4] = c[0]; cw[j][5] = c[1]; cw[j][6] = c[2]; cw[j][7] = c[3]; }
        float win[3][8];
        unsigned voff = (unsigned)((tg * 8) * PW + colbase) * 2u;
#pragma unroll
        for (int r = 0; r < 3; ++r) { const int tt = ch * 64 + tg * 8 - 3 + r; bf16x8 v = (bf16x8){0, 0, 0, 0, 0, 0, 0, 0};
          if (tt >= 0) v = *(const GAS bf16x8*)(pbase + voff);
          voff += PW * 2;
#pragma unroll
          for (int d = 0; d < 8; ++d) win[r][d] = bf2f((bf16_t)v[d]); }
        const float osc = which ? 0.08838834764831845f : 1.0f;
        LDSP dstT = which ? Kt : Qt;
#pragma unroll 2
        for (int r = 0; r < 8; ++r) {
          const bf16x8 v = *(const GAS bf16x8*)(pbase + voff);
          voff += PW * 2;
          float cur[8], y[8];
#pragma unroll
          for (int d = 0; d < 8; ++d) { cur[d] = bf2f((bf16_t)v[d]); const float a = cw[0][d] * win[0][d] + cw[1][d] * win[1][d] + cw[2][d] * win[2][d] + cw[3][d] * cur[d];
            y[d] = a * sigmoidf_(a) * osc; win[0][d] = win[1][d]; win[1][d] = win[2][d]; win[2][d] = cur[d]; }
          u32x4 w; w.x = pk2(y[0], y[1]); w.y = pk2(y[2], y[3]); w.z = pk2(y[4], y[5]); w.w = pk2(y[6], y[7]);
          *(LAS u32x4*)(dstT + offb(tg * 8 + r, dch)) = w;
        }
      } else {
        const int t2 = tid - 256;
#pragma unroll
        for (int i = 0; i < 4; ++i) { const int id = t2 + 256 * i, row = id >> 4, c16 = id & 15;
          *(LAS u32x4*)(Vt + offb(row, c16)) = *(const GAS u32x4*)(pbase + (unsigned)((row + 3) * PW + C_MLV + h * 128 + c16 * 8) * 2u); }
      }
      if (wave == 0) {
        const GAS char* nb = uptr(narrow + t0 * NWP);
        const float ig = *(const GAS float*)(nb + (unsigned)(lane * NWP + NW_MLI + h) * 4u) + gb0;
        const float lf = log_sigmoidf_(*(const GAS float*)(nb + (unsigned)(lane * NWP + NW_MLF + h) * 4u) + gb1);
        float bsum = lf;
#pragma unroll
        for (int d = 1; d < 64; d <<= 1) { const float o_ = shfl_up_f(bsum, d); if (lane >= d) bsum += o_; }
        const float u = ig - bsum; float pm = u;
#pragma unroll
        for (int d = 1; d < 64; d <<= 1) { const float o_ = shfl_up_f(pm, d); if (lane >= d) pm = fmaxf(pm, o_); }
        const float Mt = fmaxf(mprev, pm);
        const float Mlast = shfl_idx_f(Mt, 63), blast = shfl_idx_f(bsum, 63);
        U[lane] = u; Mv[lane] = Mt; AT[lane] = __expf(mprev - Mt); EM[lane] = __expf(-(bsum + Mt)); WJ[lane] = __expf(u - Mlast);
        if (lane == 0) SC[0] = __expf(mprev - Mlast);
        mprev = blast + Mlast;
      }
    }
    sync_threads();
    { ML_LANES();
#pragma unroll
      for (int i = 0; i < 2; ++i) { const int id = tid + 512 * i, row = id >> 4, c16 = id & 15; const float wj = WJ[row];
        const bf16x8 v = lds_ld8(Kt + offb(row, c16)); u32x4 w;
        w.x = pk2(bf2f((bf16_t)v[0]) * wj, bf2f((bf16_t)v[1]) * wj); w.y = pk2(bf2f((bf16_t)v[2]) * wj, bf2f((bf16_t)v[3]) * wj);
        w.z = pk2(bf2f((bf16_t)v[4]) * wj, bf2f((bf16_t)v[5]) * wj); w.w = pk2(bf2f((bf16_t)v[6]) * wj, bf2f((bf16_t)v[7]) * wj);
        *(LAS u32x4*)(KWt + offb(row, c16)) = w; }
    }
    sync_threads();
    if (eb == 0) {
      ML_LANES();
      f32x16 qn;
#pragma unroll
      for (int i = 0; i < 16; ++i) qn[i] = 0.f;
#pragma unroll
      for (int ks = 0; ks < 8; ++ks) qn = mfma32(frag_row(Ct, 128, ks, lane), frag_row(Qt, 32 * tb, ks, lane), qn);
      if (h2 == 0) QN[32 * tb + l31] = qn[0];
    }
    f32x16 acc;
    { ML_LANES();
#pragma unroll
      for (int i = 0; i < 16; ++i) acc[i] = 0.f;
#pragma unroll
      for (int ks = 0; ks < 8; ++ks) acc = mfma32(frag_row(Ct, 32 * eb, ks, lane), frag_row(Qt, 32 * tb, ks, lane), acc);
    }
    float rsum = 0.f;
#pragma unroll
    for (int jb = 0; jb < 2; ++jb) {
      if (jb <= tb) {
        ML_LANES();
        const int tl = 32 * tb + l31; const float Mt = Mv[tl];
        if (jb == 0) { const float at = AT[tl];
#pragma unroll
          for (int i = 0; i < 16; ++i) acc[i] *= at; }
        f32x16 s;
#pragma unroll
        for (int i = 0; i < 16; ++i) s[i] = 0.f;
#pragma unroll
        for (int ks = 0; ks < 8; ++ks) s = mfma32(frag_row(Kt, 32 * jb, ks, lane), frag_row(Qt, 32 * tb, ks, lane), s);
#pragma unroll
        for (int i = 0; i < 16; ++i) { const int j = 32 * jb + crow(i, h2); const float w = (j <= tl) ? __expf(U[j] - Mt) : 0.f; s[i] *= w; rsum += s[i]; }
#pragma unroll
        for (int s2 = 0; s2 < 2; ++s2) acc = mfma32(frag_tr(Vt, eb, 2 * jb + s2, lane, true), acc_frag(s, s2), acc);
      }
    }
    rsum += shfl_xor_f(rsum, 32);
    sync_threads();
    { ML_LANES();
      const int tl = 32 * tb + l31;
      const float den = AT[tl] * QN[tl] + rsum; const float dd = fmaxf(fabsf(den), EM[tl]); const float inv = 1.0f / dd;
      const GAS char* og = pbase + (unsigned)((tl + 3) * PW + C_MLO + h * 128 + 32 * eb + 4 * h2) * 2u; GAS char* op = (GAS char*)uptr(oall + t0 * OW) + (unsigned)(tl * OW + 512 + h * 128 + 32 * eb + 4 * h2) * 2u;
#pragma unroll
      for (int g = 0; g < 4; ++g) { const u32x2 gv2 = *(const GAS u32x2*)(og + 16 * g);
        const float g0 = sigmoidf_(bf2f((bf16_t)(gv2.x & 0xffff))), g1 = sigmoidf_(bf2f((bf16_t)(gv2.x >> 16))), g2 = sigmoidf_(bf2f((bf16_t)(gv2.y & 0xffff))), g3 = sigmoidf_(bf2f((bf16_t)(gv2.y >> 16)));
        u32x2 w; w.x = pk2(acc[4 * g] * inv * g0, acc[4 * g + 1] * inv * g1); w.y = pk2(acc[4 * g + 2] * inv * g2, acc[4 * g + 3] * inv * g3);
        *(GAS u32x2*)(op + 16 * g) = w; }
    }
    { ML_LANES();
      const float ast = SC[0]; const int db = wave >> 1;
#pragma unroll
      for (int x = 0; x < 2; ++x)
#pragma unroll
        for (int i = 0; i < 16; ++i) cst[x][i] *= ast;
#pragma unroll
      for (int ks = 0; ks < 4; ++ks) { const bf16x8 af = frag_tr(KWt, db, ks, lane, false);
#pragma unroll
        for (int x = 0; x < 2; ++x) cst[x] = mfma32(af, frag_tr(Vt, 2 * (wave & 1) + x, ks, lane, false), cst[x]); }
#pragma unroll
      for (int x = 0; x < 2; ++x) { const int e = 32 * (2 * (wave & 1) + x) + l31;
#pragma unroll
        for (int g = 0; g < 4; ++g) { const int d = 32 * db + 8 * g + 4 * h2; u32x2 w; w.x = pk2(cst[x][4 * g], cst[x][4 * g + 1]); w.y = pk2(cst[x][4 * g + 2], cst[x][4 * g + 3]);
          *(LAS u32x2*)(Ct + offb(e, d >> 3) + (d & 7) * 2) = w; } }
      if (tid < 128) { float s = 0.f;
        for (int j = 0; j < 64; ++j) s += bf2f(*(const LAS bf16_t*)(KWt + offb(j, tid >> 3) + (tid & 7) * 2));
        const float nn = ast * NV[tid] + s; NV[tid] = nn; *(LAS bf16_t*)(Ct + offb(128, tid >> 3) + (tid & 7) * 2) = f2bf(nn); }
    }
    sync_threads();
  }
#undef ML_LANES
}

constexpr int ST_PITCH = 144;
DEV void gla_item(LDSP lds, const bf16_t* __restrict__ proj, const float* __restrict__ narrow, const float* __restrict__ wa2  , const float* __restrict__ ba  ,
                  bf16_t* __restrict__ oall, int b, int h) {
  const int tid = OPAQUE_TID, lane = tid & 63, wave = rfl(tid >> 6), l31 = lane & 31, h2 = lane >> 5;
  LDSP QKt = lds, KWt = lds + 16384, Vt = lds + 32768, St = lds + 49152;
  LAS float* F = (LAS float*)(lds + 69632);
  LAS float *GA = F, *TOT = F + 1024, *EL = F + 1536, *SS = F + 1600;
  const size_t rowbase = (size_t)b * SEQ;
  for (int i = tid; i < 128 * ST_PITCH / 4; i += 512) ((LAS unsigned*)St)[i] = 0u;
  for (int i = tid; i < 16384 / 4; i += 512) ((LAS unsigned*)KWt)[i] = 0u;
  const int d = tid & 63, tg = tid >> 6;
  float wcol[16];
#pragma unroll
  for (int r = 0; r < 16; ++r) wcol[r] = wa2[r * 256 + h * 64 + d];
  const float bad = ba[h * 64 + d];
  f32x16 sst;
#pragma unroll
  for (int i = 0; i < 16; ++i) sst[i] = 0.f;
  const int eb = wave & 3, tb = wave >> 2;
  sync_threads();
  for (int ch = 0; ch < NCH; ++ch) {
    const size_t t0 = rowbase + (size_t)ch * 64;
    { const int id = tid * 2, row = id >> 4, c = id & 15; const float* gp = narrow + (t0 + row) * NWP + NW_GLA + c; GA[id] = gp[0]; GA[id + 1] = gp[1]; }
#pragma unroll
    for (int i = 0; i < 2; ++i) { const int id = tid + 512 * i, row = id >> 4, c16 = id & 15;
      *(LAS u32x4*)(Vt + offb(row, c16)) = *(const u32x4*)(proj + (t0 + row) * PW + C_GLV + h * 128 + c16 * 8); }
    sync_threads();
    float bc[8], tot = 0.f;
#pragma unroll
    for (int r = 0; r < 8; ++r) { const int t = 8 * tg + r; float z = bad;
#pragma unroll
      for (int k = 0; k < 16; ++k) z += GA[t * 16 + k] * wcol[k];
      tot += log_sigmoidf_(z) * 0.0625f; bc[r] = tot; }
    TOT[tg * 64 + d] = tot;
    sync_threads();
    float off = 0.f, last = 0.f;
#pragma unroll
    for (int g = 0; g < 8; ++g) { const float v = TOT[g * 64 + d]; if (g < tg) off += v; last += v; }
    if (tg == 0) EL[d] = __expf(last);
#pragma unroll
    for (int r = 0; r < 8; ++r) { const int t = 8 * tg + r; const float bcv = bc[r] + off;
      const float qv = bf2f(proj[(t0 + t) * PW + C_GLQ + h * 64 + d]) * 0.125f * __expf(bcv);
      const float kraw = bf2f(proj[(t0 + t) * PW + C_GLK + h * 64 + d]);
      *(LAS bf16_t*)(QKt + offb(t, d >> 3) + (d & 7) * 2) = f2bf(qv);
      *(LAS bf16_t*)(QKt + offb(t, 8 + (d >> 3)) + (d & 7) * 2) = f2bf(kraw * __expf(-bcv));
      *(LAS bf16_t*)(KWt + offb(t, d >> 3) + (d & 7) * 2) = f2bf(kraw * __expf(last - bcv)); }
    sync_threads();
    f32x16 acc;
#pragma unroll
    for (int i = 0; i < 16; ++i) acc[i] = 0.f;
#pragma unroll
    for (int ks = 0; ks < 4; ++ks) acc = mfma32(lds_ld8(St + (32 * eb + l31) * ST_PITCH + (16 * ks + 8 * h2) * 2), frag_row(QKt, 32 * tb, ks, lane), acc);
    const int tl = 32 * tb + l31;
#pragma unroll
    for (int jb = 0; jb < 2; ++jb) {
      if (jb <= tb) {
        f32x16 s;
#pragma unroll
        for (int i = 0; i < 16; ++i) s[i] = 0.f;
#pragma unroll
        for (int ks = 0; ks < 4; ++ks) s = mfma32(frag_row(QKt, 32 * jb, 4 + ks, lane), frag_row(QKt, 32 * tb, ks, lane), s);
#pragma unroll
        for (int i = 0; i < 16; ++i) { const int j = 32 * jb + crow(i, h2); if (j > tl) s[i] = 0.f; }
#pragma unroll
        for (int s2 = 0; s2 < 2; ++s2) acc = mfma32(frag_tr(Vt, eb, 2 * jb + s2, lane, true), acc_frag(s, s2), acc);
      }
    }
    float ss = 0.f;
#pragma unroll
    for (int i = 0; i < 16; ++i) ss += acc[i] * acc[i];
    ss += shfl_xor_f(ss, 32);
    if (h2 == 0) SS[eb * 64 + tl] = ss;
    sync_threads();
    {
      const float tot2 = SS[tl] + SS[64 + tl] + SS[128 + tl] + SS[192 + tl]; const float r = 1.0f / sqrtf(tot2 * (1.0f / 128.0f) + RMS_EPS);
      const size_t row = t0 + tl; const bf16_t* gr = proj + row * PW + C_GLR + h * 128 + 32 * eb + 4 * h2; bf16_t* op = oall + row * OW + 1024 + h * 128 + 32 * eb + 4 * h2;
#pragma unroll
      for (int g = 0; g < 4; ++g) { const u32x2 gv2 = *(const u32x2*)(gr + 8 * g);
        const float r0 = bf2f((bf16_t)(gv2.x & 0xffff)), r1 = bf2f((bf16_t)(gv2.x >> 16)), r2 = bf2f((bf16_t)(gv2.y & 0xffff)), r3 = bf2f((bf16_t)(gv2.y >> 16));
        u32x2 w; w.x = pk2(acc[4 * g] * r * r0 * sigmoidf_(r0), acc[4 * g + 1] * r * r1 * sigmoidf_(r1)); w.y = pk2(acc[4 * g + 2] * r * r2 * sigmoidf_(r2), acc[4 * g + 3] * r * r3 * sigmoidf_(r3));
        *(u32x2*)(op + 8 * g) = w; }
    }
    { const int db = wave >> 2;
#pragma unroll
      for (int i = 0; i < 16; ++i) sst[i] *= EL[32 * db + crow(i, h2)];
#pragma unroll
      for (int ks = 0; ks < 4; ++ks) sst = mfma32(frag_tr(KWt, db, ks, lane, false), frag_tr(Vt, eb, ks, lane, false), sst);
      const int e = 32 * eb + l31;
#pragma unroll
      for (int g = 0; g < 4; ++g) { const int dd = 32 * db + 8 * g + 4 * h2; u32x2 w; w.x = pk2(sst[4 * g], sst[4 * g + 1]); w.y = pk2(sst[4 * g + 2], sst[4 * g + 3]);
        *(LAS u32x2*)(St + e * ST_PITCH + dd * 2) = w; } }
    sync_threads();
  }
}

constexpr int S5_WAVE_LDS = 12800, XS_PITCH = 272;
DEV float gelu_tanh_(float y) { const float u = 0.7978845608028654f * (y + 0.044715f * y * y * y); const float e = fast_exp2(2.0f * LOG2E * u); const float th = 1.0f - 2.0f * fast_rcp(e + 1.0f); return 0.5f * y * (1.0f + th); }
DEV void s5_wave(LDSP wl, const bf16_t* __restrict__ proj, const float* __restrict__ AB, const bf16_t* __restrict__ BT, const bf16_t* __restrict__ CT, const float* __restrict__ dskip  ,
                 bf16_t* __restrict__ zout  , int b, int g) {
  const int lane = OPAQUE_TID & 63, l15 = lane & 15, kg = lane >> 4;
  LAS float* BU = (LAS float*)wl; LDSP XS = wl + 8192;
  const float are = AB[(g * 64 + lane) * 2], aim = AB[(g * 64 + lane) * 2 + 1];
  bf16x8 bfr[8], cfr[4]; const bf16x8 zero8 = (bf16x8){0, 0, 0, 0, 0, 0, 0, 0};
#pragma unroll
  for (int nb = 0; nb < 8; ++nb) bfr[nb] = (kg < 2) ? *(const bf16x8*)(BT + ((size_t)g * 128 + 16 * nb + l15) * 16 + 8 * kg) : zero8;
#pragma unroll
  for (int ks = 0; ks < 4; ++ks) cfr[ks] = *(const bf16x8*)(CT + ((size_t)g * 16 + l15) * 128 + 32 * ks + 8 * kg);
  const float dsk = dskip[g * 16 + l15];
  float xr = 0.f, xi = 0.f;
  const size_t rowbase = (size_t)b * SEQ;
  for (int t0 = 0; t0 < SEQ; t0 += 16) {
    const bf16_t* up = proj + (rowbase + t0) * PW + C_S5U + g * 16;
    const bf16x8 ua = (kg < 2) ? *(const bf16x8*)(up + (size_t)l15 * PW + 8 * kg) : zero8;
#pragma unroll
    for (int nb = 0; nb < 8; ++nb) { f32x4 c4 = (f32x4){0.f, 0.f, 0.f, 0.f}; c4 = mfma16(ua, bfr[nb], c4);
#pragma unroll
      for (int i = 0; i < 4; ++i) BU[(4 * kg + i) * 128 + 16 * nb + l15] = c4[i]; }
    wave_sync();
#pragma unroll
    for (int j = 0; j < 16; ++j) { const float br = BU[j * 128 + lane], bi = BU[j * 128 + 64 + lane];
      const float nr = are * xr - aim * xi + br, ni = are * xi + aim * xr + bi; xr = nr; xi = ni;
      *(LAS bf16_t*)(XS + j * XS_PITCH + lane * 2) = f2bf(xr); *(LAS bf16_t*)(XS + j * XS_PITCH + (64 + lane) * 2) = f2bf(xi); }
    wave_sync();
    f32x4 y4 = (f32x4){0.f, 0.f, 0.f, 0.f};
#pragma unroll
    for (int ks = 0; ks < 4; ++ks) y4 = mfma16(lds_ld8(XS + l15 * XS_PITCH + (32 * ks + 8 * kg) * 2), cfr[ks], y4);
#pragma unroll
    for (int i = 0; i < 4; ++i) { const size_t row = rowbase + t0 + 4 * kg + i; const float uu = bf2f(proj[row * PW + C_S5U + g * 16 + l15]);
      zout[row * 512 + g * 16 + l15] = f2bf(gelu_tanh_(y4[i] + dsk * uu)); }
  }
}
DEV void s5_prep_item(int idx, const float* a_re, const float* a_im, const float* log_dt, const float* b_re, const float* b_im, const float* c_re, const float* c_im,
                      float* AB, bf16_t* BT, bf16_t* CT) {
  const int g = idx >> 6, p = idx & 63;
  const float are = a_re[idx], aim = a_im[idx], dt = expf(log_dt[g]);
  const float mag = expf(dt * are), abr = mag * cosf(dt * aim), abi = mag * sinf(dt * aim);
  const float nr = abr - 1.0f, ni = abi, den = are * are + aim * aim;
  const float fr = (nr * are + ni * aim) / den, fi = (ni * are - nr * aim) / den;
  AB[idx * 2] = abr; AB[idx * 2 + 1] = abi;
  for (int c = 0; c < 16; ++c) {
    const float br = b_re[(size_t)idx * 16 + c], bi = b_im[(size_t)idx * 16 + c];
    BT[((size_t)g * 128 + p) * 16 + c] = f2bf(fr * br - fi * bi); BT[((size_t)g * 128 + 64 + p) * 16 + c] = f2bf(fr * bi + fi * br);
    CT[((size_t)g * 16 + c) * 128 + p] = f2bf(c_re[((size_t)g * 16 + c) * 64 + p]); CT[((size_t)g * 16 + c) * 128 + 64 + p] = f2bf(-c_im[((size_t)g * 16 + c) * 64 + p]);
  }
}
namespace pg8 {
#define PG8_LAS __attribute__((address_space(3)))
typedef unsigned short bf16_t;
typedef short bf16x8 __attribute__((ext_vector_type(8)));
typedef float f32x4 __attribute__((ext_vector_type(4)));
typedef unsigned u32x4 __attribute__((ext_vector_type(4)));
constexpr int BM = 256, BK = 64, HALF = 128, HTB = HALF * BK * 2  , STAGE_BYTES = 8 * HTB, NXCD = 8, WGM = 8;

__host__ __device__ __forceinline__ int lds_byte(int r, int c) { const int st = (r >> 4) * 2 + (c >> 5), rr = r & 15, cc = c & 31, ob = rr * 64 + cc * 2; return st * 1024 + (ob ^ (((ob >> 9) & 1) << 5)); }
__host__ __device__ __forceinline__ void stage_rc(int b, int& R, int& C) { const int st = b / 1024, sb = b % 1024, swz = sb ^ (((sb >> 9) & 1) << 5); R = (st >> 1) * 16 + swz / 64; C = (st & 1) * 32 + (swz % 64) / 2; }
__host__ __device__ __forceinline__ int perm32(int rho) { const int n = rho >> 4, i = rho & 15; return 8 * (i >> 2) + 4 * n + (i & 3); }

struct Unit { int pm, pn, acol, z; };
struct Gemm { const bf16_t* A; const bf16_t* Bt; int K, lda, ldb; };
typedef float f32x2 __attribute__((ext_vector_type(2)));
__device__ __forceinline__ unsigned cvt_pk_bf16(float lo, float hi) { unsigned r; asm volatile("v_cvt_pk_bf16_f32 %0, %1, %2" : "=v"(r) : "v"(lo), "v"(hi)); return r; }
template <class Epi, class Sched, bool ALIGN_EPI = false, bool SP2 = false>
__device__ __forceinline__ void gemm_phase(PG8_LAS unsigned char* lds, const Gemm g, const Sched& S, const Epi& E) {
    const int tid = OPAQUE_TID, wid = __builtin_amdgcn_readfirstlane(tid >> 6), lane = tid & 63, wr = wid >> 2, wc = wid & 3, fr = lane & 15, fq = lane >> 4;
    const int K = g.K, nt = K / BK;
    unsigned voffA[2], voffB[2];
#pragma unroll
    for (int i = 0; i < 2; ++i) { int R, C; stage_rc(tid * 16 + i * 8192, R, C); const int Rb = Epi::PERM ? ((R & ~31) + perm32(R & 31)) : R;
        voffA[i] = (unsigned)(R * g.lda + C) * 2u; voffB[i] = (unsigned)(Rb * g.ldb + C) * 2u; }
    const size_t kstep = (size_t)(BK * 2);
    const size_t hstepA = (size_t)HALF * g.lda * 2, hstepB = (size_t)HALF * g.ldb * 2;
    const size_t tstepA = 2 * hstepA, tstepB = 2 * hstepB;
    const unsigned ldsw = (unsigned)wid * 1024u;
    const int aoff = lds_byte(wr * 64 + fr, fq * 8), boff = lds_byte(wc * 32 + fr, fq * 8);
#define PG8_SA(b, h) (((b) * 2 + (h)) * HTB)
#define PG8_SB(b, h) ((4 + (b) * 2 + (h)) * HTB)
#define PG8_STAGE(bufoff, gbase, voff) do { _Pragma("unroll") for (int _i = 0; _i < 2; ++_i) \
        __builtin_amdgcn_global_load_lds((const unsigned*)((const char*)(gbase) + (voff)[_i]), (PG8_LAS unsigned*)(lds + (bufoff) + ldsw + _i * 8192), 16, 0, 0); } while (0)
#define PG8_LDA(dst, b, h) do { _Pragma("unroll") for (int m = 0; m < 4; ++m) _Pragma("unroll") for (int k = 0; k < 2; ++k) dst[m][k] = *(const PG8_LAS bf16x8*)(lds + PG8_SA(b, h) + aoff + m * 2048 + k * 1024); } while (0)
#define PG8_LDB(dst, b, h) do { _Pragma("unroll") for (int n = 0; n < 2; ++n) _Pragma("unroll") for (int k = 0; k < 2; ++k) dst[n][k] = *(const PG8_LAS bf16x8*)(lds + PG8_SB(b, h) + boff + n * 2048 + k * 1024); } while (0)
#define PG8_MMA(ai, bj, At, Bt) do { __builtin_amdgcn_s_setprio(1); _Pragma("unroll") for (int m = 0; m < 4; ++m) _Pragma("unroll") for (int n = 0; n < 2; ++n) _Pragma("unroll") for (int k = 0; k < 2; ++k) \
        acc[ai][bj][m][n] = __builtin_amdgcn_mfma_f32_16x16x32_bf16(Bt[n][k], At[m][k], acc[ai][bj][m][n], 0, 0, 0); __builtin_amdgcn_s_setprio(0); } while (0)
#define PG8_WAIT_V(n) asm volatile("s_waitcnt vmcnt(" #n ")" ::: "memory")
#define PG8_WAIT_L(n) asm volatile("s_waitcnt lgkmcnt(" #n ")" ::: "memory")
#define PG8_BAR __builtin_amdgcn_s_barrier()
#define PG8_SCHED __builtin_amdgcn_sched_barrier(0)
    Unit cur, nxt; int ui = 0;
    if (!S.next(0, cur)) return;
    f32x4 acc[2][2][4][2];
#pragma unroll
    for (int a = 0; a < 2; ++a)
#pragma unroll
        for (int b = 0; b < 2; ++b)
#pragma unroll
            for (int m = 0; m < 4; ++m)
#pragma unroll
                for (int n = 0; n < 2; ++n) acc[a][b][m][n] = (f32x4){0.f, 0.f, 0.f, 0.f};
    bf16x8 At[4][2], B0[2][2], B1[2][2];
    const char* cA = (const char*)g.A + (size_t)cur.pm * tstepA + (size_t)cur.acol * 2; const char* cB = (const char*)g.Bt + (size_t)cur.pn * tstepB;
    S.a_ready(cur);
    if constexpr (SP2) {
        PG8_STAGE(PG8_SB(0, 0), cB, voffB); PG8_STAGE(PG8_SB(0, 1), cB + hstepB, voffB); PG8_STAGE(PG8_SA(0, 0), cA, voffA); PG8_STAGE(PG8_SA(0, 1), cA + hstepA, voffA);
        if (wr == 1) PG8_BAR;
        PG8_WAIT_V(2); PG8_BAR;
        PG8_STAGE(PG8_SB(1, 0), cB + kstep, voffB); PG8_STAGE(PG8_SA(1, 0), cA + kstep, voffA); PG8_STAGE(PG8_SB(1, 1), cB + hstepB + kstep, voffB);
        PG8_WAIT_V(6); PG8_BAR;
    } else {
        PG8_STAGE(PG8_SB(0, 0), cB, voffB); PG8_STAGE(PG8_SA(0, 0), cA, voffA); PG8_STAGE(PG8_SB(0, 1), cB + hstepB, voffB); PG8_STAGE(PG8_SA(0, 1), cA + hstepA, voffA);
        if (wr == 1) PG8_BAR;
        PG8_WAIT_V(4); PG8_BAR;
        PG8_STAGE(PG8_SB(1, 0), cB + kstep, voffB); PG8_STAGE(PG8_SA(1, 0), cA + kstep, voffA); PG8_STAGE(PG8_SB(1, 1), cB + hstepB + kstep, voffB);
        PG8_WAIT_V(6); PG8_BAR;
    }
    for (;;) {
        const bool has_next = S.next(ui + 1, nxt);
        const char* nA = has_next ? (const char*)g.A + (size_t)nxt.pm * tstepA + (size_t)nxt.acol * 2 : cA; const char* nB = has_next ? (const char*)g.Bt + (size_t)nxt.pn * tstepB : cB;
        for (int t = 0; t < nt; t += 2) {
            const bool last = (t == nt - 2);
            const char* a1 = cA + (size_t)(t + 1) * kstep;
            const char* a2 = last ? nA : cA + (size_t)(t + 2) * kstep; const char* b2 = last ? nB : cB + (size_t)(t + 2) * kstep;
            const char* a3 = a2 + kstep; const char* b3 = b2 + kstep;
            if (last && has_next) S.a_ready(nxt);
            if constexpr (SP2) {
            PG8_LDB(B0, 0, 0); PG8_LDB(B1, 0, 1); PG8_SCHED; PG8_LDA(At, 0, 0); PG8_STAGE(PG8_SA(1, 1), a1 + hstepA, voffA);
            PG8_WAIT_V(8); PG8_WAIT_L(0); PG8_BAR; PG8_MMA(0, 0, At, B0); PG8_MMA(0, 1, At, B1); PG8_BAR; PG8_SCHED;
            PG8_LDA(At, 0, 1); PG8_STAGE(PG8_SB(0, 0), b2, voffB); PG8_STAGE(PG8_SB(0, 1), b2 + hstepB, voffB); PG8_STAGE(PG8_SA(0, 0), a2, voffA);
            PG8_WAIT_V(8); PG8_WAIT_L(0); PG8_BAR; PG8_MMA(1, 0, At, B0); PG8_MMA(1, 1, At, B1); PG8_BAR; PG8_SCHED;
            PG8_LDB(B0, 1, 0); PG8_LDB(B1, 1, 1); PG8_SCHED; PG8_LDA(At, 1, 0); PG8_STAGE(PG8_SA(0, 1), a2 + hstepA, voffA);
            PG8_WAIT_V(8); PG8_WAIT_L(0); PG8_BAR; PG8_MMA(0, 0, At, B0); PG8_MMA(0, 1, At, B1); PG8_BAR; PG8_SCHED;
            PG8_LDA(At, 1, 1); PG8_STAGE(PG8_SB(1, 0), b3, voffB); PG8_STAGE(PG8_SB(1, 1), b3 + hstepB, voffB); PG8_STAGE(PG8_SA(1, 0), a3, voffA);
            PG8_WAIT_V(8); PG8_WAIT_L(0); PG8_BAR; PG8_MMA(1, 0, At, B0); PG8_MMA(1, 1, At, B1); PG8_BAR; PG8_SCHED;
            } else {
            PG8_LDB(B0, 0, 0); PG8_SCHED; PG8_LDA(At, 0, 0); PG8_STAGE(PG8_SA(1, 1), a1 + hstepA, voffA);
            PG8_WAIT_L(8); PG8_BAR; PG8_WAIT_L(0); PG8_MMA(0, 0, At, B0); PG8_BAR; PG8_SCHED;
            PG8_LDB(B1, 0, 1); PG8_STAGE(PG8_SB(0, 0), b2, voffB);
            PG8_BAR; PG8_WAIT_L(0); PG8_MMA(0, 1, At, B1); PG8_BAR;
            PG8_LDA(At, 0, 1); PG8_STAGE(PG8_SA(0, 0), a2, voffA);
            PG8_BAR; PG8_WAIT_L(0); PG8_MMA(1, 0, At, B0); PG8_BAR; PG8_SCHED;
            PG8_STAGE(PG8_SB(0, 1), b2 + hstepB, voffB);
            PG8_WAIT_V(6); PG8_BAR; PG8_MMA(1, 1, At, B1); PG8_BAR;
            PG8_LDB(B0, 1, 0); PG8_SCHED; PG8_LDA(At, 1, 0); PG8_STAGE(PG8_SA(0, 1), a2 + hstepA, voffA);
            PG8_WAIT_L(8); PG8_BAR; PG8_WAIT_L(0); PG8_MMA(0, 0, At, B0); PG8_BAR; PG8_SCHED;
            PG8_LDB(B1, 1, 1); PG8_STAGE(PG8_SB(1, 0), b3, voffB);
            PG8_BAR; PG8_WAIT_L(0); PG8_MMA(0, 1, At, B1); PG8_BAR;
            PG8_LDA(At, 1, 1); PG8_STAGE(PG8_SA(1, 0), a3, voffA);
            PG8_BAR; PG8_WAIT_L(0); PG8_MMA(1, 0, At, B0); PG8_BAR; PG8_SCHED;
            PG8_STAGE(PG8_SB(1, 1), b3 + hstepB, voffB);
            PG8_WAIT_V(6); PG8_BAR; PG8_MMA(1, 1, At, B1); PG8_BAR;
            }
        }
        if constexpr (ALIGN_EPI) { if (wr == 0) PG8_BAR; }
        if constexpr (!Epi::AFTER_DRAIN) { E(acc, cur, wr, wc, fr, fq); S.done(cur); }
        if (!has_next) break;
#pragma unroll
        for (int a = 0; a < 2; ++a)
#pragma unroll
            for (int b = 0; b < 2; ++b)
#pragma unroll
                for (int m = 0; m < 4; ++m)
#pragma unroll
                    for (int n = 0; n < 2; ++n) acc[a][b][m][n] = (f32x4){0.f, 0.f, 0.f, 0.f};
        cur = nxt; cA = nA; cB = nB; ++ui;
        if constexpr (ALIGN_EPI) { if (wr == 1) PG8_BAR; }
    }
    PG8_WAIT_V(0);
    if constexpr (!ALIGN_EPI) { if (wr == 0) PG8_BAR; }
    PG8_BAR;
    if constexpr (Epi::AFTER_DRAIN) { E.fused(acc, cur, wr, wc, fr, fq, lds, wid, lane); S.done(cur); }
#undef PG8_SA
#undef PG8_SB
#undef PG8_STAGE
#undef PG8_LDA
#undef PG8_LDB
#undef PG8_MMA
#undef PG8_WAIT_V
#undef PG8_WAIT_L
#undef PG8_BAR
#undef PG8_SCHED
}
}
constexpr int DM = 2048, NLAYER = 4, FFH = 5632, NPROJ = 5888, NMT = M_TOK / 256;
constexpr size_t MiB = 1u << 20;
constexpr size_t WS_CTL = 0, CTL_ZERO_BYTES = 1 * MiB;
constexpr size_t WS_MODP = 1 * MiB, WS_S5T = 8 * MiB, WS_WGLU = 9 * MiB, WS_WIN = 10 * MiB, WS_WG = 33 * MiB, WS_WB = 65 * MiB, WS_WOUT = 73 * MiB, WS_WFI = 81 * MiB, WS_WFO = 125 * MiB;
constexpr size_t WS_NAR = 147 * MiB, WS_Z = 151 * MiB, WS_H = 183 * MiB, WS_OALL = 311 * MiB, WS_PROJ = 439 * MiB, WS_P = 791 * MiB, WS_GSCR = 1303 * MiB, WS_END = 1367 * MiB;
constexpr size_t WS_MERGED = WS_PROJ, WS_MIXB = WS_PROJ + 128 * MiB, WS_Y = WS_PROJ, WS_HID = WS_P;
static_assert(WS_WIN + (size_t)NPROJ * DM * 2 <= WS_WG && WS_WFI + (size_t)2 * FFH * DM * 2 <= WS_WFO && WS_WFO + (size_t)DM * FFH * 2 <= WS_NAR, "weight map");
static_assert(WS_NAR + (size_t)M_TOK * NWP * 4 <= WS_Z && WS_Z + (size_t)M_TOK * 512 * 2 <= WS_H && WS_H + (size_t)M_TOK * DM * 2 <= WS_OALL && WS_OALL + (size_t)M_TOK * DM * 2 <= WS_PROJ, "act map");
static_assert(WS_PROJ + (size_t)M_TOK * PW * 2 <= WS_P && WS_P + (size_t)4 * M_TOK * DM * 2 <= WS_GSCR && WS_HID + (size_t)M_TOK * FFH * 2 <= WS_GSCR && WS_GSCR + (size_t)256 * 262144 <= WS_END, "act map 2");
constexpr int KSPLIT = 8;
constexpr int CW_TMO = 0, CW_BAR = 4096, CW_Q = 16384;
constexpr int LDS_BYTES = 147456, LDS_MISC = 131072, LDS_BIAS = 131072 + 256;
constexpr int N_PHASES = 2 + 10 * NLAYER;

__device__ const unsigned char T5_BUCKET[128] = {0,1,2,3,4,5,6,7,8,9,10,11,12,13,14,15,16,16,16,17,17,18,18,18,19,19,19,20,20,20,20,21,21,21,21,22,22,22,22,22,23,23,23,23,23,23,24,24,24,24,24,24,25,25,25,25,25,25,25,26,26,26,26,26,26,26,26,27,27,27,27,27,27,27,27,27,27,28,28,28,28,28,28,28,28,28,28,29,29,29,29,29,29,29,29,29,29,29,29,30,30,30,30,30,30,30,30,30,30,30,30,30,30,31,31,31,31,31,31,31,31,31,31,31,31,31,31,31};

#define XB_TMO      128
#define XB_XCNT(j)  (256  + 64 * (j))
#define XB_XSUB(j)  (1280 + 64 * (j))
#define XB_XGEN(j)  (2304 + 64 * (j))
#define XB_TOP      3328
#define XB_TOPGEN   3392
#define XCD_BAR_WORDS 3456
#define XB_SPIN_CAP (1u << 22)
__device__ __forceinline__ unsigned xb_ld(unsigned* p)              { return __hip_atomic_load(p, __ATOMIC_RELAXED, __HIP_MEMORY_SCOPE_AGENT); }
__device__ __forceinline__ unsigned xb_add(unsigned* p, unsigned v) { return __hip_atomic_fetch_add(p, v, __ATOMIC_RELAXED, __HIP_MEMORY_SCOPE_AGENT); }
__device__ __forceinline__ unsigned xb_xcc_id() { return (unsigned)__builtin_amdgcn_s_getreg((3 << 11) | 20) & 0xFu; }
#define XB_SPIN(cond, bar) do { unsigned _sp = 0; while (cond) { __builtin_amdgcn_s_sleep(1); \
    if ((++_sp & 255u) == 0u) { if (xb_ld(&(bar)[XB_TMO])) break; if (_sp > XB_SPIN_CAP) { atomicAdd(&(bar)[XB_TMO], 1u); break; } } } } while (0)
struct XcdBarrier { unsigned* bar; unsigned x; volatile LAS unsigned* st; };
__device__ __forceinline__ XcdBarrier xcd_barrier_post(unsigned* bar, volatile LAS unsigned* st) {
    XcdBarrier b; b.bar = bar; b.x = xb_xcc_id(); b.st = st;
    if (threadIdx.x == 0) (void)xb_add(&bar[XB_XCNT(b.x)], 1u);
    return b;
}
__device__ __forceinline__ void xcd_barrier_complete(unsigned* bar, unsigned x, unsigned& nloc, unsigned& nx) {
    const unsigned G = gridDim.x * gridDim.y * gridDim.z;
    unsigned sum, cnt, mine, sp = 0u;
    for (;;) {
        sum = 0u; cnt = 0u; mine = 0u;
#pragma unroll
        for (unsigned j = 0; j < 16; ++j) { const unsigned c = xb_ld(&bar[XB_XCNT(j)]); sum += c; cnt += (c > 0u) ? 1u : 0u; mine = (j == x) ? c : mine; }
        if (sum == G) break;
        __builtin_amdgcn_s_sleep(1);
        if ((++sp & 255u) == 0u) { if (xb_ld(&bar[XB_TMO])) break; if (sp > XB_SPIN_CAP) { atomicAdd(&bar[XB_TMO], 1u); break; } }
    }
    nloc = mine > 0u ? mine : 1u; nx = cnt > 0u ? cnt : 1u;
}
__device__ __forceinline__ void xcd_barrier(const XcdBarrier& b) {
    asm volatile("s_waitcnt vmcnt(0)" ::: "memory");
    __syncthreads();
    if (threadIdx.x == 0) {
        unsigned* bar = b.bar;
        __builtin_amdgcn_s_waitcnt(0);
        unsigned nloc = b.st[0], nx = b.st[1];
        if (nloc == 0u) { xcd_barrier_complete(bar, b.x, nloc, nx); b.st[0] = nloc; b.st[1] = nx; }
        const unsigned old = xb_add(&bar[XB_XSUB(b.x)], 1u);
        const unsigned gen = old / nloc;
        if (old + 1u == (gen + 1u) * nloc) {
            __builtin_amdgcn_fence(__ATOMIC_RELEASE, "agent");
            asm volatile("s_waitcnt vmcnt(0)" ::: "memory");
            const unsigned og = xb_add(&bar[XB_TOP], 1u);
            const unsigned tg = og / nx;
            if (og + 1u == (tg + 1u) * nx) xb_add(&bar[XB_TOPGEN], 1u);
            else XB_SPIN(xb_ld(&bar[XB_TOPGEN]) == tg, bar);
            __builtin_amdgcn_fence(__ATOMIC_ACQUIRE, "agent");
            xb_add(&bar[XB_XGEN(b.x)], 1u);
            asm volatile("s_waitcnt vmcnt(0)" ::: "memory");
        } else {
            XB_SPIN(xb_ld(&bar[XB_XGEN(b.x)]) == gen, bar);
            __builtin_amdgcn_fence(__ATOMIC_ACQUIRE, "agent");
            asm volatile("s_waitcnt vmcnt(0)" ::: "memory");
        }
    }
    __syncthreads();
}

namespace pg8 {
__device__ __forceinline__ void tile_map(int nM, int nN, int L, int& pm, int& pn) {
    const int nwg = nM * nN; int wgid = L;
    { const int q = nwg / NXCD, r = nwg % NXCD, xcd = wgid % NXCD, off = wgid / NXCD; wgid = (xcd < r ? xcd * (q + 1) : r * (q + 1) + (xcd - r) * q) + off; }
    const int nig = WGM * nN, gid = wgid / nig, fm = gid * WGM, gsz = (nM - fm) < WGM ? (nM - fm) : WGM;
    pm = fm + ((wgid % nig) % gsz); pn = (wgid % nig) / gsz;
}
struct SchedPlain { int nM, nN, G, c;
    __device__ __forceinline__ bool next(int i, Unit& u) const { const long L = (long)i * G + c; if (L >= (long)nM * nN) return false; tile_map(nM, nN, (int)L, u.pm, u.pn); u.acol = 0; u.z = 0; return true; }
    __device__ __forceinline__ void a_ready(const Unit&) const {} __device__ __forceinline__ void done(const Unit&) const {} };
struct SchedP { int nM, G, c;
    __device__ __forceinline__ bool next(int i, Unit& u) const { const long L = (long)i * G + c; const int per = nM * 8; if (L >= 4L * per) return false; const int z = (int)(L / per); int pm, pn; tile_map(nM, 8, (int)(L % per), pm, pn);
        u.pm = pm; u.pn = z * 8 + pn; u.acol = 512 * z; u.z = z; return true; }
    __device__ __forceinline__ void a_ready(const Unit&) const {} __device__ __forceinline__ void done(const Unit&) const {} };
struct SchedGate { int nM, G, c;
    __device__ __forceinline__ bool next(int i, Unit& u) const { const long T = (long)(i >> 2) * G + c; if (T >= (long)nM * 8) return false; int pm, pn; tile_map(nM, 8, (int)T, pm, pn); const int z = i & 3;
        u.pm = pm; u.pn = z * 8 + pn; u.acol = 0; u.z = z; return true; }
    __device__ __forceinline__ void a_ready(const Unit&) const {} __device__ __forceinline__ void done(const Unit&) const {} };

__device__ __forceinline__ u32x4 pack8(const f32x4& a, const f32x4& b) { u32x4 w; w.x = cvt_pk_bf16(a[0], a[1]); w.y = cvt_pk_bf16(a[2], a[3]); w.z = cvt_pk_bf16(b[0], b[1]); w.w = cvt_pk_bf16(b[2], b[3]); return w; }
__device__ __forceinline__ void unpack8(const u32x4& w, f32x4& a, f32x4& b) {
    a[0] = __uint_as_float(w.x << 16); a[1] = __uint_as_float(w.x & 0xffff0000u); a[2] = __uint_as_float(w.y << 16); a[3] = __uint_as_float(w.y & 0xffff0000u);
    b[0] = __uint_as_float(w.z << 16); b[1] = __uint_as_float(w.z & 0xffff0000u); b[2] = __uint_as_float(w.w << 16); b[3] = __uint_as_float(w.w & 0xffff0000u); }
__device__ __forceinline__ float sigm(float x) { return __builtin_amdgcn_rcpf(1.0f + __builtin_amdgcn_exp2f(-1.4426950408889634f * x)); }

struct EpiPlain {
    static constexpr bool PERM = true, AFTER_DRAIN = false;
    bf16_t* O; int ldc; int colmask; size_t zstride;
    __device__ __forceinline__ void operator()(const f32x4 (&acc)[2][2][4][2], const Unit& u, int wr_, int wc_, int fr_, int fq_) const {
        const int tid = OPAQUE_TID, wid_ = __builtin_amdgcn_readfirstlane(tid >> 6), wr = wid_ >> 2, wc = wid_ & 3, fr = tid & 15, fq = (tid & 63) >> 4;
        const int row0 = u.pm * BM + wr * 64 + fr, col0 = (u.pn & colmask) * BM + wc * 32 + 8 * fq; bf16_t* base = O + (size_t)u.z * zstride;
#pragma unroll
        for (int ai = 0; ai < 2; ++ai)
#pragma unroll
            for (int m = 0; m < 4; ++m) { bf16_t* rowp = base + (size_t)(row0 + ai * HALF + m * 16) * ldc + col0;
#pragma unroll
                for (int bj = 0; bj < 2; ++bj) *(u32x4*)(rowp + bj * HALF) = pack8(acc[ai][bj][m][0], acc[ai][bj][m][1]); }
    }
};
struct EpiProj {
    static constexpr bool PERM = true, AFTER_DRAIN = false;
    bf16_t* P; float* NAR;
    __device__ __forceinline__ void operator()(const f32x4 (&acc)[2][2][4][2], const Unit& u, int wr_, int wc_, int fr_, int fq_) const {
        const int tid = OPAQUE_TID, wid_ = __builtin_amdgcn_readfirstlane(tid >> 6), wr = wid_ >> 2, wc = wid_ & 3, fr = tid & 15, fq = (tid & 63) >> 4;
        const int row0 = u.pm * BM + wr * 64 + fr;
        if (u.pn < 22) { const int col0 = u.pn * BM + wc * 32 + 8 * fq;
#pragma unroll
            for (int ai = 0; ai < 2; ++ai)
#pragma unroll
                for (int m = 0; m < 4; ++m) { bf16_t* rowp = P + (size_t)(row0 + ai * HALF + m * 16) * PW + col0;
#pragma unroll
                    for (int bj = 0; bj < 2; ++bj) *(u32x4*)(rowp + bj * HALF) = pack8(acc[ai][bj][m][0], acc[ai][bj][m][1]); }
        } else if (wc == 0 && fq < 3) {
#pragma unroll
            for (int ai = 0; ai < 2; ++ai)
#pragma unroll
                for (int m = 0; m < 4; ++m) { float* np = NAR + (size_t)(row0 + ai * HALF + m * 16) * NWP + 8 * fq; *(f32x4*)np = acc[ai][0][m][0]; *(f32x4*)(np + 4) = acc[ai][0][m][1]; }
        }
    }
};
struct EpiGlu {
    static constexpr bool PERM = true, AFTER_DRAIN = false;
    const bf16_t* Z; const float* bias; bf16_t* O;
    __device__ __forceinline__ void operator()(const f32x4 (&acc)[2][2][4][2], const Unit& u, int wr_, int wc_, int fr_, int fq_) const {
        const int tid = OPAQUE_TID, wid_ = __builtin_amdgcn_readfirstlane(tid >> 6), wr = wid_ >> 2, wc = wid_ & 3, fr = tid & 15, fq = (tid & 63) >> 4;
        const int row0 = u.pm * BM + wr * 64 + fr, col0 = u.pn * BM + wc * 32 + 8 * fq;
#pragma unroll
        for (int bj = 0; bj < 2; ++bj) { const int c = col0 + bj * HALF; const f32x4 b0 = *(const f32x4*)(bias + c), b1 = *(const f32x4*)(bias + c + 4);
#pragma unroll
            for (int ai = 0; ai < 2; ++ai)
#pragma unroll
                for (int m = 0; m < 4; ++m) { const size_t row = (size_t)(row0 + ai * HALF + m * 16); f32x4 z0, z1; unpack8(*(const u32x4*)(Z + row * 512 + c), z0, z1);
                    f32x4 v0 = acc[ai][bj][m][0] + b0, v1 = acc[ai][bj][m][1] + b1;
#pragma unroll
                    for (int j = 0; j < 4; ++j) { v0[j] = z0[j] * sigm(v0[j]); v1[j] = z1[j] * sigm(v1[j]); }
                    *(u32x4*)(O + row * OW + 1536 + c) = pack8(v0, v1); } }
    }
};
struct EpiGate {
    static constexpr bool PERM = true, AFTER_DRAIN = false;
    const bf16_t* P; const float* bias; bf16_t* scr; bf16_t* MG;
    __device__ __forceinline__ void operator()(const f32x4 (&acc)[2][2][4][2], const Unit& u, int wr_, int wc_, int fr_, int fq_) const {
        const int tid = OPAQUE_TID, wid_ = __builtin_amdgcn_readfirstlane(tid >> 6), wr = wid_ >> 2, wc = wid_ & 3, fr = tid & 15, fq = (tid & 63) >> 4;
        const int z = u.z, row0 = u.pm * BM + wr * 64 + fr, col0 = (u.pn & 7) * BM + wc * 32 + 8 * fq;
        const GAS char* Pz = uptr(P + (size_t)z * M_TOK * DM + (size_t)(u.pm * BM) * DM); const float* bz = bias + z * DM; GAS char* MGp = (GAS char*)uptr(MG + (size_t)(u.pm * BM) * DM);
        const unsigned voff = (unsigned)((wr * 64 + fr) * DM + col0) * 2u;
#pragma unroll
        for (int bj = 0; bj < 2; ++bj) { const int c = col0 + bj * HALF; const f32x4 b0 = *(const f32x4*)(bz + c), b1 = *(const f32x4*)(bz + c + 4);
#pragma unroll
            for (int qh = 0; qh < 2; ++qh) {
                u32x4 pv[4], sv[4];
#pragma unroll
                for (int qq = 0; qq < 4; ++qq) { const int q = qh * 4 + qq, ai = q >> 2, m = q & 3; pv[qq] = *(const GAS u32x4*)(Pz + voff + (unsigned)((ai * HALF + m * 16) * DM + bj * HALF) * 2u);
                    if (z > 0) sv[qq] = *(const u32x4*)(scr + ((size_t)(q * 2 + bj) * 512 + tid) * 8); }
#pragma unroll
                for (int qq = 0; qq < 4; ++qq) { const int q = qh * 4 + qq, ai = q >> 2, m = q & 3; f32x4 p0, p1; unpack8(pv[qq], p0, p1);
                    f32x4 v0 = acc[ai][bj][m][0] + b0, v1 = acc[ai][bj][m][1] + b1;
#pragma unroll
                    for (int j = 0; j < 4; ++j) { v0[j] = p0[j] * sigm(v0[j]); v1[j] = p1[j] * sigm(v1[j]); }
                    if (z > 0) { f32x4 s0, s1; unpack8(sv[qq], s0, s1); v0 += s0; v1 += s1; }
                    if (z < 3) *(u32x4*)(scr + ((size_t)(q * 2 + bj) * 512 + tid) * 8) = pack8(v0, v1);
                    else *(GAS u32x4*)(MGp + voff + (unsigned)((ai * HALF + m * 16) * DM + bj * HALF) * 2u) = pack8(v0, v1); }
                asm volatile("" ::: "memory");
            }
        }
    }
};
struct EpiSwiglu {
    static constexpr bool PERM = true, AFTER_DRAIN = false;
    bf16_t* Hd;
    __device__ __forceinline__ void operator()(const f32x4 (&acc)[2][2][4][2], const Unit& u, int wr_, int wc_, int fr_, int fq_) const {
        const int tid = OPAQUE_TID, wid_ = __builtin_amdgcn_readfirstlane(tid >> 6), wr = wid_ >> 2, wc = wid_ & 3, fr = tid & 15, fq = (tid & 63) >> 4;
        const int row0 = u.pm * BM + wr * 64 + fr, col0 = u.pn * HALF + wc * 32 + 8 * fq;
#pragma unroll
        for (int ai = 0; ai < 2; ++ai)
#pragma unroll
            for (int m = 0; m < 4; ++m) { f32x4 v0, v1;
#pragma unroll
                for (int j = 0; j < 4; ++j) { const float a0 = acc[ai][0][m][0][j], a1 = acc[ai][0][m][1][j]; v0[j] = a0 * sigm(a0) * acc[ai][1][m][0][j]; v1[j] = a1 * sigm(a1) * acc[ai][1][m][1][j]; }
                *(u32x4*)(Hd + (size_t)(row0 + ai * HALF + m * 16) * FFH + col0) = pack8(v0, v1); }
    }
};
}

struct Args { const float* in[28]; float* out; unsigned char* ws; int ph_lo, ph_hi; };
enum { I_X = 0, I_C, I_ADAW, I_ADAB, I_NORMG, I_WIN, I_RELB, I_DLAM, I_MLCONV, I_MLGB, I_GLAWA2, I_GLABA, I_S5ARE, I_S5AIM, I_S5DT, I_S5BRE, I_S5BIM, I_S5CRE, I_S5CIM, I_S5D, I_GLUW, I_GLUB, I_WBR, I_WGATE, I_BGATE, I_WOUT, I_FFIN, I_FFOUT };

typedef const __attribute__((address_space(4))) unsigned char* kaptr_t;
__device__ __forceinline__ kaptr_t ka_base() { kaptr_t p = (kaptr_t)__builtin_amdgcn_kernarg_segment_ptr(); asm volatile("" : "+s"(p)); return p; }
__device__ __forceinline__ const float* INP(int i) { return *(const float* const __attribute__((address_space(4)))*)(ka_base() + 8 * i); }
__device__ __forceinline__ float* OUTP() { return *(float* const __attribute__((address_space(4)))*)(ka_base() + 224); }
__device__ __forceinline__ unsigned char* WSB() { return *(unsigned char* const __attribute__((address_space(4)))*)(ka_base() + 232); }
static_assert(sizeof(Args) == 248, "Args layout");
template <class RowMap>
__device__ __forceinline__ void conv_item(const float* __restrict__ W, int K, int N, bf16_t* __restrict__ WT, int ldk, int koff, const RowMap& rm, LAS float* scr, int item, int lane) {
    const int nblk = (N + 31) / 32, kb = item / nblk, nb = item % nblk, k0 = 64 * kb, n0 = 32 * nb; const int nn = n0 + (lane & 31); const bool okn = nn < N;
#pragma unroll 8
    for (int i = 0; i < 32; ++i) { const int kk = 2 * i + (lane >> 5); scr[kk * 33 + (lane & 31)] = okn ? W[(size_t)(k0 + kk) * N + nn] : 0.f; }
    asm volatile("s_waitcnt lgkmcnt(0)" ::: "memory");
    const int c = lane & 7;
#pragma unroll
    for (int j = 0; j < 4; ++j) { const int n = (lane >> 3) + 8 * j; const LAS float* s = scr + (8 * c) * 33 + n;
        u32x4 o; o.x = pk2(s[0 * 33], s[1 * 33]); o.y = pk2(s[2 * 33], s[3 * 33]); o.z = pk2(s[4 * 33], s[5 * 33]); o.w = pk2(s[6 * 33], s[7 * 33]);
        if (n0 + n < N) *(u32x4*)(WT + (size_t)rm(n0 + n) * ldk + koff + k0 + 8 * c) = o; }
    asm volatile("s_waitcnt lgkmcnt(0)" ::: "memory");
}
struct RmIdent { int off; __device__ __forceinline__ int operator()(int n) const { return off + n; } };
struct RmWin { __device__ __forceinline__ int operator()(int n) const { return n < 3584 ? n : (n < 3592 ? 5632 + (n - 3584) : (n < 5128 ? n - 8 : (n < 5144 ? 5640 + (n - 5128) : n - 24))); } };
struct RmFfi { __device__ __forceinline__ int operator()(int n) const { const int g = n >= FFH, j = g ? n - FFH : n; return (j >> 7) * 256 + g * 128 + (j & 127); } };

__device__ __forceinline__ void convert_layer(int l, LDSP lds, int wg, int G) {
    const int tid_ = OPAQUE_TID, lane = tid_ & 63, gw = wg * 8 + (tid_ >> 6), NGW = G * 8, gtid = wg * 512 + tid_, NT = G * 512;
    unsigned char* ws = WSB();
    LAS float* scr = (LAS float*)(lds + (tid_ >> 6) * 16384);
    bf16_t* Win = (bf16_t*)(ws + WS_WIN); bf16_t* Wg = (bf16_t*)(ws + WS_WG); bf16_t* Wb = (bf16_t*)(ws + WS_WB); bf16_t* Wo = (bf16_t*)(ws + WS_WOUT); bf16_t* Wfi = (bf16_t*)(ws + WS_WFI); bf16_t* Wfo = (bf16_t*)(ws + WS_WFO); bf16_t* Wglu = (bf16_t*)(ws + WS_WGLU);
    constexpr int I_IN = 32 * 177, I_G1 = 32 * 64, I_G = 4 * I_G1, I_B1 = 8 * 64, I_B = 4 * I_B1, I_O = 32 * 64, I_FI = 32 * 352, I_FO = 88 * 64, I_GL = 8 * 16;
    constexpr int NIT = I_IN + I_G + I_B + I_O + I_FI + I_FO + I_GL;
    for (int it = gw; it < NIT; it += NGW) {
        int r = it;
        if (r < I_IN) { conv_item(INP(I_WIN) + (size_t)l * DM * 5656, DM, 5656, Win, DM, 0, RmWin{}, scr, r, lane); continue; } r -= I_IN;
        if (r < I_G) { const int z = r / I_G1; conv_item(INP(I_WGATE) + ((size_t)l * 4 + z) * DM * DM, DM, DM, Wg, DM, 0, RmIdent{z * DM}, scr, r % I_G1, lane); continue; } r -= I_G;
        if (r < I_B) { const int z = r / I_B1; conv_item(INP(I_WBR) + ((size_t)l * 4 + z) * 512 * DM, 512, DM, Wb, 512, 0, RmIdent{z * DM}, scr, r % I_B1, lane); continue; } r -= I_B;
        if (r < I_O) { conv_item(INP(I_WOUT) + (size_t)l * DM * DM, DM, DM, Wo, DM, 0, RmIdent{0}, scr, r, lane); continue; } r -= I_O;
        if (r < I_FI) { conv_item(INP(I_FFIN) + (size_t)l * DM * 2 * FFH, DM, 2 * FFH, Wfi, DM, 0, RmFfi{}, scr, r, lane); continue; } r -= I_FI;
        if (r < I_FO) { conv_item(INP(I_FFOUT) + (size_t)l * FFH * DM, FFH, DM, Wfo, FFH, 0, RmIdent{0}, scr, r, lane); continue; } r -= I_FO;
        conv_item(INP(I_GLUW) + (size_t)l * 512 * 512, 512, 512, Wglu, 512, 0, RmIdent{0}, scr, r, lane);
    }
    for (int i = gtid; i < 232 * 256; i += NT) ((u32x4*)(Win + (size_t)5656 * DM))[i] = (u32x4){0u, 0u, 0u, 0u};
    if (gtid < 2048) s5_prep_item(gtid, INP(I_S5ARE) + l * 2048, INP(I_S5AIM) + l * 2048, INP(I_S5DT) + l * 32, INP(I_S5BRE) + (size_t)l * 32768, INP(I_S5BIM) + (size_t)l * 32768,
                                  INP(I_S5CRE) + (size_t)l * 32768, INP(I_S5CIM) + (size_t)l * 32768, (float*)(ws + WS_S5T), (bf16_t*)(ws + WS_S5T + 65536), (bf16_t*)(ws + WS_S5T + 65536 + 262144));
}

__device__ __forceinline__ void mod_partials(LDSP lds, int wg, int G) {
    LAS float* cs = (LAS float*)lds;
    const int tid = OPAQUE_TID;
    for (int it = wg; it < KSPLIT * NLAYER * 6; it += G) {
        const int ks = it / (NLAYER * 6), l = (it / 6) % NLAYER, cg = it % 6;
        __syncthreads();
        for (int i = tid; i < BATCH * 256; i += 512) { const int b = i >> 8, k = ks * 256 + (i & 255); const float c = INP(I_C)[b * DM + k]; cs[i] = c * sigmoidf_(c); }
        __syncthreads();
        const float* wp = INP(I_ADAW) + ((size_t)l * DM + ks * 256) * (6 * DM) + cg * DM + 4 * tid;
        f32x4 s[BATCH];
#pragma unroll
        for (int b = 0; b < BATCH; ++b) s[b] = (f32x4){0.f, 0.f, 0.f, 0.f};
#pragma unroll 4
        for (int k = 0; k < 256; ++k) { const f32x4 w = *(const f32x4*)(wp + (size_t)k * (6 * DM));
#pragma unroll
            for (int b = 0; b < BATCH; ++b) s[b] += w * cs[b * 256 + k]; }
        float* mp = (float*)(WSB() + WS_MODP);
#pragma unroll
        for (int b = 0; b < BATCH; ++b) *(f32x4*)(mp + (((size_t)ks * NLAYER + l) * BATCH + b) * (6 * DM) + cg * DM + 4 * tid) = s[b];
    }
}
__device__ __forceinline__ f32x4 mod_vec(int l, int b, int idx, int tid) {
    f32x4 s = *(const f32x4*)(INP(I_ADAB) + (size_t)l * 6 * DM + idx * DM + 4 * tid);
    const float* mp = (const float*)(WSB() + WS_MODP);
#pragma unroll
    for (int ks = 0; ks < KSPLIT; ++ks) s += *(const f32x4*)(mp + (((size_t)ks * NLAYER + l) * BATCH + b) * (6 * DM) + idx * DM + 4 * tid);
    return s;
}
__device__ __forceinline__ void norm_phase(LDSP lds, int wg, int G, const float* xin, float* xout, const bf16_t* ysrc, int l_res, int i_gate, int i_ga, bf16_t* hout, int l_h, int i_scale, int i_shift, int i_gb) {
    LAS f32x4* VA = (LAS f32x4*)lds; LAS f32x4* VB = (LAS f32x4*)(lds + 8192); LAS f32x4* VC = (LAS f32x4*)(lds + 16384);
    const int tid = OPAQUE_TID, lane = tid & 63, wave = tid >> 6;
    for (int chunk = wg; chunk < M_TOK / 128; chunk += G) {
        const int b = (chunk * 128) / SEQ;
        __syncthreads();
        if (ysrc) VA[tid] = mod_vec(l_res, b, i_gate, tid) * *(const f32x4*)(INP(I_NORMG) + ((size_t)l_res * 4 + i_ga) * DM + 4 * tid);
        if (hout) { VB[tid] = (mod_vec(l_h, b, i_scale, tid) + 1.0f) * *(const f32x4*)(INP(I_NORMG) + ((size_t)l_h * 4 + i_gb) * DM + 4 * tid); VC[tid] = mod_vec(l_h, b, i_shift, tid); }
        __syncthreads();
        for (int r = wave; r < 128; r += 8) {
            const size_t row = (size_t)chunk * 128 + r;
            f32x4 x[8];
#pragma unroll
            for (int j = 0; j < 8; ++j) x[j] = *((const f32x4*)(xin + row * DM) + lane + 64 * j);
            if (ysrc) {
                f32x4 y[8]; float ss = 0.f;
#pragma unroll
                for (int j = 0; j < 8; ++j) { const u32x2 w = *((const u32x2*)(ysrc + row * DM) + lane + 64 * j);
                    y[j][0] = __uint_as_float(w.x << 16); y[j][1] = __uint_as_float(w.x & 0xffff0000u); y[j][2] = __uint_as_float(w.y << 16); y[j][3] = __uint_as_float(w.y & 0xffff0000u);
                    ss += (y[j][0] * y[j][0] + y[j][1] * y[j][1]) + (y[j][2] * y[j][2] + y[j][3] * y[j][3]); }
                ss = wave_sum_f(ss); const float rn = 1.0f / sqrtf(ss * (1.0f / DM) + RMS_EPS);
#pragma unroll
                for (int j = 0; j < 8; ++j) { x[j] += y[j] * rn * VA[lane + 64 * j]; *((f32x4*)(xout + row * DM) + lane + 64 * j) = x[j]; }
            }
            if (hout) {
                float ss = 0.f;
#pragma unroll
                for (int j = 0; j < 8; ++j) ss += (x[j][0] * x[j][0] + x[j][1] * x[j][1]) + (x[j][2] * x[j][2] + x[j][3] * x[j][3]);
                ss = wave_sum_f(ss); const float rn = 1.0f / sqrtf(ss * (1.0f / DM) + RMS_EPS);
#pragma unroll
                for (int j = 0; j < 8; ++j) { const f32x4 hv = x[j] * rn * VB[lane + 64 * j] + VC[lane + 64 * j]; u32x2 w; w.x = pk2(hv[0], hv[1]); w.y = pk2(hv[2], hv[3]);
                    *((u32x2*)(hout + row * DM) + lane + 64 * j) = w; }
            }
        }
    }
}

#ifndef MX_ML
#define MX_ML 1
#endif
#ifndef MX_GLA
#define MX_GLA 1
#endif
#ifndef MX_S5
#define MX_S5 1
#endif
#ifndef MX_ATT
#define MX_ATT 1
#endif
#ifndef PH_G1
#define PH_G1 1
#endif
#ifndef PH_MIX
#define PH_MIX 1
#endif
#ifndef PH_G2
#define PH_G2 1
#endif
#ifndef PH_G3
#define PH_G3 1
#endif
#ifndef PH_G4
#define PH_G4 1
#endif
#ifndef PH_G5
#define PH_G5 1
#endif
#ifndef PH_N2
#define PH_N2 1
#endif
#ifndef PH_G6
#define PH_G6 1
#endif
#ifndef PH_G7
#define PH_G7 1
#endif
#ifndef PH_N3
#define PH_N3 1
#endif
__global__ void __launch_bounds__(512, 2) fwd_kernel(Args a) {
    extern __shared__ __attribute__((aligned(16))) unsigned char lds_raw[];
    LDSP lds = (LDSP)lds_raw;
    const int G = gridDim.x, wg = blockIdx.x;
#define ws WSB()
#define ctl ((unsigned*)(WSB() + WS_CTL))
    volatile LAS unsigned* MISC = (volatile LAS unsigned*)(lds + LDS_MISC);
    if (threadIdx.x < 64) MISC[threadIdx.x] = 0u;
    __syncthreads();
    XcdBarrier bar = xcd_barrier_post(ctl + CW_BAR, MISC);
    const int lo = a.ph_lo, hi = a.ph_hi;
    int ph = 0;
#define IN(k) (lo <= (k) && (k) < hi)
#define SEAM(k) do { if (IN(k) && IN((k) + 1)) xcd_barrier(bar); } while (0)
#define Hb ((bf16_t*)(ws + WS_H))
#define PROJ ((bf16_t*)(ws + WS_PROJ))
#define NAR ((float*)(ws + WS_NAR))
#define OALL ((bf16_t*)(ws + WS_OALL))
#define Zb ((bf16_t*)(ws + WS_Z))
#define Pb ((bf16_t*)(ws + WS_P))
#define MG ((bf16_t*)(ws + WS_MERGED))
#define MIXB ((bf16_t*)(ws + WS_MIXB))
#define Yb ((bf16_t*)(ws + WS_Y))
#define HID ((bf16_t*)(ws + WS_HID))

    if (IN(ph)) { mod_partials(lds, wg, G); __syncthreads(); convert_layer(0, lds, wg, G); }
    SEAM(ph); ++ph;
    if (IN(ph)) norm_phase(lds, wg, G, INP(I_X), nullptr, nullptr, 0, 0, 0, Hb, 0, 1, 0, 0);
    SEAM(ph); ++ph;

    for (int l = 0; l < NLAYER; ++l) {
        if (IN(ph) && PH_G1) { pg8::Gemm g{Hb, (const bf16_t*)(ws + WS_WIN), DM, DM, DM}; pg8::SchedPlain S{NMT, NPROJ / 256, G, wg}; pg8::EpiProj E{PROJ, NAR};
            pg8::gemm_phase<pg8::EpiProj, pg8::SchedPlain, true, true>((PG8_LAS unsigned char*)lds, g, S, E); }
        SEAM(ph); ++ph;
        if (IN(ph) && PH_MIX) {
            const int tid = OPAQUE_TID, lane = tid & 63, wave = __builtin_amdgcn_readfirstlane(tid >> 6);
            LAS float* biasT = (LAS float*)(lds + LDS_BIAS);
            if (tid < 512) { const int h = tid >> 7, d = tid & 127; biasT[tid] = INP(I_RELB)[T5_BUCKET[d] * 4 + h] * LOG2E; }
            const float* dl = INP(I_DLAM) + l * 256;
            const float s1 = wave_sum_f(dl[lane] * dl[64 + lane]), s2 = wave_sum_f(dl[128 + lane] * dl[192 + lane]);
            const float lam_init = 0.8f - 0.6f * __expf(-0.3f * (float)l), lam = __expf(s1) - __expf(s2) + lam_init;
            __syncthreads();
            if (MX_ML && wg < 16) mlstm_item(lds, PROJ, NAR, INP(I_MLCONV) + l * 4096, INP(I_MLGB) + l * 8, OALL, wg >> 2, wg & 3);
            else if (MX_GLA && wg < 32) gla_item(lds, PROJ, NAR, INP(I_GLAWA2) + l * 4096, INP(I_GLABA) + l * 256, OALL, (wg - 16) >> 2, (wg - 16) & 3);
            else if (MX_S5 && wg < 48) { const int pair = (wg - 32) * 8 + wave; s5_wave(lds + wave * S5_WAVE_LDS, PROJ, (const float*)(ws + WS_S5T), (const bf16_t*)(ws + WS_S5T + 65536), (const bf16_t*)(ws + WS_S5T + 65536 + 262144),
                                                                         INP(I_S5D) + l * 512, Zb, pair >> 5, pair & 31); }
            __syncthreads();
            for (;;) {
                if (tid == 0) MISC[16] = __hip_atomic_fetch_add(ctl + CW_Q + 64 * l, 1u, __ATOMIC_RELAXED, __HIP_MEMORY_SCOPE_AGENT);
                __syncthreads();
                const unsigned item = MISC[16];
                if (item >= (unsigned)(BATCH * 4 * (SEQ / 128))) break;
                const int qb = (SEQ / 128 - 1) - (int)(item / (BATCH * 4)), bh = (int)(item % (BATCH * 4));
                if (MX_ATT) attn_unit(lds, biasT, PROJ, OALL, lam, lam_init, bh >> 2, bh & 3, qb);
            }
        }
        SEAM(ph); ++ph;
        if (IN(ph) && PH_G2) { pg8::Gemm g{Zb, (const bf16_t*)(ws + WS_WGLU), 512, 512, 512}; pg8::SchedPlain S{NMT, 2, G, wg}; pg8::EpiGlu E{Zb, INP(I_GLUB) + l * 512, OALL};
            pg8::gemm_phase<pg8::EpiGlu, pg8::SchedPlain, true, true>((PG8_LAS unsigned char*)lds, g, S, E); }
        SEAM(ph); ++ph;
        if (IN(ph) && PH_G3) { pg8::Gemm g{OALL, (const bf16_t*)(ws + WS_WB), 512, DM, 512}; pg8::SchedP S{NMT, G, wg}; pg8::EpiPlain E{Pb, DM, 7, (size_t)M_TOK * DM};
            pg8::gemm_phase<pg8::EpiPlain, pg8::SchedP, true, true>((PG8_LAS unsigned char*)lds, g, S, E); }
        SEAM(ph); ++ph;
        if (IN(ph) && PH_G4) { pg8::Gemm g{Hb, (const bf16_t*)(ws + WS_WG), DM, DM, DM}; pg8::SchedGate S{NMT, G, wg}; pg8::EpiGate E{Pb, INP(I_BGATE) + (size_t)l * 4 * DM, (bf16_t*)(ws + WS_GSCR) + (size_t)wg * 65536, MG};
            pg8::gemm_phase<pg8::EpiGate, pg8::SchedGate, true, true>((PG8_LAS unsigned char*)lds, g, S, E); }
        SEAM(ph); ++ph;
        if (IN(ph) && PH_G5) { pg8::Gemm g{MG, (const bf16_t*)(ws + WS_WOUT), DM, DM, DM}; pg8::SchedPlain S{NMT, 8, G, wg}; pg8::EpiPlain E{MIXB, DM, 0xffff, 0};
            pg8::gemm_phase<pg8::EpiPlain, pg8::SchedPlain, true, true>((PG8_LAS unsigned char*)lds, g, S, E); }
        SEAM(ph); ++ph;
        if (IN(ph) && PH_N2) norm_phase(lds, wg, G, l == 0 ? INP(I_X) : OUTP(), OUTP(), MIXB, l, 2, 1, Hb, l, 4, 3, 2);
        SEAM(ph); ++ph;
        if (IN(ph) && PH_G6) { pg8::Gemm g{Hb, (const bf16_t*)(ws + WS_WFI), DM, DM, DM}; pg8::SchedPlain S{NMT, 2 * FFH / 256, G, wg}; pg8::EpiSwiglu E{HID};
            pg8::gemm_phase<pg8::EpiSwiglu, pg8::SchedPlain, true, true>((PG8_LAS unsigned char*)lds, g, S, E); }
        SEAM(ph); ++ph;
        if (IN(ph) && PH_G7) { pg8::Gemm g{HID, (const bf16_t*)(ws + WS_WFO), FFH, FFH, FFH}; pg8::SchedPlain S{NMT, 8, G, wg}; pg8::EpiPlain E{Yb, DM, 0xffff, 0};
            pg8::gemm_phase<pg8::EpiPlain, pg8::SchedPlain, true, true>((PG8_LAS unsigned char*)lds, g, S, E); }
        SEAM(ph); ++ph;
        if (IN(ph) && PH_N3) { norm_phase(lds, wg, G, OUTP(), OUTP(), Yb, l, 5, 3, (l + 1 < NLAYER) ? Hb : nullptr, l + 1, 1, 0, 0);
            if (l + 1 < NLAYER) { __syncthreads(); convert_layer(l + 1, lds, wg, G); } }
        SEAM(ph); ++ph;
    }
#undef IN
#undef SEAM
#undef ws
#undef ctl
#undef Hb
#undef PROJ
#undef NAR
#undef OALL
#undef Zb
#undef Pb
#undef MG
#undef MIXB
#undef Yb
#undef HID
}

#ifndef ONE_LAUNCH
#define ONE_LAUNCH 1
#endif
extern "C" void kernel_launch(void* const* d_in, const int* in_sizes, int n_in, void* d_out, int out_size, void* d_ws, size_t ws_size, hipStream_t stream) {
    static int grid = 0;
    if (grid == 0) {
        if (n_in != 28 || in_sizes[0] != M_TOK * DM || out_size != M_TOK * DM || ws_size < WS_END) { fprintf(stderr, "kernel_launch: unexpected shapes/workspace (n_in %d, ws %zu < %zu)\n", n_in, ws_size, (size_t)WS_END); grid = -1; return; }
        int dev = 0, cus = 0, per_cu = 0;
        if (hipGetDevice(&dev) != hipSuccess || hipDeviceGetAttribute(&cus, hipDeviceAttributeMultiprocessorCount, dev) != hipSuccess) { grid = -1; return; }
        if (hipFuncSetAttribute((const void*)fwd_kernel, hipFuncAttributeMaxDynamicSharedMemorySize, LDS_BYTES) != hipSuccess) { fprintf(stderr, "kernel_launch: hipFuncSetAttribute failed\n"); grid = -1; return; }
        if (hipOccupancyMaxActiveBlocksPerMultiprocessor(&per_cu, (const void*)fwd_kernel, 512, LDS_BYTES) != hipSuccess || per_cu < 1) fprintf(stderr, "kernel_launch: occupancy query says %d\n", per_cu);
        (void)hipGetLastError();
        grid = cus;
        if (grid > 256) grid = 256;
    }
    if (grid < 0) return;
    if (hipMemsetAsync((char*)d_ws + WS_CTL, 0, CTL_ZERO_BYTES, stream) != hipSuccess) return;
    Args a{};
    for (int i = 0; i < 28; ++i) a.in[i] = (const float*)d_in[i];
    a.out = (float*)d_out; a.ws = (unsigned char*)d_ws;
#if ONE_LAUNCH
    a.ph_lo = 0; a.ph_hi = N_PHASES;
    hipLaunchKernelGGL(fwd_kernel, dim3(grid), dim3(512), LDS_BYTES, stream, a);
#else
    for (int p = 0; p < N_PHASES; ++p) { a.ph_lo = p; a.ph_hi = p + 1; hipLaunchKernelGGL(fwd_kernel, dim3(grid), dim3(512), LDS_BYTES, stream, a); }
#endif
}
```

```cpp
#define ONE_LAUNCH 1

#include <hip/hip_runtime.h>
#include <cstdio>
#include <cstdint>
typedef unsigned short bf16_t;
typedef short bf16x8 __attribute__((ext_vector_type(8)));
typedef short s16x4 __attribute__((ext_vector_type(4)));
typedef float f32x4 __attribute__((ext_vector_type(4)));
typedef float f32x16 __attribute__((ext_vector_type(16)));
typedef unsigned u32x4 __attribute__((ext_vector_type(4)));
typedef unsigned u32x2 __attribute__((ext_vector_type(2)));

#ifdef HOST_EMU
#include <cmath>
#include <cstring>
#include <cstdint>
#include <pthread.h>
#define LAS
#define GAS
#define DEV static inline
#define GLOBAL_FN
struct EmuWave { pthread_barrier_t bar; float fa[64][8], fb[64][8]; uintptr_t addr[64]; float v[64]; };
struct EmuBlock { pthread_barrier_t bar; EmuWave wv[8]; };
extern EmuBlock* g_blk;
extern thread_local int emu_tid;
extern thread_local int emu_bid;
#define THREAD_IDX emu_tid
#define OPAQUE_TID emu_tid
DEV int opq(int x) { return x; }
#define BLOCK_IDX emu_bid
DEV void sync_threads() { pthread_barrier_wait(&g_blk->bar); }
DEV void wave_bar() { pthread_barrier_wait(&g_blk->wv[emu_tid >> 6].bar); }
DEV float bf2f(bf16_t b) { unsigned u = (unsigned)b << 16; float f; memcpy(&f, &u, 4); return f; }
DEV bf16_t f2bf(float f) { unsigned u; memcpy(&u, &f, 4); return (bf16_t)((u + 0x7fffu + ((u >> 16) & 1u)) >> 16); }
DEV f32x16 mfma32(bf16x8 a, bf16x8 b, f32x16 c) {
  EmuWave& w = g_blk->wv[emu_tid >> 6]; const int l = emu_tid & 63;
  for (int j = 0; j < 8; ++j) { w.fa[l][j] = bf2f((bf16_t)a[j]); w.fb[l][j] = bf2f((bf16_t)b[j]); }
  wave_bar();
  const int col = l & 31, hi = l >> 5;
  for (int i = 0; i < 16; ++i) { const int row = (i & 3) + 8 * (i >> 2) + 4 * hi; float s = c[i];
    for (int k = 0; k < 16; ++k) s += w.fa[row + 32 * (k >> 3)][k & 7] * w.fb[col + 32 * (k >> 3)][k & 7];
    c[i] = s; }
  wave_bar();
  return c;
}
DEV f32x4 mfma16(bf16x8 a, bf16x8 b, f32x4 c) {
  EmuWave& w = g_blk->wv[emu_tid >> 6]; const int l = emu_tid & 63;
  for (int j = 0; j < 8; ++j) { w.fa[l][j] = bf2f((bf16_t)a[j]); w.fb[l][j] = bf2f((bf16_t)b[j]); }
  wave_bar();
  const int col = l & 15, g = l >> 4;
  for (int i = 0; i < 4; ++i) { const int row = 4 * g + i; float s = c[i];
    for (int k = 0; k < 32; ++k) s += w.fa[row + 16 * (k >> 3)][k & 7] * w.fb[col + 16 * (k >> 3)][k & 7];
    c[i] = s; }
  wave_bar();
  return c;
}
DEV s16x4 lds_tr(const char* p) {
  EmuWave& w = g_blk->wv[emu_tid >> 6]; const int l = emu_tid & 63;
  w.addr[l] = (uintptr_t)p; wave_bar();
  const int g = l >> 4, i = l & 15; s16x4 r;
  for (int q = 0; q < 4; ++q) { const char* src = (const char*)w.addr[16 * g + 4 * q + (i >> 2)] + 2 * (i & 3); short s; memcpy(&s, src, 2); r[q] = s; }
  wave_bar();
  return r;
}
DEV float shfl_xor_f(float v, int m) { EmuWave& w = g_blk->wv[emu_tid >> 6]; const int l = emu_tid & 63; w.v[l] = v; wave_bar(); float r = w.v[l ^ m]; wave_bar(); return r; }
DEV float shfl_up_f(float v, int d) { EmuWave& w = g_blk->wv[emu_tid >> 6]; const int l = emu_tid & 63; w.v[l] = v; wave_bar(); float r = (l >= d) ? w.v[l - d] : v; wave_bar(); return r; }
DEV float shfl_idx_f(float v, int s) { EmuWave& w = g_blk->wv[emu_tid >> 6]; const int l = emu_tid & 63; w.v[l] = v; wave_bar(); float r = w.v[s]; wave_bar(); return r; }
DEV float fast_exp2(float x) { return exp2f(x); }
DEV float fast_rcp(float x) { return 1.0f / x; }
DEV float fast_rsq(float x) { return 1.0f / sqrtf(x); }
DEV int rfl(int x) { return x; }
DEV void wave_sync() { wave_bar(); }
DEV void sched_fence() {}
DEV const char* uptr(const void* q) { return (const char*)q; }
#define __expf expf
#else
#include <hip/hip_runtime.h>
#define LAS __attribute__((address_space(3)))
#define GAS __attribute__((address_space(1)))
#define DEV __device__ __forceinline__
#define THREAD_IDX ((int)threadIdx.x)
DEV int opaque_tid_() { int t = (int)threadIdx.x; asm volatile("" : "+v"(t)); return t; }
#define OPAQUE_TID opaque_tid_()
DEV int opq(int x) { asm volatile("" : "+v"(x)); return x; }
#define BLOCK_IDX ((int)blockIdx.x)
DEV void sync_threads() { __syncthreads(); }
DEV float bf2f(bf16_t b) { return __uint_as_float((unsigned)b << 16); }
DEV bf16_t f2bf(float f) { unsigned u = __float_as_uint(f); return (bf16_t)((u + 0x7fffu + ((u >> 16) & 1u)) >> 16); }
DEV f32x16 mfma32(bf16x8 a, bf16x8 b, f32x16 c) { return __builtin_amdgcn_mfma_f32_32x32x16_bf16(a, b, c, 0, 0, 0); }
DEV f32x4 mfma16(bf16x8 a, bf16x8 b, f32x4 c) { return __builtin_amdgcn_mfma_f32_16x16x32_bf16(a, b, c, 0, 0, 0); }
typedef short v4i16_t __attribute__((ext_vector_type(4)));
DEV s16x4 lds_tr(const LAS char* p) { return __builtin_bit_cast(s16x4, __builtin_amdgcn_ds_read_tr16_b64_v4i16((LAS v4i16_t*)p)); }
DEV float shfl_xor_f(float v, int m) { return __shfl_xor(v, m); }
DEV float shfl_up_f(float v, int d) { return __shfl_up(v, d); }
DEV float shfl_idx_f(float v, int s) { return __shfl(v, s); }
DEV float fast_exp2(float x) { return __builtin_amdgcn_exp2f(x); }
DEV float fast_rcp(float x) { return __builtin_amdgcn_rcpf(x); }
DEV float fast_rsq(float x) { return __builtin_amdgcn_rsqf(x); }
DEV int rfl(int x) { return __builtin_amdgcn_readfirstlane(x); }
DEV void wave_sync() { asm volatile("s_waitcnt lgkmcnt(0)" ::: "memory"); }
DEV void sched_fence() { __builtin_amdgcn_sched_barrier(0); }
DEV const GAS char* uptr(const void* q) { const unsigned long long v = (unsigned long long)q; const unsigned lo = __builtin_amdgcn_readfirstlane((unsigned)v), hi = __builtin_amdgcn_readfirstlane((unsigned)(v >> 32)); return (const GAS char*)(((unsigned long long)hi << 32) | lo); }
#endif
typedef LAS char* LDSP;
DEV unsigned pk2(float lo, float hi) { return (unsigned)f2bf(lo) | ((unsigned)f2bf(hi) << 16); }
DEV int crow(int i, int hi) { return (i & 3) + 8 * (i >> 2) + 4 * hi; }
DEV unsigned offb(unsigned row, unsigned ch) { return 256u * row + 16u * (ch ^ (((row & 3u) << 2) | ((row >> 2) & 3u))); }
DEV bf16x8 lds_ld8(LDSP p) { return *(const LAS bf16x8*)p; }
DEV bf16x8 frag_row(LDSP tile, int rb, int ks, int lane) { return lds_ld8(tile + offb(rb + (lane & 31), 2 * ks + (lane >> 5))); }
DEV bf16x8 frag_tr(LDSP tile, int cb, int ks, int lane, bool perm) {
  const int h2 = lane >> 5, blk = (lane >> 4) & 1, q = (lane & 15) >> 2, p = lane & 3;
  const int r0 = perm ? (16 * ks + 4 * h2) : (16 * ks + 8 * h2), dr = perm ? 8 : 4;
  const unsigned ch = 4 * cb + 2 * blk + (p >> 1), bo = 8 * (p & 1);
  const s16x4 a = lds_tr(tile + offb(r0 + q, ch) + bo), b = lds_tr(tile + offb(r0 + dr + q, ch) + bo);
  return (bf16x8){a[0], a[1], a[2], a[3], b[0], b[1], b[2], b[3]};
}
DEV bf16x8 acc_frag(const f32x16& x, int s) {
  u32x4 w; w.x = pk2(x[8 * s + 0], x[8 * s + 1]); w.y = pk2(x[8 * s + 2], x[8 * s + 3]); w.z = pk2(x[8 * s + 4], x[8 * s + 5]); w.w = pk2(x[8 * s + 6], x[8 * s + 7]);
  return __builtin_bit_cast(bf16x8, w);
}
#ifndef SEQ
#define SEQ 8192
#endif
#ifndef BATCH
#define BATCH 4
#endif
constexpr int M_TOK = BATCH * SEQ, PW = 5632, OW = 2048, NCH = SEQ / 64;
constexpr int C_DAQ = 0, C_DAK = 512, C_DAV = 1024, C_MLQ = 1536, C_MLK = 2048, C_MLV = 2560, C_MLO = 3072, C_GLQ = 3584, C_GLK = 3840, C_GLV = 4096, C_GLR = 4608, C_S5U = 5120;
constexpr int NW_MLI = 0, NW_MLF = 4, NW_GLA = 8, NWP = 32;
constexpr float LOG2E = 1.4426950408889634f, RMS_EPS = 1e-6f;
#define NEG_INF (-__builtin_inff())

DEV float sigmoidf_(float x) { return fast_rcp(1.0f + fast_exp2(-x * LOG2E)); }
DEV float log_sigmoidf_(float x) {
  const float ax = x < 0.f ? -x : x; return (x < 0.f ? x : 0.f) - log1pf(__expf(-ax)); }
DEV float wave_sum_f(float v) { for (int o = 1; o < 64; o <<= 1) v += shfl_xor_f(v, o); return v; }

DEV void attn_unit(LDSP lds, const LAS float* biasT, const bf16_t* __restrict__ proj, bf16_t* __restrict__ oall, float lam, float lam_init, int b, int h, int qb) {
  const int tid = OPAQUE_TID, lane = tid & 63, wave = rfl(tid >> 6), l31 = lane & 31, h2 = lane >> 5;
  const int mp = wave >> 2, wq = wave & 3, q0 = qb * 128, r0 = q0 + 32 * wq;
  const size_t rowbase = (size_t)b * SEQ;
  bf16x8 qf[4];
  { const bf16_t* qp = proj + (rowbase + r0 + l31) * PW + C_DAQ + h * 128 + mp * 64 + 8 * h2;
#pragma unroll
    for (int ks = 0; ks < 4; ++ks) qf[ks] = *(const bf16x8*)(qp + 16 * ks); }
  f32x16 o[4];
#pragma unroll
  for (int c = 0; c < 4; ++c)
#pragma unroll
    for (int i = 0; i < 16; ++i) o[c][i] = 0.f;
  float mrun = NEG_INF, lpart = 0.f;
  const int nt = 2 * qb + 2, tlast = (r0 + 31) >> 6;
  const float scale2 = 0.125f * LOG2E;
  const LAS float* bt = biasT + h * 128;
  u32x4 rk[2], rv[2];
  const bf16_t* gk = proj + rowbase * PW + C_DAK + h * 128; const bf16_t* gv = proj + rowbase * PW + C_DAV + h * 128;
#define ATT_LOAD(t) do { _Pragma("unroll") for (int i = 0; i < 2; ++i) { const int id = tid + 512 * i, row = id >> 4, ch = id & 15; \
    rk[i] = *(const u32x4*)(gk + (size_t)(64 * (t) + row) * PW + ch * 8); rv[i] = *(const u32x4*)(gv + (size_t)(64 * (t) + row) * PW + ch * 8); } } while (0)
#define ATT_STORE(buf) do { _Pragma("unroll") for (int i = 0; i < 2; ++i) { const int id = tid + 512 * i, row = id >> 4, ch = id & 15; \
    *(LAS u32x4*)(lds + (buf) * 16384 + offb(row, ch)) = rk[i]; *(LAS u32x4*)(lds + 32768 + (buf) * 16384 + offb(row, ch)) = rv[i]; } } while (0)
  ATT_LOAD(0); ATT_STORE(0); sync_threads();
  for (int t = 0; t < nt; ++t) {
    if (t + 1 < nt) ATT_LOAD(t + 1);
    if (t <= tlast) {
      LDSP Kt = lds + (t & 1) * 16384, Vt = lds + 32768 + (t & 1) * 16384;
      f32x16 p[2];
#pragma unroll
      for (int kb = 0; kb < 2; ++kb) {
#pragma unroll
        for (int i = 0; i < 16; ++i) p[kb][i] = 0.f;
#pragma unroll
        for (int ks = 0; ks < 4; ++ks) p[kb] = mfma32(frag_row(Kt, 32 * kb, 4 * mp + ks, lane), qf[ks], p[kb]);
      }
      const int qabs = r0 + l31, j0 = 64 * t;
      const bool far = (r0 - (j0 + 63)) >= 127;
      const float bfar = bt[127];
      float mx = NEG_INF;
#pragma unroll
      for (int kb = 0; kb < 2; ++kb)
#pragma unroll
        for (int i = 0; i < 16; ++i) {
          const int dist = qabs - (j0 + 32 * kb + crow(i, h2));
          float bv = bfar; if (!far) bv = bt[dist < 0 ? 0 : (dist > 127 ? 127 : dist)];
          float s = p[kb][i] * scale2 + bv; if (dist < 0) s = NEG_INF;
          p[kb][i] = s; mx = fmaxf(mx, s);
        }
      mx = fmaxf(mx, shfl_xor_f(mx, 32));
      const float mnew = fmaxf(mrun, mx), alpha = fast_exp2(mrun - mnew);
      mrun = mnew;
      float rs = 0.f;
#pragma unroll
      for (int kb = 0; kb < 2; ++kb)
#pragma unroll
        for (int i = 0; i < 16; ++i) { const float e = fast_exp2(p[kb][i] - mnew); p[kb][i] = e; rs += e; }
      lpart = lpart * alpha + rs;
#pragma unroll
      for (int c = 0; c < 4; ++c)
#pragma unroll
        for (int i = 0; i < 16; ++i) o[c][i] *= alpha;
#pragma unroll
      for (int ks = 0; ks < 4; ++ks) {
        const bf16x8 pf = acc_frag(p[ks >> 1], ks & 1);
#pragma unroll
        for (int c = 0; c < 4; ++c) o[c] = mfma32(frag_tr(Vt, c, ks, lane, true), pf, o[c]);
      }
    }
    if (t + 1 < nt) ATT_STORE((t + 1) & 1);
    sync_threads();
  }
#undef ATT_LOAD
#undef ATT_STORE
  { const float ltot = lpart + shfl_xor_f(lpart, 32), inv = 1.0f / ltot;
#pragma unroll
    for (int c = 0; c < 4; ++c)
#pragma unroll
      for (int i = 0; i < 16; ++i) o[c][i] *= inv; }
  LAS float* X = (LAS float*)lds;
  if (mp == 1) {
#pragma unroll
    for (int c = 0; c < 4; ++c)
#pragma unroll
      for (int i = 0; i < 16; ++i) X[((wq * 4 + c) * 16 + i) * 64 + lane] = o[c][i];
  }
  sync_threads();
  if (mp == 0) {
    float ss = 0.f;
#pragma unroll
    for (int c = 0; c < 4; ++c)
#pragma unroll
      for (int i = 0; i < 16; ++i) { const float d = o[c][i] - lam * X[((wq * 4 + c) * 16 + i) * 64 + lane]; o[c][i] = d; ss += d * d; }
    ss += shfl_xor_f(ss, 32);
    const float r = (1.0f - lam_init) / sqrtf(ss * (1.0f / 128.0f) + RMS_EPS);
    bf16_t* op = oall + (rowbase + r0 + l31) * OW + 0 + h * 128 + 4 * h2;
#pragma unroll
    for (int c = 0; c < 4; ++c)
#pragma unroll
      for (int g = 0; g < 4; ++g) { u32x2 w; w.x = pk2(o[c][4 * g] * r, o[c][4 * g + 1] * r); w.y = pk2(o[c][4 * g + 2] * r, o[c][4 * g + 3] * r);
        *(u32x2*)(op + 32 * c + 8 * g) = w; }
  }
  sync_threads();
}

DEV void mlstm_item(LDSP lds, const bf16_t* __restrict__ proj, const float* __restrict__ narrow, const float* __restrict__ convw  , const float* __restrict__ gateb  ,
                    bf16_t* __restrict__ oall, int b, int h) {
  const int tid0 = OPAQUE_TID, wave = rfl(tid0 >> 6);
#define ML_LANES() const int tid = opq(tid0), lane = tid & 63, l31 = lane & 31, h2 = lane >> 5; (void)l31; (void)h2; (void)lane
  LDSP Qt = lds, Kt = lds + 16384, Vt = lds + 32768, KWt = lds + 49152, Ct = lds + 65536;
  LAS float* F = (LAS float*)(lds + 106496);
  LAS float *U = F, *Mv = F + 64, *AT = F + 128, *EM = F + 192, *WJ = F + 256, *QN = F + 320, *SC = F + 384, *NV = F + 392, *CW = F + 520;
  const size_t rowbase = (size_t)b * SEQ;
  { ML_LANES();
    for (int i = tid; i < 40960 / 4; i += 512) ((LAS unsigned*)Ct)[i] = 0u;
    if (tid < 128) NV[tid] = 0.f;
    for (int i = tid; i < 1024; i += 512) { const int j = i >> 8, r = i & 255; CW[i] = convw[j * 1024 + (r >> 7) * 512 + h * 128 + (r & 127)]; }
  }
  const float gb0 = gateb[h], gb1 = gateb[4 + h];
  f32x16 cst[2];
#pragma unroll
  for (int x = 0; x < 2; ++x)
#pragma unroll
    for (int i = 0; i < 16; ++i) cst[x][i] = 0.f;
  float mprev = 0.f;
  const int eb = wave & 3, tb = wave >> 2;
  bf16x8 rqk[11]; u32x4 rvv[4]; float rig = 0.f, rfg = 0.f;
#define ML_PREFETCH(chn) do { ML_LANES(); const size_t t0n = rowbase + (size_t)(chn) * 64; const GAS char* pb = uptr(proj + (t0n - 3) * PW); \
    if (tid < 256) { const int which = (tid >> 7) & 1, dch = tid & 15, tg = (tid & 127) >> 4; unsigned voff = (unsigned)((tg * 8) * PW + (which ? C_MLK : C_MLQ) + h * 128 + dch * 8) * 2u; \
      _Pragma("unroll") for (int r = 0; r < 11; ++r) { bf16x8 v = (bf16x8){0, 0, 0, 0, 0, 0, 0, 0}; if ((chn) * 64 + tg * 8 - 3 + r >= 0) v = *(const GAS bf16x8*)(pb + voff); rqk[r] = v; voff += PW * 2; } } \
    else { const int t2 = tid - 256; _Pragma("unroll") for (int i = 0; i < 4; ++i) { const int id = t2 + 256 * i, row = id >> 4, c16 = id & 15; rvv[i] = *(const GAS u32x4*)(pb + (unsigned)((row + 3) * PW + C_MLV + h * 128 + c16 * 8) * 2u); } } \
    if (wave == 0) { const GAS char* nb = uptr(narrow + t0n * NWP); rig = *(const GAS float*)(nb + (unsigned)(lane * NWP + NW_MLI + h) * 4u); rfg = *(const GAS float*)(nb + (unsigned)(lane * NWP + NW_MLF + h) * 4u); } } while (0)
  ML_PREFETCH(0);
  sync_threads();
  for (int ch = 0; ch < NCH; ++ch) {
    const size_t t0 = rowbase + (size_t)ch * 64;
    const GAS char* pbase = uptr(proj + (t0 - 3) * PW);
    { ML_LANES();
      if (tid < 256) {
        const int which = (tid >> 7) & 1, dch = tid & 15, tg = (tid & 127) >> 4;
        float cw[4][8];
#pragma unroll
        for (int j = 0; j < 4; ++j) { const f32x4 a = *(const LAS f32x4*)(CW + j * 256 + which * 128 + dch * 8), c = *(const LAS f32x4*)(CW + j * 256 + which * 128 + dch * 8 + 4);
          cw[j][0] = a[0]; cw[j][1] = a[1]; cw[j][2] = a[2]; cw[j][3] = a[3]; cw[j][4] = c[0]; cw[j][5] = c[1]; cw[j][6] = c[2]; cw[j][7] = c[3]; }
        float win[3][8];
#pragma unroll
        for (int r = 0; r < 3; ++r)
#pragma unroll
          for (int d = 0; d < 8; ++d) win[r][d] = bf2f((bf16_t)rqk[r][d]);
        const float osc = which ? 0.08838834764831845f : 1.0f;
        LDSP dstT = which ? Kt : Qt;
#pragma unroll
        for (int r = 0; r < 8; ++r) {
          float cur[8], y[8];
#pragma unroll
          for (int d = 0; d < 8; ++d) { cur[d] = bf2f((bf16_t)rqk[3 + r][d]); const float a = cw[0][d] * win[0][d] + cw[1][d] * win[1][d] + cw[2][d] * win[2][d] + cw[3][d] * cur[d];
            y[d] = a * sigmoidf_(a) * osc; win[0][d] = win[1][d]; win[1][d] = win[2][d]; win[2][d] = cur[d]; }
          u32x4 w; w.x = pk2(y[0], y[1]); w.y = pk2(y[2], y[3]); w.z = pk2(y[4], y[5]); w.w = pk2(y[6], y[7]);
          *(LAS u32x4*)(dstT + offb(tg * 8 + r, dch)) = w;
        }
      } else {
        const int t2 = tid - 256;
#pragma unroll
        for (int i = 0; i < 4; ++i) { const int id = t2 + 256 * i, row = id >> 4, c16 = id & 15; *(LAS u32x4*)(Vt + offb(row, c16)) = rvv[i]; }
      }
      if (wave == 0) {
        const float ig = rig + gb0;
        const float lf = log_sigmoidf_(rfg + gb1);
        float bsum = lf;
#pragma unroll
        for (int d = 1; d < 64; d <<= 1) { const float o_ = shfl_up_f(bsum, d); if (lane >= d) bsum += o_; }
        const float u = ig - bsum; float pm = u;
#pragma unroll
        for (int d = 1; d < 64; d <<= 1) { const float o_ = shfl_up_f(pm, d); if (lane >= d) pm = fmaxf(pm, o_); }
        const float Mt = fmaxf(mprev, pm);
        const float Mlast = shfl_idx_f(Mt, 63), blast = shfl_idx_f(bsum, 63);
        U[lane] = u; Mv[lane] = Mt; AT[lane] = __expf(mprev - Mt); EM[lane] = __expf(-(bsum + Mt)); WJ[lane] = __expf(u - Mlast);
        if (lane == 0) SC[0] = __expf(mprev - Mlast);
        mprev = blast + Mlast;
      }
    }
    if (ch + 1 < NCH) ML_PREFETCH(ch + 1);
    sync_threads();
    { ML_LANES();
#pragma unroll
      for (int i = 0; i < 2; ++i) { const int id = tid + 512 * i, row = id >> 4, c16 = id & 15; const float wj = WJ[row];
        const bf16x8 v = lds_ld8(Kt + offb(row, c16)); u32x4 w;
        w.x = pk2(bf2f((bf16_t)v[0]) * wj, bf2f((bf16_t)v[1]) * wj); w.y = pk2(bf2f((bf16_t)v[2]) * wj, bf2f((bf16_t)v[3]) * wj);
        w.z = pk2(bf2f((bf16_t)v[4]) * wj, bf2f((bf16_t)v[5]) * wj); w.w = pk2(bf2f((bf16_t)v[6]) * wj, bf2f((bf16_t)v[7]) * wj);
        *(LAS u32x4*)(KWt + offb(row, c16)) = w; }
    }
    sync_threads();
    if (eb == 0) {
      ML_LANES();
      f32x16 qn;
#pragma unroll
      for (int i = 0; i < 16; ++i) qn[i] = 0.f;
#pragma unroll
      for (int ks = 0; ks < 8; ++ks) qn = mfma32(frag_row(Ct, 128, ks, lane), frag_row(Qt, 32 * tb, ks, lane), qn);
      if (h2 == 0) QN[32 * tb + l31] = qn[0];
    }
    f32x16 acc;
    { ML_LANES();
#pragma unroll
      for (int i = 0; i < 16; ++i) acc[i] = 0.f;
#pragma unroll
      for (int ks = 0; ks < 8; ++ks) acc = mfma32(frag_row(Ct, 32 * eb, ks, lane), frag_row(Qt, 32 * tb, ks, lane), acc);
    }
    float rsum = 0.f;
#pragma unroll
    for (int jb = 0; jb < 2; ++jb) {
      if (jb <= tb) {
        ML_LANES();
        const int tl = 32 * tb + l31; const float Mt = Mv[tl];
        if (jb == 0) { const float at = AT[tl];
#pragma unroll
          for (int i = 0; i < 16; ++i) acc[i] *= at; }
        f32x16 s;
#pragma unroll
        for (int i = 0; i < 16; ++i) s[i] = 0.f;
#pragma unroll
        for (int ks = 0; ks < 8; ++ks) s = mfma32(frag_row(Kt, 32 * jb, ks, lane), frag_row(Qt, 32 * tb, ks, lane), s);
#pragma unroll
        for (int i = 0; i < 16; ++i) { const int j = 32 * jb + crow(i, h2); const float w = (j <= tl) ? __expf(U[j] - Mt) : 0.f; s[i] *= w; rsum += s[i]; }
#pragma unroll
        for (int s2 = 0; s2 < 2; ++s2) acc = mfma32(frag_tr(Vt, eb, 2 * jb + s2, lane, true), acc_frag(s, s2), acc);
      }
    }
    rsum += shfl_xor_f(rsum, 32);
    sync_threads();
    { ML_LANES();
      const int tl = 32 * tb + l31;
      const float den = AT[tl] * QN[tl] + rsum; const float dd = fmaxf(fabsf(den), EM[tl]); const float inv = 1.0f / dd;
      const GAS char* og = pbase + (unsigned)((tl + 3) * PW + C_MLO + h * 128 + 32 * eb + 4 * h2) * 2u; GAS char* op = (GAS char*)uptr(oall + t0 * OW) + (unsigned)(tl * OW + 512 + h * 128 + 32 * eb + 4 * h2) * 2u;
#pragma unroll
      for (int g = 0; g < 4; ++g) { const u32x2 gv2 = *(const GAS u32x2*)(og + 16 * g);
        const float g0 = sigmoidf_(bf2f((bf16_t)(gv2.x & 0xffff))), g1 = sigmoidf_(bf2f((bf16_t)(gv2.x >> 16))), g2 = sigmoidf_(bf2f((bf16_t)(gv2.y & 0xffff))), g3 = sigmoidf_(bf2f((bf16_t)(gv2.y >> 16)));
        u32x2 w; w.x = pk2(acc[4 * g] * inv * g0, acc[4 * g + 1] * inv * g1); w.y = pk2(acc[4 * g + 2] * inv * g2, acc[4 * g + 3] * inv * g3);
        *(GAS u32x2*)(op + 16 * g) = w; }
    }
    { ML_LANES();
      const float ast = SC[0]; const int db = wave >> 1;
#pragma unroll
      for (int x = 0; x < 2; ++x)
#pragma unroll
        for (int i = 0; i < 16; ++i) cst[x][i] *= ast;
#pragma unroll
      for (int ks = 0; ks < 4; ++ks) { const bf16x8 af = frag_tr(KWt, db, ks, lane, false);
#pragma unroll
        for (int x = 0; x < 2; ++x) cst[x] = mfma32(af, frag_tr(Vt, 2 * (wave & 1) + x, ks, lane, false), cst[x]); }
#pragma unroll
      for (int x = 0; x < 2; ++x) { const int e = 32 * (2 * (wave & 1) + x) + l31;
#pragma unroll
        for (int g = 0; g < 4; ++g) { const int d = 32 * db + 8 * g + 4 * h2; u32x2 w; w.x = pk2(cst[x][4 * g], cst[x][4 * g + 1]); w.y = pk2(cst[x][4 * g + 2], cst[x][4 * g + 3]);
          *(LAS u32x2*)(Ct + offb(e, d >> 3) + (d & 7) * 2) = w; } }
    }
    if ((wave & 1) == 0) {
      ML_LANES(); const int db = wave >> 1; const float ast = SC[0];
      const bf16x8 ones = (bf16x8){0x3f80, 0x3f80, 0x3f80, 0x3f80, 0x3f80, 0x3f80, 0x3f80, 0x3f80};
      f32x16 cs;
#pragma unroll
      for (int i = 0; i < 16; ++i) cs[i] = 0.f;
#pragma unroll
      for (int ks = 0; ks < 4; ++ks) cs = mfma32(frag_tr(KWt, db, ks, lane, false), ones, cs);
      if (l31 == 0) {
#pragma unroll
        for (int i = 0; i < 16; ++i) { const int d = 32 * db + crow(i, h2); const float nn = ast * NV[d] + cs[i]; NV[d] = nn; *(LAS bf16_t*)(Ct + offb(128, d >> 3) + (d & 7) * 2) = f2bf(nn); } }
    }
    sync_threads();
  }
#undef ML_LANES
#undef ML_PREFETCH
}

constexpr int ST_PITCH = 144;
DEV void gla_item(LDSP lds, const bf16_t* __restrict__ proj, const float* __restrict__ narrow, const float* __restrict__ wa2  , const float* __restrict__ ba  ,
                  bf16_t* __restrict__ oall, int b, int h) {
  const int tid = OPAQUE_TID, lane = tid & 63, wave = rfl(tid >> 6), l31 = lane & 31, h2 = lane >> 5;
  LDSP QKt = lds, KWt = lds + 16384, Vt = lds + 32768, St = lds + 49152;
  LAS float* F = (LAS float*)(lds + 69632);
  LAS float *GA = F, *TOT = F + 1024, *EL = F + 1536, *SS = F + 1600;
  const size_t rowbase = (size_t)b * SEQ;
  for (int i = tid; i < 128 * ST_PITCH / 4; i += 512) ((LAS unsigned*)St)[i] = 0u;
  for (int i = tid; i < 16384 / 4; i += 512) ((LAS unsigned*)KWt)[i] = 0u;
  const int d = tid & 63, tg = tid >> 6;
  float wcol[16];
#pragma unroll
  for (int r = 0; r < 16; ++r) wcol[r] = wa2[r * 256 + h * 64 + d];
  const float bad = ba[h * 64 + d];
  f32x16 sst;
#pragma unroll
  for (int i = 0; i < 16; ++i) sst[i] = 0.f;
  const int eb = wave & 3, tb = wave >> 2;
  float rga[2]; u32x4 rvv[2]; bf16_t rq[8], rk[8];
#define GLA_PREFETCH(chn) do { const size_t t0n = rowbase + (size_t)(chn) * 64; const GAS char* pb = uptr(proj + t0n * PW); const GAS char* nb = uptr(narrow + t0n * NWP); \
    { const int id = tid * 2, row = id >> 4, c = id & 15; const GAS float* gp = (const GAS float*)(nb + (unsigned)(row * NWP + NW_GLA + c) * 4u); rga[0] = gp[0]; rga[1] = gp[1]; } \
    _Pragma("unroll") for (int i = 0; i < 2; ++i) { const int id = tid + 512 * i, row = id >> 4, c16 = id & 15; rvv[i] = *(const GAS u32x4*)(pb + (unsigned)(row * PW + C_GLV + h * 128 + c16 * 8) * 2u); } \
    _Pragma("unroll") for (int r = 0; r < 8; ++r) { const unsigned o = (unsigned)((8 * tg + r) * PW + h * 64 + d) * 2u; rq[r] = *(const GAS bf16_t*)(pb + o + C_GLQ * 2); rk[r] = *(const GAS bf16_t*)(pb + o + C_GLK * 2); } } while (0)
  GLA_PREFETCH(0);
  sync_threads();
  for (int ch = 0; ch < NCH; ++ch) {
    const size_t t0 = rowbase + (size_t)ch * 64;
    { const int id = tid * 2; GA[id] = rga[0]; GA[id + 1] = rga[1]; }
#pragma unroll
    for (int i = 0; i < 2; ++i) { const int id = tid + 512 * i, row = id >> 4, c16 = id & 15; *(LAS u32x4*)(Vt + offb(row, c16)) = rvv[i]; }
    float qraw[8], kraw8[8];
#pragma unroll
    for (int r = 0; r < 8; ++r) { qraw[r] = bf2f(rq[r]); kraw8[r] = bf2f(rk[r]); }
    if (ch + 1 < NCH) GLA_PREFETCH(ch + 1);
    sync_threads();
    float bc[8], tot = 0.f;
#pragma unroll
    for (int r = 0; r < 8; ++r) { const int t = 8 * tg + r; float z = bad;
#pragma unroll
      for (int k = 0; k < 16; ++k) z += GA[t * 16 + k] * wcol[k];
      tot += log_sigmoidf_(z) * 0.0625f; bc[r] = tot; }
    TOT[tg * 64 + d] = tot;
    sync_threads();
    float off = 0.f, last = 0.f;
#pragma unroll
    for (int g = 0; g < 8; ++g) { const float v = TOT[g * 64 + d]; if (g < tg) off += v; last += v; }
    if (tg == 0) EL[d] = __expf(last);
#pragma unroll
    for (int r = 0; r < 8; ++r) { const int t = 8 * tg + r; const float bcv = bc[r] + off;
      const float qv = qraw[r] * 0.125f * __expf(bcv);
      const float kraw = kraw8[r];
      *(LAS bf16_t*)(QKt + offb(t, d >> 3) + (d & 7) * 2) = f2bf(qv);
      *(LAS bf16_t*)(QKt + offb(t, 8 + (d >> 3)) + (d & 7) * 2) = f2bf(kraw * __expf(-bcv));
      *(LAS bf16_t*)(KWt + offb(t, d >> 3) + (d & 7) * 2) = f2bf(kraw * __expf(last - bcv)); }
    sync_threads();
    f32x16 acc;
#pragma unroll
    for (int i = 0; i < 16; ++i) acc[i] = 0.f;
#pragma unroll
    for (int ks = 0; ks < 4; ++ks) acc = mfma32(lds_ld8(St + (32 * eb + l31) * ST_PITCH + (16 * ks + 8 * h2) * 2), frag_row(QKt, 32 * tb, ks, lane), acc);
    const int tl = 32 * tb + l31;
#pragma unroll
    for (int jb = 0; jb < 2; ++jb) {
      if (jb <= tb) {
        f32x16 s;
#pragma unroll
        for (int i = 0; i < 16; ++i) s[i] = 0.f;
#pragma unroll
        for (int ks = 0; ks < 4; ++ks) s = mfma32(frag_row(QKt, 32 * jb, 4 + ks, lane), frag_row(QKt, 32 * tb, ks, lane), s);
#pragma unroll
        for (int i = 0; i < 16; ++i) { const int j = 32 * jb + crow(i, h2); if (j > tl) s[i] = 0.f; }
#pragma unroll
        for (int s2 = 0; s2 < 2; ++s2) acc = mfma32(frag_tr(Vt, eb, 2 * jb + s2, lane, true), acc_frag(s, s2), acc);
      }
    }
    float ss = 0.f;
#pragma unroll
    for (int i = 0; i < 16; ++i) ss += acc[i] * acc[i];
    ss += shfl_xor_f(ss, 32);
    if (h2 == 0) SS[eb * 64 + tl] = ss;
    sync_threads();
    {
      const float tot2 = SS[tl] + SS[64 + tl] + SS[128 + tl] + SS[192 + tl]; const float r = 1.0f / sqrtf(tot2 * (1.0f / 128.0f) + RMS_EPS);
      const size_t row = t0 + tl; const bf16_t* gr = proj + row * PW + C_GLR + h * 128 + 32 * eb + 4 * h2; bf16_t* op = oall + row * OW + 1024 + h * 128 + 32 * eb + 4 * h2;
#pragma unroll
      for (int g = 0; g < 4; ++g) { const u32x2 gv2 = *(const u32x2*)(gr + 8 * g);
        const float r0 = bf2f((bf16_t)(gv2.x & 0xffff)), r1 = bf2f((bf16_t)(gv2.x >> 16)), r2 = bf2f((bf16_t)(gv2.y & 0xffff)), r3 = bf2f((bf16_t)(gv2.y >> 16));
        u32x2 w; w.x = pk2(acc[4 * g] * r * r0 * sigmoidf_(r0), acc[4 * g + 1] * r * r1 * sigmoidf_(r1)); w.y = pk2(acc[4 * g + 2] * r * r2 * sigmoidf_(r2), acc[4 * g + 3] * r * r3 * sigmoidf_(r3));
        *(u32x2*)(op + 8 * g) = w; }
    }
    { const int db = wave >> 2;
#pragma unroll
      for (int i = 0; i < 16; ++i) sst[i] *= EL[32 * db + crow(i, h2)];
#pragma unroll
      for (int ks = 0; ks < 4; ++ks) sst = mfma32(frag_tr(KWt, db, ks, lane, false), frag_tr(Vt, eb, ks, lane, false), sst);
      const int e = 32 * eb + l31;
#pragma unroll
      for (int g = 0; g < 4; ++g) { const int dd = 32 * db + 8 * g + 4 * h2; u32x2 w; w.x = pk2(sst[4 * g], sst[4 * g + 1]); w.y = pk2(sst[4 * g + 2], sst[4 * g + 3]);
        *(LAS u32x2*)(St + e * ST_PITCH + dd * 2) = w; } }
    sync_threads();
  }
#undef GLA_PREFETCH
}

constexpr int S5_WAVE_LDS = 12800, XS_PITCH = 272;
DEV float gelu_tanh_(float y) { const float u = 0.7978845608028654f * (y + 0.044715f * y * y * y); const float e = fast_exp2(2.0f * LOG2E * u); const float th = 1.0f - 2.0f * fast_rcp(e + 1.0f); return 0.5f * y * (1.0f + th); }
DEV void s5_wave(LDSP wl, const bf16_t* __restrict__ proj, const float* __restrict__ AB, const bf16_t* __restrict__ BT, const bf16_t* __restrict__ CT, const float* __restrict__ dskip  ,
                 bf16_t* __restrict__ zout  , int b, int g) {
  const int lane = OPAQUE_TID & 63, l15 = lane & 15, kg = lane >> 4;
  LAS float* BU = (LAS float*)wl; LDSP XS = wl + 8192;
  const float are = AB[(g * 64 + lane) * 2], aim = AB[(g * 64 + lane) * 2 + 1];
  bf16x8 bfr[8], cfr[4]; const bf16x8 zero8 = (bf16x8){0, 0, 0, 0, 0, 0, 0, 0};
#pragma unroll
  for (int nb = 0; nb < 8; ++nb) bfr[nb] = (kg < 2) ? *(const bf16x8*)(BT + ((size_t)g * 128 + 16 * nb + l15) * 16 + 8 * kg) : zero8;
#pragma unroll
  for (int ks = 0; ks < 4; ++ks) cfr[ks] = *(const bf16x8*)(CT + ((size_t)g * 16 + l15) * 128 + 32 * ks + 8 * kg);
  const float dsk = dskip[g * 16 + l15];
  float xr = 0.f, xi = 0.f;
  const size_t rowbase = (size_t)b * SEQ;
  for (int t0 = 0; t0 < SEQ; t0 += 16) {
    const bf16_t* up = proj + (rowbase + t0) * PW + C_S5U + g * 16;
    const bf16x8 ua = (kg < 2) ? *(const bf16x8*)(up + (size_t)l15 * PW + 8 * kg) : zero8;
#pragma unroll
    for (int nb = 0; nb < 8; ++nb) { f32x4 c4 = (f32x4){0.f, 0.f, 0.f, 0.f}; c4 = mfma16(ua, bfr[nb], c4);
#pragma unroll
      for (int i = 0; i < 4; ++i) BU[(4 * kg + i) * 128 + 16 * nb + l15] = c4[i]; }
    wave_sync();
#pragma unroll
    for (int j = 0; j < 16; ++j) { const float br = BU[j * 128 + lane], bi = BU[j * 128 + 64 + lane];
      const float nr = are * xr - aim * xi + br, ni = are * xi + aim * xr + bi; xr = nr; xi = ni;
      *(LAS bf16_t*)(XS + j * XS_PITCH + lane * 2) = f2bf(xr); *(LAS bf16_t*)(XS + j * XS_PITCH + (64 + lane) * 2) = f2bf(xi); }
    wave_sync();
    f32x4 y4 = (f32x4){0.f, 0.f, 0.f, 0.f};
#pragma unroll
    for (int ks = 0; ks < 4; ++ks) y4 = mfma16(lds_ld8(XS + l15 * XS_PITCH + (32 * ks + 8 * kg) * 2), cfr[ks], y4);
#pragma unroll
    for (int i = 0; i < 4; ++i) { const size_t row = rowbase + t0 + 4 * kg + i; const float uu = bf2f(proj[row * PW + C_S5U + g * 16 + l15]);
      zout[row * 512 + g * 16 + l15] = f2bf(gelu_tanh_(y4[i] + dsk * uu)); }
  }
}
DEV void s5_prep_item(int idx, const float* a_re, const float* a_im, const float* log_dt, const float* b_re, const float* b_im, const float* c_re, const float* c_im,
                      float* AB, bf16_t* BT, bf16_t* CT) {
  const int g = idx >> 6, p = idx & 63;
  const float are = a_re[idx], aim = a_im[idx], dt = expf(log_dt[g]);
  const float mag = expf(dt * are), abr = mag * cosf(dt * aim), abi = mag * sinf(dt * aim);
  const float nr = abr - 1.0f, ni = abi, den = are * are + aim * aim;
  const float fr = (nr * are + ni * aim) / den, fi = (ni * are - nr * aim) / den;
  AB[idx * 2] = abr; AB[idx * 2 + 1] = abi;
  for (int c = 0; c < 16; ++c) {
    const float br = b_re[(size_t)idx * 16 + c], bi = b_im[(size_t)idx * 16 + c];
    BT[((size_t)g * 128 + p) * 16 + c] = f2bf(fr * br - fi * bi); BT[((size_t)g * 128 + 64 + p) * 16 + c] = f2bf(fr * bi + fi * br);
    CT[((size_t)g * 16 + c) * 128 + p] = f2bf(c_re[((size_t)g * 16 + c) * 64 + p]); CT[((size_t)g * 16 + c) * 128 + 64 + p] = f2bf(-c_im[((size_t)g * 16 + c) * 64 + p]);
  }
}
namespace pg8 {
#define PG8_LAS __attribute__((address_space(3)))
typedef unsigned short bf16_t;
typedef short bf16x8 __attribute__((ext_vector_type(8)));
typedef float f32x4 __attribute__((ext_vector_type(4)));
typedef unsigned u32x4 __attribute__((ext_vector_type(4)));
constexpr int BM = 256, BK = 64, HALF = 128, HTB = HALF * BK * 2  , STAGE_BYTES = 8 * HTB, NXCD = 8, WGM = 8;

__host__ __device__ __forceinline__ int lds_byte(int r, int c) { const int st = (r >> 4) * 2 + (c >> 5), rr = r & 15, cc = c & 31, ob = rr * 64 + cc * 2; return st * 1024 + (ob ^ (((ob >> 9) & 1) << 5)); }
__host__ __device__ __forceinline__ void stage_rc(int b, int& R, int& C) { const int st = b / 1024, sb = b % 1024, swz = sb ^ (((sb >> 9) & 1) << 5); R = (st >> 1) * 16 + swz / 64; C = (st & 1) * 32 + (swz % 64) / 2; }
__host__ __device__ __forceinline__ int perm32(int rho) { const int n = rho >> 4, i = rho & 15; return 8 * (i >> 2) + 4 * n + (i & 3); }

struct Unit { int pm, pn, acol, z; };
struct Gemm { const bf16_t* A; const bf16_t* Bt; int K, lda, ldb; };
typedef float f32x2 __attribute__((ext_vector_type(2)));
__device__ __forceinline__ unsigned cvt_pk_bf16(float lo, float hi) { unsigned r; asm volatile("v_cvt_pk_bf16_f32 %0, %1, %2" : "=v"(r) : "v"(lo), "v"(hi)); return r; }
template <class Epi, class Sched, bool ALIGN_EPI = false, bool SP2 = false>
__device__ __forceinline__ void gemm_phase(PG8_LAS unsigned char* lds, const Gemm g, const Sched& S, const Epi& E) {
    const int tid = OPAQUE_TID, wid = __builtin_amdgcn_readfirstlane(tid >> 6), lane = tid & 63, wr = wid >> 2, wc = wid & 3, fr = lane & 15, fq = lane >> 4;
    const int K = g.K, nt = K / BK;
    unsigned voffA[2], voffB[2];
#pragma unroll
    for (int i = 0; i < 2; ++i) { int R, C; stage_rc(tid * 16 + i * 8192, R, C); const int Rb = Epi::PERM ? ((R & ~31) + perm32(R & 31)) : R;
        voffA[i] = (unsigned)(R * g.lda + C) * 2u; voffB[i] = (unsigned)(Rb * g.ldb + C) * 2u; }
    const size_t kstep = (size_t)(BK * 2);
    const size_t hstepA = (size_t)HALF * g.lda * 2, hstepB = (size_t)HALF * g.ldb * 2;
    const size_t tstepA = 2 * hstepA, tstepB = 2 * hstepB;
    const unsigned ldsw = (unsigned)wid * 1024u;
    const int aoff = lds_byte(wr * 64 + fr, fq * 8), boff = lds_byte(wc * 32 + fr, fq * 8);
#define PG8_SA(b, h) (((b) * 2 + (h)) * HTB)
#define PG8_SB(b, h) ((4 + (b) * 2 + (h)) * HTB)
#define PG8_STAGE(bufoff, gbase, voff) do { _Pragma("unroll") for (int _i = 0; _i < 2; ++_i) \
        __builtin_amdgcn_global_load_lds((const unsigned*)((const char*)(gbase) + (voff)[_i]), (PG8_LAS unsigned*)(lds + (bufoff) + ldsw + _i * 8192), 16, 0, 0); } while (0)
#define PG8_LDA(dst, b, h) do { _Pragma("unroll") for (int m = 0; m < 4; ++m) _Pragma("unroll") for (int k = 0; k < 2; ++k) dst[m][k] = *(const PG8_LAS bf16x8*)(lds + PG8_SA(b, h) + aoff + m * 2048 + k * 1024); } while (0)
#define PG8_LDB(dst, b, h) do { _Pragma("unroll") for (int n = 0; n < 2; ++n) _Pragma("unroll") for (int k = 0; k < 2; ++k) dst[n][k] = *(const PG8_LAS bf16x8*)(lds + PG8_SB(b, h) + boff + n * 2048 + k * 1024); } while (0)
#define PG8_MMA(ai, bj, At, Bt) do { __builtin_amdgcn_s_setprio(1); _Pragma("unroll") for (int m = 0; m < 4; ++m) _Pragma("unroll") for (int n = 0; n < 2; ++n) _Pragma("unroll") for (int k = 0; k < 2; ++k) \
        acc[ai][bj][m][n] = __builtin_amdgcn_mfma_f32_16x16x32_bf16(Bt[n][k], At[m][k], acc[ai][bj][m][n], 0, 0, 0); __builtin_amdgcn_s_setprio(0); } while (0)
#define PG8_WAIT_V(n) asm volatile("s_waitcnt vmcnt(" #n ")" ::: "memory")
#define PG8_WAIT_L(n) asm volatile("s_waitcnt lgkmcnt(" #n ")" ::: "memory")
#define PG8_BAR __builtin_amdgcn_s_barrier()
#define PG8_SCHED __builtin_amdgcn_sched_barrier(0)
    Unit cur, nxt; int ui = 0;
    if (!S.next(0, cur)) return;
    f32x4 acc[2][2][4][2];
#pragma unroll
    for (int a = 0; a < 2; ++a)
#pragma unroll
        for (int b = 0; b < 2; ++b)
#pragma unroll
            for (int m = 0; m < 4; ++m)
#pragma unroll
                for (int n = 0; n < 2; ++n) acc[a][b][m][n] = (f32x4){0.f, 0.f, 0.f, 0.f};
    bf16x8 At[4][2], B0[2][2], B1[2][2];
    const char* cA = (const char*)g.A + (size_t)cur.pm * tstepA + (size_t)cur.acol * 2; const char* cB = (const char*)g.Bt + (size_t)cur.pn * tstepB;
    S.a_ready(cur);
    if constexpr (SP2) {
        PG8_STAGE(PG8_SB(0, 0), cB, voffB); PG8_STAGE(PG8_SB(0, 1), cB + hstepB, voffB); PG8_STAGE(PG8_SA(0, 0), cA, voffA); PG8_STAGE(PG8_SA(0, 1), cA + hstepA, voffA);
        if (wr == 1) PG8_BAR;
        PG8_WAIT_V(2); PG8_BAR;
        PG8_STAGE(PG8_SB(1, 0), cB + kstep, voffB); PG8_STAGE(PG8_SA(1, 0), cA + kstep, voffA); PG8_STAGE(PG8_SB(1, 1), cB + hstepB + kstep, voffB);
        PG8_WAIT_V(6); PG8_BAR;
    } else {
        PG8_STAGE(PG8_SB(0, 0), cB, voffB); PG8_STAGE(PG8_SA(0, 0), cA, voffA); PG8_STAGE(PG8_SB(0, 1), cB + hstepB, voffB); PG8_STAGE(PG8_SA(0, 1), cA + hstepA, voffA);
        if (wr == 1) PG8_BAR;
        PG8_WAIT_V(4); PG8_BAR;
        PG8_STAGE(PG8_SB(1, 0), cB + kstep, voffB); PG8_STAGE(PG8_SA(1, 0), cA + kstep, voffA); PG8_STAGE(PG8_SB(1, 1), cB + hstepB + kstep, voffB);
        PG8_WAIT_V(6); PG8_BAR;
    }
    for (;;) {
        const bool has_next = S.next(ui + 1, nxt);
        const char* nA = has_next ? (const char*)g.A + (size_t)nxt.pm * tstepA + (size_t)nxt.acol * 2 : cA; const char* nB = has_next ? (const char*)g.Bt + (size_t)nxt.pn * tstepB : cB;
        for (int t = 0; t < nt; t += 2) {
            const bool last = (t == nt - 2);
            const char* a1 = cA + (size_t)(t + 1) * kstep;
            const char* a2 = last ? nA : cA + (size_t)(t + 2) * kstep; const char* b2 = last ? nB : cB + (size_t)(t + 2) * kstep;
            const char* a3 = a2 + kstep; const char* b3 = b2 + kstep;
            if (last && has_next) S.a_ready(nxt);
            if constexpr (SP2) {
            PG8_LDB(B0, 0, 0); PG8_LDB(B1, 0, 1); PG8_SCHED; PG8_LDA(At, 0, 0); PG8_STAGE(PG8_SA(1, 1), a1 + hstepA, voffA);
            PG8_WAIT_V(8); PG8_WAIT_L(0); PG8_BAR; PG8_MMA(0, 0, At, B0); PG8_MMA(0, 1, At, B1); PG8_BAR; PG8_SCHED;
            PG8_LDA(At, 0, 1); PG8_STAGE(PG8_SB(0, 0), b2, voffB); PG8_STAGE(PG8_SB(0, 1), b2 + hstepB, voffB); PG8_STAGE(PG8_SA(0, 0), a2, voffA);
            PG8_WAIT_V(8); PG8_WAIT_L(0); PG8_BAR; PG8_MMA(1, 0, At, B0); PG8_MMA(1, 1, At, B1); PG8_BAR; PG8_SCHED;
            PG8_LDB(B0, 1, 0); PG8_LDB(B1, 1, 1); PG8_SCHED; PG8_LDA(At, 1, 0); PG8_STAGE(PG8_SA(0, 1), a2 + hstepA, voffA);
            PG8_WAIT_V(8); PG8_WAIT_L(0); PG8_BAR; PG8_MMA(0, 0, At, B0); PG8_MMA(0, 1, At, B1); PG8_BAR; PG8_SCHED;
            PG8_LDA(At, 1, 1); PG8_STAGE(PG8_SB(1, 0), b3, voffB); PG8_STAGE(PG8_SB(1, 1), b3 + hstepB, voffB); PG8_STAGE(PG8_SA(1, 0), a3, voffA);
            PG8_WAIT_V(8); PG8_WAIT_L(0); PG8_BAR; PG8_MMA(1, 0, At, B0); PG8_MMA(1, 1, At, B1); PG8_BAR; PG8_SCHED;
            } else {
            PG8_LDB(B0, 0, 0); PG8_SCHED; PG8_LDA(At, 0, 0); PG8_STAGE(PG8_SA(1, 1), a1 + hstepA, voffA);
            PG8_WAIT_L(8); PG8_BAR; PG8_WAIT_L(0); PG8_MMA(0, 0, At, B0); PG8_BAR; PG8_SCHED;
            PG8_LDB(B1, 0, 1); PG8_STAGE(PG8_SB(0, 0), b2, voffB);
            PG8_BAR; PG8_WAIT_L(0); PG8_MMA(0, 1, At, B1); PG8_BAR;
            PG8_LDA(At, 0, 1); PG8_STAGE(PG8_SA(0, 0), a2, voffA);
            PG8_BAR; PG8_WAIT_L(0); PG8_MMA(1, 0, At, B0); PG8_BAR; PG8_SCHED;
            PG8_STAGE(PG8_SB(0, 1), b2 + hstepB, voffB);
            PG8_WAIT_V(6); PG8_BAR; PG8_MMA(1, 1, At, B1); PG8_BAR;
            PG8_LDB(B0, 1, 0); PG8_SCHED; PG8_LDA(At, 1, 0); PG8_STAGE(PG8_SA(0, 1), a2 + hstepA, voffA);
            PG8_WAIT_L(8); PG8_BAR; PG8_WAIT_L(0); PG8_MMA(0, 0, At, B0); PG8_BAR; PG8_SCHED;
            PG8_LDB(B1, 1, 1); PG8_STAGE(PG8_SB(1, 0), b3, voffB);
            PG8_BAR; PG8_WAIT_L(0); PG8_MMA(0, 1, At, B1); PG8_BAR;
            PG8_LDA(At, 1, 1); PG8_STAGE(PG8_SA(1, 0), a3, voffA);
            PG8_BAR; PG8_WAIT_L(0); PG8_MMA(1, 0, At, B0); PG8_BAR; PG8_SCHED;
            PG8_STAGE(PG8_SB(1, 1), b3 + hstepB, voffB);
            PG8_WAIT_V(6); PG8_BAR; PG8_MMA(1, 1, At, B1); PG8_BAR;
            }
        }
        if constexpr (ALIGN_EPI) { if (wr == 0) PG8_BAR; }
        if constexpr (!Epi::AFTER_DRAIN) { E(acc, cur, wr, wc, fr, fq); S.done(cur); }
        if (!has_next) break;
#pragma unroll
        for (int a = 0; a < 2; ++a)
#pragma unroll
            for (int b = 0; b < 2; ++b)
#pragma unroll
                for (int m = 0; m < 4; ++m)
#pragma unroll
                    for (int n = 0; n < 2; ++n) acc[a][b][m][n] = (f32x4){0.f, 0.f, 0.f, 0.f};
        cur = nxt; cA = nA; cB = nB; ++ui;
        if constexpr (ALIGN_EPI) { if (wr == 1) PG8_BAR; }
    }
    PG8_WAIT_V(0);
    if constexpr (!ALIGN_EPI) { if (wr == 0) PG8_BAR; }
    PG8_BAR;
    if constexpr (Epi::AFTER_DRAIN) { E.fused(acc, cur, wr, wc, fr, fq, lds, wid, lane); S.done(cur); }
#undef PG8_SA
#undef PG8_SB
#undef PG8_STAGE
#undef PG8_LDA
#undef PG8_LDB
#undef PG8_MMA
#undef PG8_WAIT_V
#undef PG8_WAIT_L
#undef PG8_BAR
#undef PG8_SCHED
}
}
constexpr int DM = 2048, NLAYER = 4, FFH = 5632, NPROJ = 5888, NMT = M_TOK / 256;
constexpr size_t MiB = 1u << 20;
constexpr size_t WS_CTL = 0, CTL_ZERO_BYTES = 1 * MiB;
constexpr size_t WS_MODP = 1 * MiB, WS_S5T = 8 * MiB, WS_WGLU = 9 * MiB, WS_WIN = 10 * MiB, WS_WG = 33 * MiB, WS_WB = 65 * MiB, WS_WOUT = 73 * MiB, WS_WFI = 81 * MiB, WS_WFO = 125 * MiB;
constexpr size_t WS_NAR = 147 * MiB, WS_Z = 151 * MiB, WS_H = 183 * MiB, WS_OALL = 311 * MiB, WS_PROJ = 439 * MiB, WS_P = 791 * MiB, WS_GSCR = 1303 * MiB, WS_END = 1367 * MiB;
constexpr size_t WS_MERGED = WS_PROJ, WS_MIXB = WS_PROJ + 128 * MiB, WS_Y = WS_PROJ, WS_HID = WS_P;
static_assert(WS_WIN + (size_t)NPROJ * DM * 2 <= WS_WG && WS_WFI + (size_t)2 * FFH * DM * 2 <= WS_WFO && WS_WFO + (size_t)DM * FFH * 2 <= WS_NAR, "weight map");
static_assert(WS_NAR + (size_t)M_TOK * NWP * 4 <= WS_Z && WS_Z + (size_t)M_TOK * 512 * 2 <= WS_H && WS_H + (size_t)M_TOK * DM * 2 <= WS_OALL && WS_OALL + (size_t)M_TOK * DM * 2 <= WS_PROJ, "act map");
static_assert(WS_PROJ + (size_t)M_TOK * PW * 2 <= WS_P && WS_P + (size_t)4 * M_TOK * DM * 2 <= WS_GSCR && WS_HID + (size_t)M_TOK * FFH * 2 <= WS_GSCR && WS_GSCR + (size_t)256 * 262144 <= WS_END, "act map 2");
constexpr int KSPLIT = 8;
constexpr int CW_TMO = 0, CW_BAR = 4096, CW_Q = 16384;
constexpr int LDS_BYTES = 147456, LDS_MISC = 131072, LDS_BIAS = 131072 + 256;
constexpr int N_PHASES = 2 + 10 * NLAYER;

__device__ const unsigned char T5_BUCKET[128] = {0,1,2,3,4,5,6,7,8,9,10,11,12,13,14,15,16,16,16,17,17,18,18,18,19,19,19,20,20,20,20,21,21,21,21,22,22,22,22,22,23,23,23,23,23,23,24,24,24,24,24,24,25,25,25,25,25,25,25,26,26,26,26,26,26,26,26,27,27,27,27,27,27,27,27,27,27,28,28,28,28,28,28,28,28,28,28,29,29,29,29,29,29,29,29,29,29,29,29,30,30,30,30,30,30,30,30,30,30,30,30,30,30,31,31,31,31,31,31,31,31,31,31,31,31,31,31,31};

#define XB_TMO      128
#define XB_XCNT(j)  (256  + 64 * (j))
#define XB_XSUB(j)  (1280 + 64 * (j))
#define XB_XGEN(j)  (2304 + 64 * (j))
#define XB_TOP      3328
#define XB_TOPGEN   3392
#define XCD_BAR_WORDS 3456
#define XB_SPIN_CAP (1u << 22)
__device__ __forceinline__ unsigned xb_ld(unsigned* p)              { return __hip_atomic_load(p, __ATOMIC_RELAXED, __HIP_MEMORY_SCOPE_AGENT); }
__device__ __forceinline__ unsigned xb_add(unsigned* p, unsigned v) { return __hip_atomic_fetch_add(p, v, __ATOMIC_RELAXED, __HIP_MEMORY_SCOPE_AGENT); }
__device__ __forceinline__ unsigned xb_xcc_id() { return (unsigned)__builtin_amdgcn_s_getreg((3 << 11) | 20) & 0xFu; }
#define XB_SPIN(cond, bar) do { unsigned _sp = 0; while (cond) { __builtin_amdgcn_s_sleep(1); \
    if ((++_sp & 255u) == 0u) { if (xb_ld(&(bar)[XB_TMO])) break; if (_sp > XB_SPIN_CAP) { atomicAdd(&(bar)[XB_TMO], 1u); break; } } } } while (0)
struct XcdBarrier { unsigned* bar; unsigned x; volatile LAS unsigned* st; };
__device__ __forceinline__ XcdBarrier xcd_barrier_post(unsigned* bar, volatile LAS unsigned* st) {
    XcdBarrier b; b.bar = bar; b.x = xb_xcc_id(); b.st = st;
    if (threadIdx.x == 0) (void)xb_add(&bar[XB_XCNT(b.x)], 1u);
    return b;
}
__device__ __forceinline__ void xcd_barrier_complete(unsigned* bar, unsigned x, unsigned& nloc, unsigned& nx) {
    const unsigned G = gridDim.x * gridDim.y * gridDim.z;
    unsigned sum, cnt, mine, sp = 0u;
    for (;;) {
        sum = 0u; cnt = 0u; mine = 0u;
#pragma unroll
        for (unsigned j = 0; j < 16; ++j) { const unsigned c = xb_ld(&bar[XB_XCNT(j)]); sum += c; cnt += (c > 0u) ? 1u : 0u; mine = (j == x) ? c : mine; }
        if (sum == G) break;
        __builtin_amdgcn_s_sleep(1);
        if ((++sp & 255u) == 0u) { if (xb_ld(&bar[XB_TMO])) break; if (sp > XB_SPIN_CAP) { atomicAdd(&bar[XB_TMO], 1u); break; } }
    }
    nloc = mine > 0u ? mine : 1u; nx = cnt > 0u ? cnt : 1u;
}
__device__ __forceinline__ void xcd_barrier(const XcdBarrier& b) {
    asm volatile("s_waitcnt vmcnt(0)" ::: "memory");
    __syncthreads();
    if (threadIdx.x == 0) {
        unsigned* bar = b.bar;
        __builtin_amdgcn_s_waitcnt(0);
        unsigned nloc = b.st[0], nx = b.st[1];
        if (nloc == 0u) { xcd_barrier_complete(bar, b.x, nloc, nx); b.st[0] = nloc; b.st[1] = nx; }
        const unsigned old = xb_add(&bar[XB_XSUB(b.x)], 1u);
        const unsigned gen = old / nloc;
        if (old + 1u == (gen + 1u) * nloc) {
            __builtin_amdgcn_fence(__ATOMIC_RELEASE, "agent");
            asm volatile("s_waitcnt vmcnt(0)" ::: "memory");
            const unsigned og = xb_add(&bar[XB_TOP], 1u);
            const unsigned tg = og / nx;
            if (og + 1u == (tg + 1u) * nx) xb_add(&bar[XB_TOPGEN], 1u);
            else XB_SPIN(xb_ld(&bar[XB_TOPGEN]) == tg, bar);
            __builtin_amdgcn_fence(__ATOMIC_ACQUIRE, "agent");
            xb_add(&bar[XB_XGEN(b.x)], 1u);
            asm volatile("s_waitcnt vmcnt(0)" ::: "memory");
        } else {
            XB_SPIN(xb_ld(&bar[XB_XGEN(b.x)]) == gen, bar);
            __builtin_amdgcn_fence(__ATOMIC_ACQUIRE, "agent");
            asm volatile("s_waitcnt vmcnt(0)" ::: "memory");
        }
    }
    __syncthreads();
}

namespace pg8 {
__device__ __forceinline__ void tile_map(int nM, int nN, int L, int& pm, int& pn) {
    const int nwg = nM * nN; int wgid = L;
    { const int q = nwg / NXCD, r = nwg % NXCD, xcd = wgid % NXCD, off = wgid / NXCD; wgid = (xcd < r ? xcd * (q + 1) : r * (q + 1) + (xcd - r) * q) + off; }
    const int nig = WGM * nN, gid = wgid / nig, fm = gid * WGM, gsz = (nM - fm) < WGM ? (nM - fm) : WGM;
    pm = fm + ((wgid % nig) % gsz); pn = (wgid % nig) / gsz;
}
struct SchedPlain { int nM, nN, G, c;
    __device__ __forceinline__ bool next(int i, Unit& u) const { const long L = (long)i * G + c; if (L >= (long)nM * nN) return false; tile_map(nM, nN, (int)L, u.pm, u.pn); u.acol = 0; u.z = 0; return true; }
    __device__ __forceinline__ void a_ready(const Unit&) const {} __device__ __forceinline__ void done(const Unit&) const {} };
struct SchedP { int nM, G, c;
    __device__ __forceinline__ bool next(int i, Unit& u) const { const long L = (long)i * G + c; const int per = nM * 8; if (L >= 4L * per) return false; const int z = (int)(L / per); int pm, pn; tile_map(nM, 8, (int)(L % per), pm, pn);
        u.pm = pm; u.pn = z * 8 + pn; u.acol = 512 * z; u.z = z; return true; }
    __device__ __forceinline__ void a_ready(const Unit&) const {} __device__ __forceinline__ void done(const Unit&) const {} };
struct SchedGate { int nM, G, c;
    __device__ __forceinline__ bool next(int i, Unit& u) const { const long T = (long)(i >> 2) * G + c; if (T >= (long)nM * 8) return false; int pm, pn; tile_map(nM, 8, (int)T, pm, pn); const int z = i & 3;
        u.pm = pm; u.pn = z * 8 + pn; u.acol = 0; u.z = z; return true; }
    __device__ __forceinline__ void a_ready(const Unit&) const {} __device__ __forceinline__ void done(const Unit&) const {} };

__device__ __forceinline__ u32x4 pack8(const f32x4& a, const f32x4& b) { u32x4 w; w.x = cvt_pk_bf16(a[0], a[1]); w.y = cvt_pk_bf16(a[2], a[3]); w.z = cvt_pk_bf16(b[0], b[1]); w.w = cvt_pk_bf16(b[2], b[3]); return w; }
__device__ __forceinline__ void unpack8(const u32x4& w, f32x4& a, f32x4& b) {
    a[0] = __uint_as_float(w.x << 16); a[1] = __uint_as_float(w.x & 0xffff0000u); a[2] = __uint_as_float(w.y << 16); a[3] = __uint_as_float(w.y & 0xffff0000u);
    b[0] = __uint_as_float(w.z << 16); b[1] = __uint_as_float(w.z & 0xffff0000u); b[2] = __uint_as_float(w.w << 16); b[3] = __uint_as_float(w.w & 0xffff0000u); }
__device__ __forceinline__ float sigm(float x) { return __builtin_amdgcn_rcpf(1.0f + __builtin_amdgcn_exp2f(-1.4426950408889634f * x)); }

struct EpiPlain {
    static constexpr bool PERM = true, AFTER_DRAIN = false;
    bf16_t* O; int ldc; int colmask; size_t zstride;
    __device__ __forceinline__ void operator()(const f32x4 (&acc)[2][2][4][2], const Unit& u, int wr_, int wc_, int fr_, int fq_) const {
        const int tid = OPAQUE_TID, wid_ = __builtin_amdgcn_readfirstlane(tid >> 6), wr = wid_ >> 2, wc = wid_ & 3, fr = tid & 15, fq = (tid & 63) >> 4;
        const int row0 = u.pm * BM + wr * 64 + fr, col0 = (u.pn & colmask) * BM + wc * 32 + 8 * fq; bf16_t* base = O + (size_t)u.z * zstride;
#pragma unroll
        for (int ai = 0; ai < 2; ++ai)
#pragma unroll
            for (int m = 0; m < 4; ++m) { bf16_t* rowp = base + (size_t)(row0 + ai * HALF + m * 16) * ldc + col0;
#pragma unroll
                for (int bj = 0; bj < 2; ++bj) *(u32x4*)(rowp + bj * HALF) = pack8(acc[ai][bj][m][0], acc[ai][bj][m][1]); }
    }
};
struct EpiProj {
    static constexpr bool PERM = true, AFTER_DRAIN = false;
    bf16_t* P; float* NAR;
    __device__ __forceinline__ void operator()(const f32x4 (&acc)[2][2][4][2], const Unit& u, int wr_, int wc_, int fr_, int fq_) const {
        const int tid = OPAQUE_TID, wid_ = __builtin_amdgcn_readfirstlane(tid >> 6), wr = wid_ >> 2, wc = wid_ & 3, fr = tid & 15, fq = (tid & 63) >> 4;
        const int row0 = u.pm * BM + wr * 64 + fr;
        if (u.pn < 22) { const int col0 = u.pn * BM + wc * 32 + 8 * fq;
#pragma unroll
            for (int ai = 0; ai < 2; ++ai)
#pragma unroll
                for (int m = 0; m < 4; ++m) { bf16_t* rowp = P + (size_t)(row0 + ai * HALF + m * 16) * PW + col0;
#pragma unroll
                    for (int bj = 0; bj < 2; ++bj) *(u32x4*)(rowp + bj * HALF) = pack8(acc[ai][bj][m][0], acc[ai][bj][m][1]); }
        } else if (wc == 0 && fq < 3) {
#pragma unroll
            for (int ai = 0; ai < 2; ++ai)
#pragma unroll
                for (int m = 0; m < 4; ++m) { float* np = NAR + (size_t)(row0 + ai * HALF + m * 16) * NWP + 8 * fq; *(f32x4*)np = acc[ai][0][m][0]; *(f32x4*)(np + 4) = acc[ai][0][m][1]; }
        }
    }
};
struct EpiGlu {
    static constexpr bool PERM = true, AFTER_DRAIN = false;
    const bf16_t* Z; const float* bias; bf16_t* O;
    __device__ __forceinline__ void operator()(const f32x4 (&acc)[2][2][4][2], const Unit& u, int wr_, int wc_, int fr_, int fq_) const {
        const int tid = OPAQUE_TID, wid_ = __builtin_amdgcn_readfirstlane(tid >> 6), wr = wid_ >> 2, wc = wid_ & 3, fr = tid & 15, fq = (tid & 63) >> 4;
        const int row0 = u.pm * BM + wr * 64 + fr, col0 = u.pn * BM + wc * 32 + 8 * fq;
#pragma unroll
        for (int bj = 0; bj < 2; ++bj) { const int c = col0 + bj * HALF; const f32x4 b0 = *(const f32x4*)(bias + c), b1 = *(const f32x4*)(bias + c + 4);
#pragma unroll
            for (int ai = 0; ai < 2; ++ai)
#pragma unroll
                for (int m = 0; m < 4; ++m) { const size_t row = (size_t)(row0 + ai * HALF + m * 16); f32x4 z0, z1; unpack8(*(const u32x4*)(Z + row * 512 + c), z0, z1);
                    f32x4 v0 = acc[ai][bj][m][0] + b0, v1 = acc[ai][bj][m][1] + b1;
#pragma unroll
                    for (int j = 0; j < 4; ++j) { v0[j] = z0[j] * sigm(v0[j]); v1[j] = z1[j] * sigm(v1[j]); }
                    *(u32x4*)(O + row * OW + 1536 + c) = pack8(v0, v1); } }
    }
};
struct EpiGate {
    static constexpr bool PERM = true, AFTER_DRAIN = false;
    const bf16_t* P; const float* bias; bf16_t* scr; bf16_t* MG;
    __device__ __forceinline__ void operator()(const f32x4 (&acc)[2][2][4][2], const Unit& u, int wr_, int wc_, int fr_, int fq_) const {
        const int tid = OPAQUE_TID, wid_ = __builtin_amdgcn_readfirstlane(tid >> 6), wr = wid_ >> 2, wc = wid_ & 3, fr = tid & 15, fq = (tid & 63) >> 4;
        const int z = u.z, row0 = u.pm * BM + wr * 64 + fr, col0 = (u.pn & 7) * BM + wc * 32 + 8 * fq;
        const GAS char* Pz = uptr(P + (size_t)z * M_TOK * DM + (size_t)(u.pm * BM) * DM); const float* bz = bias + z * DM; GAS char* MGp = (GAS char*)uptr(MG + (size_t)(u.pm * BM) * DM);
        const unsigned voff = (unsigned)((wr * 64 + fr) * DM + col0) * 2u;
#pragma unroll
        for (int bj = 0; bj < 2; ++bj) { const int c = col0 + bj * HALF; const f32x4 b0 = *(const f32x4*)(bz + c), b1 = *(const f32x4*)(bz + c + 4);
#pragma unroll
            for (int qh = 0; qh < 2; ++qh) {
                u32x4 pv[4], sv[4];
#pragma unroll
                for (int qq = 0; qq < 4; ++qq) { const int q = qh * 4 + qq, ai = q >> 2, m = q & 3; pv[qq] = *(const GAS u32x4*)(Pz + voff + (unsigned)((ai * HALF + m * 16) * DM + bj * HALF) * 2u);
                    if (z > 0) sv[qq] = *(const u32x4*)(scr + ((size_t)(q * 2 + bj) * 512 + tid) * 8); }
#pragma unroll
                for (int qq = 0; qq < 4; ++qq) { const int q = qh * 4 + qq, ai = q >> 2, m = q & 3; f32x4 p0, p1; unpack8(pv[qq], p0, p1);
                    f32x4 v0 = acc[ai][bj][m][0] + b0, v1 = acc[ai][bj][m][1] + b1;
#pragma unroll
                    for (int j = 0; j < 4; ++j) { v0[j] = p0[j] * sigm(v0[j]); v1[j] = p1[j] * sigm(v1[j]); }
                    if (z > 0) { f32x4 s0, s1; unpack8(sv[qq], s0, s1); v0 += s0; v1 += s1; }
                    if (z < 3) *(u32x4*)(scr + ((size_t)(q * 2 + bj) * 512 + tid) * 8) = pack8(v0, v1);
                    else *(GAS u32x4*)(MGp + voff + (unsigned)((ai * HALF + m * 16) * DM + bj * HALF) * 2u) = pack8(v0, v1); }
                asm volatile("" ::: "memory");
            }
        }
    }
};
struct EpiSwiglu {
    static constexpr bool PERM = true, AFTER_DRAIN = false;
    bf16_t* Hd;
    __device__ __forceinline__ void operator()(const f32x4 (&acc)[2][2][4][2], const Unit& u, int wr_, int wc_, int fr_, int fq_) const {
        const int tid = OPAQUE_TID, wid_ = __builtin_amdgcn_readfirstlane(tid >> 6), wr = wid_ >> 2, wc = wid_ & 3, fr = tid & 15, fq = (tid & 63) >> 4;
        const int row0 = u.pm * BM + wr * 64 + fr, col0 = u.pn * HALF + wc * 32 + 8 * fq;
#pragma unroll
        for (int ai = 0; ai < 2; ++ai)
#pragma unroll
            for (int m = 0; m < 4; ++m) { f32x4 v0, v1;
#pragma unroll
                for (int j = 0; j < 4; ++j) { const float a0 = acc[ai][0][m][0][j], a1 = acc[ai][0][m][1][j]; v0[j] = a0 * sigm(a0) * acc[ai][1][m][0][j]; v1[j] = a1 * sigm(a1) * acc[ai][1][m][1][j]; }
                *(u32x4*)(Hd + (size_t)(row0 + ai * HALF + m * 16) * FFH + col0) = pack8(v0, v1); }
    }
};
}

struct Args { const float* in[28]; float* out; unsigned char* ws; int ph_lo, ph_hi; };
enum { I_X = 0, I_C, I_ADAW, I_ADAB, I_NORMG, I_WIN, I_RELB, I_DLAM, I_MLCONV, I_MLGB, I_GLAWA2, I_GLABA, I_S5ARE, I_S5AIM, I_S5DT, I_S5BRE, I_S5BIM, I_S5CRE, I_S5CIM, I_S5D, I_GLUW, I_GLUB, I_WBR, I_WGATE, I_BGATE, I_WOUT, I_FFIN, I_FFOUT };

typedef const __attribute__((address_space(4))) unsigned char* kaptr_t;
__device__ __forceinline__ kaptr_t ka_base() { kaptr_t p = (kaptr_t)__builtin_amdgcn_kernarg_segment_ptr(); asm volatile("" : "+s"(p)); return p; }
__device__ __forceinline__ const float* INP(int i) { return *(const float* const __attribute__((address_space(4)))*)(ka_base() + 8 * i); }
__device__ __forceinline__ float* OUTP() { return *(float* const __attribute__((address_space(4)))*)(ka_base() + 224); }
__device__ __forceinline__ unsigned char* WSB() { return *(unsigned char* const __attribute__((address_space(4)))*)(ka_base() + 232); }
static_assert(sizeof(Args) == 248, "Args layout");
template <class RowMap>
__device__ __forceinline__ void conv_item(const float* __restrict__ W, int K, int N, bf16_t* __restrict__ WT, int ldk, int koff, const RowMap& rm, LAS float* scr, int item, int lane) {
    const int nblk = (N + 31) / 32, kb = item / nblk, nb = item % nblk, k0 = 64 * kb, n0 = 32 * nb; const int nn = n0 + (lane & 31); const bool okn = nn < N;
#pragma unroll 8
    for (int i = 0; i < 32; ++i) { const int kk = 2 * i + (lane >> 5); scr[kk * 33 + (lane & 31)] = okn ? W[(size_t)(k0 + kk) * N + nn] : 0.f; }
    asm volatile("s_waitcnt lgkmcnt(0)" ::: "memory");
    const int c = lane & 7;
#pragma unroll
    for (int j = 0; j < 4; ++j) { const int n = (lane >> 3) + 8 * j; const LAS float* s = scr + (8 * c) * 33 + n;
        u32x4 o; o.x = pk2(s[0 * 33], s[1 * 33]); o.y = pk2(s[2 * 33], s[3 * 33]); o.z = pk2(s[4 * 33], s[5 * 33]); o.w = pk2(s[6 * 33], s[7 * 33]);
        if (n0 + n < N) *(u32x4*)(WT + (size_t)rm(n0 + n) * ldk + koff + k0 + 8 * c) = o; }
    asm volatile("s_waitcnt lgkmcnt(0)" ::: "memory");
}
struct RmIdent { int off; __device__ __forceinline__ int operator()(int n) const { return off + n; } };
struct RmWin { __device__ __forceinline__ int operator()(int n) const { return n < 3584 ? n : (n < 3592 ? 5632 + (n - 3584) : (n < 5128 ? n - 8 : (n < 5144 ? 5640 + (n - 5128) : n - 24))); } };
struct RmFfi { __device__ __forceinline__ int operator()(int n) const { const int g = n >= FFH, j = g ? n - FFH : n; return (j >> 7) * 256 + g * 128 + (j & 127); } };

__device__ __forceinline__ void convert_layer(int l, LDSP lds, int wg, int G) {
    const int tid_ = OPAQUE_TID, lane = tid_ & 63, gw = wg * 8 + (tid_ >> 6), NGW = G * 8, gtid = wg * 512 + tid_, NT = G * 512;
    unsigned char* ws = WSB();
    LAS float* scr = (LAS float*)(lds + (tid_ >> 6) * 16384);
    bf16_t* Win = (bf16_t*)(ws + WS_WIN); bf16_t* Wg = (bf16_t*)(ws + WS_WG); bf16_t* Wb = (bf16_t*)(ws + WS_WB); bf16_t* Wo = (bf16_t*)(ws + WS_WOUT); bf16_t* Wfi = (bf16_t*)(ws + WS_WFI); bf16_t* Wfo = (bf16_t*)(ws + WS_WFO); bf16_t* Wglu = (bf16_t*)(ws + WS_WGLU);
    constexpr int I_IN = 32 * 177, I_G1 = 32 * 64, I_G = 4 * I_G1, I_B1 = 8 * 64, I_B = 4 * I_B1, I_O = 32 * 64, I_FI = 32 * 352, I_FO = 88 * 64, I_GL = 8 * 16;
    constexpr int NIT = I_IN + I_G + I_B + I_O + I_FI + I_FO + I_GL;
    for (int it = gw; it < NIT; it += NGW) {
        int r = it;
        if (r < I_IN) { conv_item(INP(I_WIN) + (size_t)l * DM * 5656, DM, 5656, Win, DM, 0, RmWin{}, scr, r, lane); continue; } r -= I_IN;
        if (r < I_G) { const int z = r / I_G1; conv_item(INP(I_WGATE) + ((size_t)l * 4 + z) * DM * DM, DM, DM, Wg, DM, 0, RmIdent{z * DM}, scr, r % I_G1, lane); continue; } r -= I_G;
        if (r < I_B) { const int z = r / I_B1; conv_item(INP(I_WBR) + ((size_t)l * 4 + z) * 512 * DM, 512, DM, Wb, 512, 0, RmIdent{z * DM}, scr, r % I_B1, lane); continue; } r -= I_B;
        if (r < I_O) { conv_item(INP(I_WOUT) + (size_t)l * DM * DM, DM, DM, Wo, DM, 0, RmIdent{0}, scr, r, lane); continue; } r -= I_O;
        if (r < I_FI) { conv_item(INP(I_FFIN) + (size_t)l * DM * 2 * FFH, DM, 2 * FFH, Wfi, DM, 0, RmFfi{}, scr, r, lane); continue; } r -= I_FI;
        if (r < I_FO) { conv_item(INP(I_FFOUT) + (size_t)l * FFH * DM, FFH, DM, Wfo, FFH, 0, RmIdent{0}, scr, r, lane); continue; } r -= I_FO;
        conv_item(INP(I_GLUW) + (size_t)l * 512 * 512, 512, 512, Wglu, 512, 0, RmIdent{0}, scr, r, lane);
    }
    for (int i = gtid; i < 232 * 256; i += NT) ((u32x4*)(Win + (size_t)5656 * DM))[i] = (u32x4){0u, 0u, 0u, 0u};
    if (gtid < 2048) s5_prep_item(gtid, INP(I_S5ARE) + l * 2048, INP(I_S5AIM) + l * 2048, INP(I_S5DT) + l * 32, INP(I_S5BRE) + (size_t)l * 32768, INP(I_S5BIM) + (size_t)l * 32768,
                                  INP(I_S5CRE) + (size_t)l * 32768, INP(I_S5CIM) + (size_t)l * 32768, (float*)(ws + WS_S5T), (bf16_t*)(ws + WS_S5T + 65536), (bf16_t*)(ws + WS_S5T + 65536 + 262144));
}

__device__ __forceinline__ void mod_partials(LDSP lds, int wg, int G) {
    LAS float* cs = (LAS float*)lds;
    const int tid = OPAQUE_TID;
    for (int it = wg; it < KSPLIT * NLAYER * 6; it += G) {
        const int ks = it / (NLAYER * 6), l = (it / 6) % NLAYER, cg = it % 6;
        __syncthreads();
        for (int i = tid; i < BATCH * 256; i += 512) { const int b = i >> 8, k = ks * 256 + (i & 255); const float c = INP(I_C)[b * DM + k]; cs[i] = c * sigmoidf_(c); }
        __syncthreads();
        const float* wp = INP(I_ADAW) + ((size_t)l * DM + ks * 256) * (6 * DM) + cg * DM + 4 * tid;
        f32x4 s[BATCH];
#pragma unroll
        for (int b = 0; b < BATCH; ++b) s[b] = (f32x4){0.f, 0.f, 0.f, 0.f};
#pragma unroll 4
        for (int k = 0; k < 256; ++k) { const f32x4 w = *(const f32x4*)(wp + (size_t)k * (6 * DM));
#pragma unroll
            for (int b = 0; b < BATCH; ++b) s[b] += w * cs[b * 256 + k]; }
        float* mp = (float*)(WSB() + WS_MODP);
#pragma unroll
        for (int b = 0; b < BATCH; ++b) *(f32x4*)(mp + (((size_t)ks * NLAYER + l) * BATCH + b) * (6 * DM) + cg * DM + 4 * tid) = s[b];
    }
}
__device__ __forceinline__ f32x4 mod_vec(int l, int b, int idx, int tid) {
    f32x4 s = *(const f32x4*)(INP(I_ADAB) + (size_t)l * 6 * DM + idx * DM + 4 * tid);
    const float* mp = (const float*)(WSB() + WS_MODP);
#pragma unroll
    for (int ks = 0; ks < KSPLIT; ++ks) s += *(const f32x4*)(mp + (((size_t)ks * NLAYER + l) * BATCH + b) * (6 * DM) + idx * DM + 4 * tid);
    return s;
}
__device__ __forceinline__ void norm_phase(LDSP lds, int wg, int G, const float* xin, float* xout, const bf16_t* ysrc, int l_res, int i_gate, int i_ga, bf16_t* hout, int l_h, int i_scale, int i_shift, int i_gb) {
    LAS f32x4* VA = (LAS f32x4*)lds; LAS f32x4* VB = (LAS f32x4*)(lds + 8192); LAS f32x4* VC = (LAS f32x4*)(lds + 16384);
    const int tid = OPAQUE_TID, lane = tid & 63, wave = tid >> 6;
    for (int chunk = wg; chunk < M_TOK / 128; chunk += G) {
        const int b = (chunk * 128) / SEQ;
        __syncthreads();
        if (ysrc) VA[tid] = mod_vec(l_res, b, i_gate, tid) * *(const f32x4*)(INP(I_NORMG) + ((size_t)l_res * 4 + i_ga) * DM + 4 * tid);
        if (hout) { VB[tid] = (mod_vec(l_h, b, i_scale, tid) + 1.0f) * *(const f32x4*)(INP(I_NORMG) + ((size_t)l_h * 4 + i_gb) * DM + 4 * tid); VC[tid] = mod_vec(l_h, b, i_shift, tid); }
        __syncthreads();
        for (int r = wave; r < 128; r += 8) {
            const size_t row = (size_t)chunk * 128 + r;
            f32x4 x[8];
#pragma unroll
            for (int j = 0; j < 8; ++j) x[j] = *((const f32x4*)(xin + row * DM) + lane + 64 * j);
            if (ysrc) {
                f32x4 y[8]; float ss = 0.f;
#pragma unroll
                for (int j = 0; j < 8; ++j) { const u32x2 w = *((const u32x2*)(ysrc + row * DM) + lane + 64 * j);
                    y[j][0] = __uint_as_float(w.x << 16); y[j][1] = __uint_as_float(w.x & 0xffff0000u); y[j][2] = __uint_as_float(w.y << 16); y[j][3] = __uint_as_float(w.y & 0xffff0000u);
                    ss += (y[j][0] * y[j][0] + y[j][1] * y[j][1]) + (y[j][2] * y[j][2] + y[j][3] * y[j][3]); }
                ss = wave_sum_f(ss); const float rn = 1.0f / sqrtf(ss * (1.0f / DM) + RMS_EPS);
#pragma unroll
                for (int j = 0; j < 8; ++j) { x[j] += y[j] * rn * VA[lane + 64 * j]; *((f32x4*)(xout + row * DM) + lane + 64 * j) = x[j]; }
            }
            if (hout) {
                float ss = 0.f;
#pragma unroll
                for (int j = 0; j < 8; ++j) ss += (x[j][0] * x[j][0] + x[j][1] * x[j][1]) + (x[j][2] * x[j][2] + x[j][3] * x[j][3]);
                ss = wave_sum_f(ss); const float rn = 1.0f / sqrtf(ss * (1.0f / DM) + RMS_EPS);
#pragma unroll
                for (int j = 0; j < 8; ++j) { const f32x4 hv = x[j] * rn * VB[lane + 64 * j] + VC[lane + 64 * j]; u32x2 w; w.x = pk2(hv[0], hv[1]); w.y = pk2(hv[2], hv[3]);
                    *((u32x2*)(hout + row * DM) + lane + 64 * j) = w; }
            }
        }
    }
}

#ifndef REP_G1
#define REP_G1 1
#endif
#ifndef REP_MIX
#define REP_MIX 1
#endif
#ifndef REP_G2
#define REP_G2 1
#endif
#ifndef REP_G3
#define REP_G3 1
#endif
#ifndef REP_G4
#define REP_G4 1
#endif
#ifndef REP_G5
#define REP_G5 1
#endif
#ifndef REP_G6
#define REP_G6 1
#endif
#ifndef REP_G7
#define REP_G7 1
#endif
#ifndef PROBE_ITEMS
#define PROBE_ITEMS 15
#endif
#ifndef MX_ML
#define MX_ML 1
#endif
#ifndef MX_GLA
#define MX_GLA 1
#endif
#ifndef MX_S5
#define MX_S5 1
#endif
#ifndef MX_ATT
#define MX_ATT 1
#endif
#ifndef PH_G1
#define PH_G1 1
#endif
#ifndef PH_MIX
#define PH_MIX 1
#endif
#ifndef PH_G2
#define PH_G2 1
#endif
#ifndef PH_G3
#define PH_G3 1
#endif
#ifndef PH_G4
#define PH_G4 1
#endif
#ifndef PH_G5
#define PH_G5 1
#endif
#ifndef PH_N2
#define PH_N2 1
#endif
#ifndef PH_G6
#define PH_G6 1
#endif
#ifndef PH_G7
#define PH_G7 1
#endif
#ifndef PH_N3
#define PH_N3 1
#endif
__global__ void __launch_bounds__(512, 2) fwd_kernel(Args a) {
    extern __shared__ __attribute__((aligned(16))) unsigned char lds_raw[];
    LDSP lds = (LDSP)lds_raw;
    const int G = gridDim.x, wg = blockIdx.x;
#define ws WSB()
#define ctl ((unsigned*)(WSB() + WS_CTL))
    volatile LAS unsigned* MISC = (volatile LAS unsigned*)(lds + LDS_MISC);
    if (threadIdx.x < 64) MISC[threadIdx.x] = 0u;
    __syncthreads();
    XcdBarrier bar = xcd_barrier_post(ctl + CW_BAR, MISC);
    const int lo = a.ph_lo, hi = a.ph_hi;
    int ph = 0;
#define IN(k) (lo <= (k) && (k) < hi)
#define SEAM(k) do { if (IN(k) && IN((k) + 1)) xcd_barrier(bar); } while (0)
#define Hb ((bf16_t*)(ws + WS_H))
#define PROJ ((bf16_t*)(ws + WS_PROJ))
#define NAR ((float*)(ws + WS_NAR))
#define OALL ((bf16_t*)(ws + WS_OALL))
#define Zb ((bf16_t*)(ws + WS_Z))
#define Pb ((bf16_t*)(ws + WS_P))
#define MG ((bf16_t*)(ws + WS_MERGED))
#define MIXB ((bf16_t*)(ws + WS_MIXB))
#define Yb ((bf16_t*)(ws + WS_Y))
#define HID ((bf16_t*)(ws + WS_HID))

    if (IN(ph)) { mod_partials(lds, wg, G); __syncthreads(); convert_layer(0, lds, wg, G); }
    SEAM(ph); ++ph;
    if (IN(ph)) norm_phase(lds, wg, G, INP(I_X), nullptr, nullptr, 0, 0, 0, Hb, 0, 1, 0, 0);
    SEAM(ph); ++ph;

    for (int l = 0; l < NLAYER; ++l) {
        if (IN(ph) && PH_G1) for (int rep = 0; rep < REP_G1; ++rep) { pg8::Gemm g{Hb, (const bf16_t*)(ws + WS_WIN), DM, DM, DM}; pg8::SchedPlain S{NMT, NPROJ / 256, G, wg}; pg8::EpiProj E{PROJ, NAR};
            pg8::gemm_phase<pg8::EpiProj, pg8::SchedPlain, true, true>((PG8_LAS unsigned char*)lds, g, S, E); }
        SEAM(ph); ++ph;
        if (IN(ph) && PH_MIX) for (int rep = 0; rep < REP_MIX; ++rep) {
            const int tid = OPAQUE_TID, lane = tid & 63, wave = __builtin_amdgcn_readfirstlane(tid >> 6);
            LAS float* biasT = (LAS float*)(lds + LDS_BIAS);
            if (tid < 512) { const int h = tid >> 7, d = tid & 127; biasT[tid] = INP(I_RELB)[T5_BUCKET[d] * 4 + h] * LOG2E; }
            const float* dl = INP(I_DLAM) + l * 256;
            const float s1 = wave_sum_f(dl[lane] * dl[64 + lane]), s2 = wave_sum_f(dl[128 + lane] * dl[192 + lane]);
            const float lam_init = 0.8f - 0.6f * __expf(-0.3f * (float)l), lam = __expf(s1) - __expf(s2) + lam_init;
            __syncthreads();
            if (MX_ML && (rep == 0 || (PROBE_ITEMS & 1)) && wg < 16) mlstm_item(lds, PROJ, NAR, INP(I_MLCONV) + l * 4096, INP(I_MLGB) + l * 8, OALL, wg >> 2, wg & 3);
            else if (MX_GLA && (rep == 0 || (PROBE_ITEMS & 2)) && wg >= 16 && wg < 32) gla_item(lds, PROJ, NAR, INP(I_GLAWA2) + l * 4096, INP(I_GLABA) + l * 256, OALL, (wg - 16) >> 2, (wg - 16) & 3);
            else if (MX_S5 && (rep == 0 || (PROBE_ITEMS & 4)) && wg >= 32 && wg < 48) { const int pair = (wg - 32) * 8 + wave; s5_wave(lds + wave * S5_WAVE_LDS, PROJ, (const float*)(ws + WS_S5T), (const bf16_t*)(ws + WS_S5T + 65536), (const bf16_t*)(ws + WS_S5T + 65536 + 262144),
                                                                         INP(I_S5D) + l * 512, Zb, pair >> 5, pair & 31); }
            __syncthreads();
            if (rep == 0 || (PROBE_ITEMS & 8)) for (;;) {
                if (tid == 0) MISC[16] = __hip_atomic_fetch_add(ctl + CW_Q + 64 * (l + 4 * rep), 1u, __ATOMIC_RELAXED, __HIP_MEMORY_SCOPE_AGENT);
                __syncthreads();
                const unsigned item = MISC[16];
                if (item >= (unsigned)(BATCH * 4 * (SEQ / 128))) break;
                const int qb = (SEQ / 128 - 1) - (int)(item / (BATCH * 4)), bh = (int)(item % (BATCH * 4));
                if (MX_ATT) attn_unit(lds, biasT, PROJ, OALL, lam, lam_init, bh >> 2, bh & 3, qb);
            }
        }
        SEAM(ph); ++ph;
        if (IN(ph) && PH_G2) for (int rep = 0; rep < REP_G2; ++rep) { pg8::Gemm g{Zb, (const bf16_t*)(ws + WS_WGLU), 512, 512, 512}; pg8::SchedPlain S{NMT, 2, G, wg}; pg8::EpiGlu E{Zb, INP(I_GLUB) + l * 512, OALL};
            pg8::gemm_phase<pg8::EpiGlu, pg8::SchedPlain, true, true>((PG8_LAS unsigned char*)lds, g, S, E); }
        SEAM(ph); ++ph;
        if (IN(ph) && PH_G3) for (int rep = 0; rep < REP_G3; ++rep) { pg8::Gemm g{OALL, (const bf16_t*)(ws + WS_WB), 512, DM, 512}; pg8::SchedP S{NMT, G, wg}; pg8::EpiPlain E{Pb, DM, 7, (size_t)M_TOK * DM};
            pg8::gemm_phase<pg8::EpiPlain, pg8::SchedP, true, true>((PG8_LAS unsigned char*)lds, g, S, E); }
        SEAM(ph); ++ph;
        if (IN(ph) && PH_G4) for (int rep = 0; rep < REP_G4; ++rep) { pg8::Gemm g{Hb, (const bf16_t*)(ws + WS_WG), DM, DM, DM}; pg8::SchedGate S{NMT, G, wg}; pg8::EpiGate E{Pb, INP(I_BGATE) + (size_t)l * 4 * DM, (bf16_t*)(ws + WS_GSCR) + (size_t)wg * 65536, MG};
            pg8::gemm_phase<pg8::EpiGate, pg8::SchedGate, true, true>((PG8_LAS unsigned char*)lds, g, S, E); }
        SEAM(ph); ++ph;
        if (IN(ph) && PH_G5) for (int rep = 0; rep < REP_G5; ++rep) { pg8::Gemm g{MG, (const bf16_t*)(ws + WS_WOUT), DM, DM, DM}; pg8::SchedPlain S{NMT, 8, G, wg}; pg8::EpiPlain E{MIXB, DM, 0xffff, 0};
            pg8::gemm_phase<pg8::EpiPlain, pg8::SchedPlain, true, true>((PG8_LAS unsigned char*)lds, g, S, E); }
        SEAM(ph); ++ph;
        if (IN(ph) && PH_N2) norm_phase(lds, wg, G, l == 0 ? INP(I_X) : OUTP(), OUTP(), MIXB, l, 2, 1, Hb, l, 4, 3, 2);
        SEAM(ph); ++ph;
        if (IN(ph) && PH_G6) for (int rep = 0; rep < REP_G6; ++rep) { pg8::Gemm g{Hb, (const bf16_t*)(ws + WS_WFI), DM, DM, DM}; pg8::SchedPlain S{NMT, 2 * FFH / 256, G, wg}; pg8::EpiSwiglu E{HID};
            pg8::gemm_phase<pg8::EpiSwiglu, pg8::SchedPlain, true, true>((PG8_LAS unsigned char*)lds, g, S, E); }
        SEAM(ph); ++ph;
        if (IN(ph) && PH_G7) for (int rep = 0; rep < REP_G7; ++rep) { pg8::Gemm g{HID, (const bf16_t*)(ws + WS_WFO), FFH, FFH, FFH}; pg8::SchedPlain S{NMT, 8, G, wg}; pg8::EpiPlain E{Yb, DM, 0xffff, 0};
            pg8::gemm_phase<pg8::EpiPlain, pg8::SchedPlain, true, true>((PG8_LAS unsigned char*)lds, g, S, E); }
        SEAM(ph); ++ph;
        if (IN(ph) && PH_N3) { norm_phase(lds, wg, G, OUTP(), OUTP(), Yb, l, 5, 3, (l + 1 < NLAYER) ? Hb : nullptr, l + 1, 1, 0, 0);
            if (l + 1 < NLAYER) { __syncthreads(); convert_layer(l + 1, lds, wg, G); } }
        SEAM(ph); ++ph;
    }
#undef IN
#undef SEAM
#undef ws
#undef ctl
#undef Hb
#undef PROJ
#undef NAR
#undef OALL
#undef Zb
#undef Pb
#undef MG
#undef MIXB
#undef Yb
#undef HID
}

#ifndef ONE_LAUNCH
#define ONE_LAUNCH 1
#endif
extern "C" void kernel_launch(void* const* d_in, const int* in_sizes, int n_in, void* d_out, int out_size, void* d_ws, size_t ws_size, hipStream_t stream) {
    static int grid = 0;
    if (grid == 0) {
        if (n_in != 28 || in_sizes[0] != M_TOK * DM || out_size != M_TOK * DM || ws_size < WS_END) { fprintf(stderr, "kernel_launch: unexpected shapes/workspace (n_in %d, ws %zu < %zu)\n", n_in, ws_size, (size_t)WS_END); grid = -1; return; }
        int dev = 0, cus = 0, per_cu = 0;
        if (hipGetDevice(&dev) != hipSuccess || hipDeviceGetAttribute(&cus, hipDeviceAttributeMultiprocessorCount, dev) != hipSuccess) { grid = -1; return; }
        if (hipFuncSetAttribute((const void*)fwd_kernel, hipFuncAttributeMaxDynamicSharedMemorySize, LDS_BYTES) != hipSuccess) { fprintf(stderr, "kernel_launch: hipFuncSetAttribute failed\n"); grid = -1; return; }
        if (hipOccupancyMaxActiveBlocksPerMultiprocessor(&per_cu, (const void*)fwd_kernel, 512, LDS_BYTES) != hipSuccess || per_cu < 1) fprintf(stderr, "kernel_launch: occupancy query says %d\n", per_cu);
        (void)hipGetLastError();
        grid = cus;
        if (grid > 256) grid = 256;
    }
    if (grid < 0) return;
    if (hipMemsetAsync((char*)d_ws + WS_CTL, 0, CTL_ZERO_BYTES, stream) != hipSuccess) return;
    Args a{};
    for (int i = 0; i < 28; ++i) a.in[i] = (const float*)d_in[i];
    a.out = (float*)d_out; a.ws = (unsigned char*)d_ws;
#if ONE_LAUNCH
    a.ph_lo = 0; a.ph_hi = N_PHASES;
    hipLaunchKernelGGL(fwd_kernel, dim3(grid), dim3(512), LDS_BYTES, stream, a);
#else
    for (int p = 0; p < N_PHASES; ++p) { a.ph_lo = p; a.ph_hi = p + 1; hipLaunchKernelGGL(fwd_kernel, dim3(grid), dim3(512), LDS_BYTES, stream, a); }
#endif
}
```

```cpp
#define ONE_LAUNCH 1

#include <hip/hip_runtime.h>
#include <cstdio>
#include <cstdint>
typedef unsigned short bf16_t;
typedef short bf16x8 __attribute__((ext_vector_type(8)));
typedef short s16x4 __attribute__((ext_vector_type(4)));
typedef float f32x4 __attribute__((ext_vector_type(4)));
typedef float f32x16 __attribute__((ext_vector_type(16)));
typedef unsigned u32x4 __attribute__((ext_vector_type(4)));
typedef unsigned u32x2 __attribute__((ext_vector_type(2)));

#ifdef HOST_EMU
#include <cmath>
#include <cstring>
#include <cstdint>
#include <pthread.h>
#define LAS
#define GAS
#define DEV static inline
#define GLOBAL_FN
struct EmuWave { pthread_barrier_t bar; float fa[64][8], fb[64][8]; uintptr_t addr[64]; float v[64]; };
struct EmuBlock { pthread_barrier_t bar; EmuWave wv[8]; };
extern EmuBlock* g_blk;
extern thread_local int emu_tid;
extern thread_local int emu_bid;
#define THREAD_IDX emu_tid
#define OPAQUE_TID emu_tid
DEV int opq(int x) { return x; }
#define BLOCK_IDX emu_bid
DEV void sync_threads() { pthread_barrier_wait(&g_blk->bar); }
DEV void wave_bar() { pthread_barrier_wait(&g_blk->wv[emu_tid >> 6].bar); }
DEV float bf2f(bf16_t b) { unsigned u = (unsigned)b << 16; float f; memcpy(&f, &u, 4); return f; }
DEV bf16_t f2bf(float f) { unsigned u; memcpy(&u, &f, 4); return (bf16_t)((u + 0x7fffu + ((u >> 16) & 1u)) >> 16); }
DEV f32x16 mfma32(bf16x8 a, bf16x8 b, f32x16 c) {
  EmuWave& w = g_blk->wv[emu_tid >> 6]; const int l = emu_tid & 63;
  for (int j = 0; j < 8; ++j) { w.fa[l][j] = bf2f((bf16_t)a[j]); w.fb[l][j] = bf2f((bf16_t)b[j]); }
  wave_bar();
  const int col = l & 31, hi = l >> 5;
  for (int i = 0; i < 16; ++i) { const int row = (i & 3) + 8 * (i >> 2) + 4 * hi; float s = c[i];
    for (int k = 0; k < 16; ++k) s += w.fa[row + 32 * (k >> 3)][k & 7] * w.fb[col + 32 * (k >> 3)][k & 7];
    c[i] = s; }
  wave_bar();
  return c;
}
DEV f32x4 mfma16(bf16x8 a, bf16x8 b, f32x4 c) {
  EmuWave& w = g_blk->wv[emu_tid >> 6]; const int l = emu_tid & 63;
  for (int j = 0; j < 8; ++j) { w.fa[l][j] = bf2f((bf16_t)a[j]); w.fb[l][j] = bf2f((bf16_t)b[j]); }
  wave_bar();
  const int col = l & 15, g = l >> 4;
  for (int i = 0; i < 4; ++i) { const int row = 4 * g + i; float s = c[i];
    for (int k = 0; k < 32; ++k) s += w.fa[row + 16 * (k >> 3)][k & 7] * w.fb[col + 16 * (k >> 3)][k & 7];
    c[i] = s; }
  wave_bar();
  return c;
}
DEV s16x4 lds_tr(const char* p) {
  EmuWave& w = g_blk->wv[emu_tid >> 6]; const int l = emu_tid & 63;
  w.addr[l] = (uintptr_t)p; wave_bar();
  const int g = l >> 4, i = l & 15; s16x4 r;
  for (int q = 0; q < 4; ++q) { const char* src = (const char*)w.addr[16 * g + 4 * q + (i >> 2)] + 2 * (i & 3); short s; memcpy(&s, src, 2); r[q] = s; }
  wave_bar();
  return r;
}
DEV float shfl_xor_f(float v, int m) { EmuWave& w = g_blk->wv[emu_tid >> 6]; const int l = emu_tid & 63; w.v[l] = v; wave_bar(); float r = w.v[l ^ m]; wave_bar(); return r; }
DEV float shfl_up_f(float v, int d) { EmuWave& w = g_blk->wv[emu_tid >> 6]; const int l = emu_tid & 63; w.v[l] = v; wave_bar(); float r = (l >= d) ? w.v[l - d] : v; wave_bar(); return r; }
DEV float shfl_idx_f(float v, int s) { EmuWave& w = g_blk->wv[emu_tid >> 6]; const int l = emu_tid & 63; w.v[l] = v; wave_bar(); float r = w.v[s]; wave_bar(); return r; }
DEV float fast_exp2(float x) { return exp2f(x); }
DEV float fast_rcp(float x) { return 1.0f / x; }
DEV float fast_rsq(float x) { return 1.0f / sqrtf(x); }
DEV int rfl(int x) { return x; }
DEV void wave_sync() { wave_bar(); }
DEV bool wave_any(bool v) { EmuWave& w = g_blk->wv[emu_tid >> 6]; const int l = emu_tid & 63; w.v[l] = v ? 1.f : 0.f; wave_bar(); bool r = false; for (int i = 0; i < 64; ++i) r |= (w.v[i] != 0.f); wave_bar(); return r; }
DEV void sched_fence() {}
DEV void lds_dma16(const void* g, char* l) { memcpy(l + 16 * (emu_tid & 63), g, 16); }
#define WAIT_VM(n) do {} while (0)
DEV void raw_barrier() { sync_threads(); }
DEV const char* uptr(const void* q) { return (const char*)q; }
DEV void st_wt2(float* p_, float a, float b) { p_[0] = a; p_[1] = b; }
DEV void ld_wt2(const float* p_, float& a, float& b) { a = p_[0]; b = p_[1]; }
DEV void st_wt1(float* p_, float a) { p_[0] = a; }
DEV float ld_wt1(const float* p_) { return p_[0]; }
#define __expf expf
#else
#include <hip/hip_runtime.h>
#define LAS __attribute__((address_space(3)))
#define GAS __attribute__((address_space(1)))
#define DEV __device__ __forceinline__
#define THREAD_IDX ((int)threadIdx.x)
DEV int opaque_tid_() { int t = (int)threadIdx.x; asm volatile("" : "+v"(t)); return t; }
#define OPAQUE_TID opaque_tid_()
DEV int opq(int x) { asm volatile("" : "+v"(x)); return x; }
#define BLOCK_IDX ((int)blockIdx.x)
DEV void sync_threads() { __syncthreads(); }
DEV float bf2f(bf16_t b) { return __uint_as_float((unsigned)b << 16); }
DEV bf16_t f2bf(float f) { unsigned u = __float_as_uint(f); return (bf16_t)((u + 0x7fffu + ((u >> 16) & 1u)) >> 16); }
DEV f32x16 mfma32(bf16x8 a, bf16x8 b, f32x16 c) { return __builtin_amdgcn_mfma_f32_32x32x16_bf16(a, b, c, 0, 0, 0); }
DEV f32x4 mfma16(bf16x8 a, bf16x8 b, f32x4 c) { return __builtin_amdgcn_mfma_f32_16x16x32_bf16(a, b, c, 0, 0, 0); }
typedef short v4i16_t __attribute__((ext_vector_type(4)));
DEV s16x4 lds_tr(const LAS char* p) { return __builtin_bit_cast(s16x4, __builtin_amdgcn_ds_read_tr16_b64_v4i16((LAS v4i16_t*)p)); }
DEV float shfl_xor_f(float v, int m) { return __shfl_xor(v, m); }
DEV float shfl_up_f(float v, int d) { return __shfl_up(v, d); }
DEV float shfl_idx_f(float v, int s) { return __shfl(v, s); }
DEV float fast_exp2(float x) { return __builtin_amdgcn_exp2f(x); }
DEV float fast_rcp(float x) { return __builtin_amdgcn_rcpf(x); }
DEV float fast_rsq(float x) { return __builtin_amdgcn_rsqf(x); }
DEV int rfl(int x) { return __builtin_amdgcn_readfirstlane(x); }
DEV void wave_sync() { asm volatile("s_waitcnt lgkmcnt(0)" ::: "memory"); }
DEV bool wave_any(bool v) { return __any(v); }
DEV void sched_fence() { __builtin_amdgcn_sched_barrier(0); }
DEV void lds_dma16(const GAS void* g, LAS char* l) { __builtin_amdgcn_global_load_lds((const GAS unsigned*)g, (LAS unsigned*)l, 16, 0, 0); }
#define WAIT_VM(n) asm volatile("s_waitcnt vmcnt(" #n ")" ::: "memory")
DEV void raw_barrier() { asm volatile("s_waitcnt lgkmcnt(0)" ::: "memory"); __builtin_amdgcn_s_barrier(); asm volatile("" ::: "memory"); }
DEV void st_wt2(float* p_, float a, float b) { __hip_atomic_store((unsigned long long*)p_, ((unsigned long long)__float_as_uint(b) << 32) | __float_as_uint(a), __ATOMIC_RELAXED, __HIP_MEMORY_SCOPE_AGENT); }
DEV void ld_wt2(const float* p_, float& a, float& b) { const unsigned long long v = __hip_atomic_load((unsigned long long*)p_, __ATOMIC_RELAXED, __HIP_MEMORY_SCOPE_AGENT); a = __uint_as_float((unsigned)v); b = __uint_as_float((unsigned)(v >> 32)); }
DEV void st_wt1(float* p_, float a) { __hip_atomic_store((unsigned*)p_, __float_as_uint(a), __ATOMIC_RELAXED, __HIP_MEMORY_SCOPE_AGENT); }
DEV float ld_wt1(const float* p_) { return __uint_as_float(__hip_atomic_load((unsigned*)p_, __ATOMIC_RELAXED, __HIP_MEMORY_SCOPE_AGENT)); }
DEV const GAS char* uptr(const void* q) { const unsigned long long v = (unsigned long long)q; const unsigned lo = __builtin_amdgcn_readfirstlane((unsigned)v), hi = __builtin_amdgcn_readfirstlane((unsigned)(v >> 32)); return (const GAS char*)(((unsigned long long)hi << 32) | lo); }
#endif
typedef LAS char* LDSP;
#ifdef HOST_EMU
DEV unsigned pk2(float lo, float hi) { return (unsigned)f2bf(lo) | ((unsigned)f2bf(hi) << 16); }
#else
typedef float f32x2_t_ __attribute__((ext_vector_type(2))); typedef __bf16 bf16x2_t_ __attribute__((ext_vector_type(2)));
DEV unsigned pk2(float lo, float hi) { const f32x2_t_ v = {lo, hi}; const bf16x2_t_ b = __builtin_convertvector(v, bf16x2_t_); return __builtin_bit_cast(unsigned, b); }
#endif
DEV int crow(int i, int hi) { return (i & 3) + 8 * (i >> 2) + 4 * hi; }
DEV unsigned offb(unsigned row, unsigned ch) { return 256u * row + 16u * (ch ^ (((row & 3u) << 2) | ((row >> 2) & 3u))); }
DEV bf16x8 lds_ld8(LDSP p) { return *(const LAS bf16x8*)p; }
DEV bf16x8 frag_row(LDSP tile, int rb, int ks, int lane) { return lds_ld8(tile + offb(rb + (lane & 31), 2 * ks + (lane >> 5))); }
DEV bf16x8 frag_tr(LDSP tile, int cb, int ks, int lane, bool perm) {
  const int h2 = lane >> 5, blk = (lane >> 4) & 1, q = (lane & 15) >> 2, p = lane & 3;
  const int r0 = perm ? (16 * ks + 4 * h2) : (16 * ks + 8 * h2), dr = perm ? 8 : 4;
  const unsigned ch = 4 * cb + 2 * blk + (p >> 1), bo = 8 * (p & 1);
  const s16x4 a = lds_tr(tile + offb(r0 + q, ch) + bo), b = lds_tr(tile + offb(r0 + dr + q, ch) + bo);
  return (bf16x8){a[0], a[1], a[2], a[3], b[0], b[1], b[2], b[3]};
}
DEV bf16x8 acc_frag(const f32x16& x, int s) {
  u32x4 w; w.x = pk2(x[8 * s + 0], x[8 * s + 1]); w.y = pk2(x[8 * s + 2], x[8 * s + 3]); w.z = pk2(x[8 * s + 4], x[8 * s + 5]); w.w = pk2(x[8 * s + 6], x[8 * s + 7]);
  return __builtin_bit_cast(bf16x8, w);
}
#ifndef SEQ
#define SEQ 8192
#endif
#ifndef BATCH
#define BATCH 4
#endif
constexpr int M_TOK = BATCH * SEQ, PW = 5632, OW = 2048, NCH = SEQ / 64;
constexpr int C_DAQ = 0, C_DAK = 512, C_DAV = 1024, C_MLQ = 1536, C_MLK = 2048, C_MLV = 2560, C_MLO = 3072, C_GLQ = 3584, C_GLK = 3840, C_GLV = 4096, C_GLR = 4608, C_S5U = 5120;
constexpr int NW_MLI = 0, NW_MLF = 4, NW_GLA = 8, NWP = 32;
constexpr float LOG2E = 1.4426950408889634f, RMS_EPS = 1e-6f;
#define NEG_INF (-__builtin_inff())

DEV float sigmoidf_(float x) { return fast_rcp(1.0f + fast_exp2(-x * LOG2E)); }
DEV float log_sigmoidf_(float x) {
  const float ax = x < 0.f ? -x : x; return (x < 0.f ? x : 0.f) - log1pf(__expf(-ax)); }
DEV float wave_sum_f(float v) { for (int o = 1; o < 64; o <<= 1) v += shfl_xor_f(v, o); return v; }

DEV void attn_unit(LDSP lds, const LAS float* biasT, const bf16_t* __restrict__ proj, bf16_t* __restrict__ oall, float lam, float lam_init, int b, int h, int qb) {
  const int tid = OPAQUE_TID, lane = tid & 63, wave = rfl(tid >> 6), l31 = lane & 31, h2 = lane >> 5;
  const int mp = wave >> 2, wq = wave & 3, q0 = qb * 128, r0 = q0 + 32 * wq;
  const size_t rowbase = (size_t)b * SEQ;
  bf16x8 qf[4];
  { const bf16_t* qp = proj + (rowbase + r0 + l31) * PW + C_DAQ + h * 128 + mp * 64 + 8 * h2;
#pragma unroll
    for (int ks = 0; ks < 4; ++ks) qf[ks] = *(const bf16x8*)(qp + 16 * ks); }
  f32x16 o[4];
#pragma unroll
  for (int c = 0; c < 4; ++c)
#pragma unroll
    for (int i = 0; i < 16; ++i) o[c][i] = 0.f;
  float mrun = 0.f, lpart = 0.f;
  const int nt = 2 * qb + 2, tlast = (r0 + 31) >> 6;
  const float THR = 8.0f;
  const LAS float* bt = biasT + h * 128;
  const float bfar = bt[127];
  unsigned koff[4], vb[2][4];
  { const int blk = (lane >> 4) & 1, q = (lane & 15) >> 2, p = lane & 3;
#pragma unroll
    for (int ks = 0; ks < 4; ++ks) koff[ks] = offb(l31, 8 * mp + 2 * ks + h2);
#pragma unroll
    for (int tt = 0; tt < 2; ++tt)
#pragma unroll
      for (int c = 0; c < 4; ++c) vb[tt][c] = 256u * (8 * tt + 4 * h2 + q) + 16u * ((2 * blk + (p >> 1)) ^ ((2 * tt + h2) & 3)) + 8u * (p & 1) + 64u * (c ^ q); }
  u32x4 rk[2], rv[2];
  const GAS char* gk = uptr(proj + rowbase * PW + C_DAK + h * 128); const unsigned goff = (unsigned)((tid >> 4) * PW + (tid & 15) * 8) * 2u, soff = offb(tid >> 4, tid & 15);
#define ATT_LOAD(t) do { _Pragma("unroll") for (int i = 0; i < 2; ++i) { const unsigned o_ = goff + (unsigned)((64 * (t) + 32 * i) * PW) * 2u; \
    rk[i] = *(const GAS u32x4*)(gk + o_); rv[i] = *(const GAS u32x4*)(gk + o_ + (C_DAV - C_DAK) * 2); } } while (0)
#define ATT_STORE(buf) do { _Pragma("unroll") for (int i = 0; i < 2; ++i) { \
    *(LAS u32x4*)(lds + (buf) * 16384 + soff + 8192 * i) = rk[i]; *(LAS u32x4*)(lds + 32768 + (buf) * 16384 + soff + 8192 * i) = rv[i]; } } while (0)
  ATT_LOAD(0); ATT_STORE(0); sync_threads();
  for (int t = 0; t < nt; ++t) {
    if (t + 1 < nt) ATT_LOAD(t + 1);
    if (t <= tlast) {
      LDSP Kt = lds + (t & 1) * 16384, Vt = lds + 32768 + (t & 1) * 16384;
      const int qabs = r0 + l31, j0 = 64 * t;
      const bool far = (r0 - (j0 + 63)) >= 127;
      const float cinit = (far ? bfar : 0.f) - mrun;
      f32x16 p[2];
#pragma unroll
      for (int kb = 0; kb < 2; ++kb) {
#pragma unroll
        for (int i = 0; i < 16; ++i) p[kb][i] = cinit;
#pragma unroll
        for (int ks = 0; ks < 4; ++ks) p[kb] = mfma32(lds_ld8(Kt + koff[ks] + 8192 * kb), qf[ks], p[kb]);
      }
      float mx = NEG_INF;
      if (far) {
#pragma unroll
        for (int kb = 0; kb < 2; ++kb)
#pragma unroll
          for (int i = 0; i < 16; i += 2) mx = fmaxf(fmaxf(mx, p[kb][i]), p[kb][i + 1]);
      } else {
#pragma unroll
        for (int kb = 0; kb < 2; ++kb)
#pragma unroll
          for (int i = 0; i < 16; ++i) {
            const int dist = qabs - (j0 + 32 * kb + crow(i, h2));
            float s = p[kb][i] + bt[dist < 0 ? 0 : (dist > 127 ? 127 : dist)]; if (dist < 0) s = NEG_INF;
            p[kb][i] = s; mx = fmaxf(mx, s);
          }
      }
      mx = fmaxf(mx, shfl_xor_f(mx, 32));
      if (__builtin_expect(wave_any(mx > THR) || t == 0, 0)) {
        const float delta = (mx > THR || t == 0) ? mx : 0.f, alpha = fast_exp2(-delta);
        mrun += delta; lpart *= alpha;
#pragma unroll
        for (int c = 0; c < 4; ++c)
#pragma unroll
          for (int i = 0; i < 16; ++i) o[c][i] *= alpha;
#pragma unroll
        for (int kb = 0; kb < 2; ++kb)
#pragma unroll
          for (int i = 0; i < 16; ++i) p[kb][i] -= delta;
      }
      float rs = 0.f;
#pragma unroll
      for (int kb = 0; kb < 2; ++kb)
#pragma unroll
        for (int i = 0; i < 16; ++i) { const float e = fast_exp2(p[kb][i]); p[kb][i] = e; rs += e; }
      lpart += rs;
#pragma unroll
      for (int ks = 0; ks < 4; ++ks) {
        const bf16x8 pf = acc_frag(p[ks >> 1], ks & 1);
#pragma unroll
        for (int c = 0; c < 4; ++c) { const s16x4 va = lds_tr(Vt + vb[0][c] + 4096 * ks), vc = lds_tr(Vt + vb[1][c] + 4096 * ks);
          o[c] = mfma32((bf16x8){va[0], va[1], va[2], va[3], vc[0], vc[1], vc[2], vc[3]}, pf, o[c]); }
      }
    }
    if (t + 1 < nt) ATT_STORE((t + 1) & 1);
    sync_threads();
  }
#undef ATT_LOAD
#undef ATT_STORE
  { const float ltot = lpart + shfl_xor_f(lpart, 32), inv = 1.0f / ltot;
#pragma unroll
    for (int c = 0; c < 4; ++c)
#pragma unroll
      for (int i = 0; i < 16; ++i) o[c][i] *= inv; }
  LAS float* X = (LAS float*)lds;
  if (mp == 1) {
#pragma unroll
    for (int c = 0; c < 4; ++c)
#pragma unroll
      for (int i = 0; i < 16; ++i) X[((wq * 4 + c) * 16 + i) * 64 + lane] = o[c][i];
  }
  sync_threads();
  if (mp == 0) {
    float ss = 0.f;
#pragma unroll
    for (int c = 0; c < 4; ++c)
#pragma unroll
      for (int i = 0; i < 16; ++i) { const float d = o[c][i] - lam * X[((wq * 4 + c) * 16 + i) * 64 + lane]; o[c][i] = d; ss += d * d; }
    ss += shfl_xor_f(ss, 32);
    const float r = (1.0f - lam_init) / sqrtf(ss * (1.0f / 128.0f) + RMS_EPS);
    bf16_t* op = oall + (rowbase + r0 + l31) * OW + 0 + h * 128 + 4 * h2;
#pragma unroll
    for (int c = 0; c < 4; ++c)
#pragma unroll
      for (int g = 0; g < 4; ++g) { u32x2 w; w.x = pk2(o[c][4 * g] * r, o[c][4 * g + 1] * r); w.y = pk2(o[c][4 * g + 2] * r, o[c][4 * g + 3] * r);
        *(u32x2*)(op + 32 * c + 8 * g) = w; }
  }
  sync_threads();
}

DEV void mlstm_item(LDSP lds, const bf16_t* __restrict__ proj, const float* __restrict__ narrow, const float* __restrict__ convw  , const float* __restrict__ gateb  ,
                    bf16_t* __restrict__ oall, int b, int h) {
  const int tid0 = OPAQUE_TID, wave = rfl(tid0 >> 6);
#define ML_LANES() const int tid = opq(tid0), lane = tid & 63, l31 = lane & 31, h2 = lane >> 5; (void)l31; (void)h2; (void)lane
  LDSP Qt = lds, Kt = lds + 16384, Vt = lds + 32768, KWt = lds + 49152, Ct = lds + 65536;
  LAS float* F = (LAS float*)(lds + 106496);
  LAS float *U = F, *Mv = F + 64, *AT = F + 128, *EM = F + 192, *WJ = F + 256, *QN = F + 320, *SC = F + 384, *NV = F + 392, *CW = F + 520;
  const size_t rowbase = (size_t)b * SEQ;
  { ML_LANES();
    for (int i = tid; i < 40960 / 4; i += 512) ((LAS unsigned*)Ct)[i] = 0u;
    if (tid < 128) NV[tid] = 0.f;
    for (int i = tid; i < 1024; i += 512) { const int j = i >> 8, r = i & 255; CW[i] = convw[j * 1024 + (r >> 7) * 512 + h * 128 + (r & 127)]; }
  }
  const float gb0 = gateb[h], gb1 = gateb[4 + h];
  f32x16 cst[2];
#pragma unroll
  for (int x = 0; x < 2; ++x)
#pragma unroll
    for (int i = 0; i < 16; ++i) cst[x][i] = 0.f;
  float mprev = 0.f;
  const int eb = wave & 3, tb = wave >> 2;
  bf16x8 rqk[11]; u32x4 rvv[4]; float rig = 0.f, rfg = 0.f;
#define ML_PREFETCH(chn) do { ML_LANES(); const size_t t0n = rowbase + (size_t)(chn) * 64; const GAS char* pb = uptr(proj + (t0n - 3) * PW); \
    if (tid < 256) { const int which = (tid >> 7) & 1, dch = tid & 15, tg = (tid & 127) >> 4; unsigned voff = (unsigned)((tg * 8) * PW + (which ? C_MLK : C_MLQ) + h * 128 + dch * 8) * 2u; \
      _Pragma("unroll") for (int r = 0; r < 11; ++r) { bf16x8 v = (bf16x8){0, 0, 0, 0, 0, 0, 0, 0}; if ((chn) * 64 + tg * 8 - 3 + r >= 0) v = *(const GAS bf16x8*)(pb + voff); rqk[r] = v; voff += PW * 2; } } \
    else { const int t2 = tid - 256; _Pragma("unroll") for (int i = 0; i < 4; ++i) { const int id = t2 + 256 * i, row = id >> 4, c16 = id & 15; rvv[i] = *(const GAS u32x4*)(pb + (unsigned)((row + 3) * PW + C_MLV + h * 128 + c16 * 8) * 2u); } } \
    if (wave == 0) { const GAS char* nb = uptr(narrow + t0n * NWP); rig = *(const GAS float*)(nb + (unsigned)(lane * NWP + NW_MLI + h) * 4u); rfg = *(const GAS float*)(nb + (unsigned)(lane * NWP + NW_MLF + h) * 4u); } } while (0)
  ML_PREFETCH(0);
  sync_threads();
  for (int ch = 0; ch < NCH; ++ch) {
    const size_t t0 = rowbase + (size_t)ch * 64;
    const GAS char* pbase = uptr(proj + (t0 - 3) * PW);
    { ML_LANES();
      if (tid < 256) {
        const int which = (tid >> 7) & 1, dch = tid & 15, tg = (tid & 127) >> 4;
        float cw[4][8];
#pragma unroll
        for (int j = 0; j < 4; ++j) { const f32x4 a = *(const LAS f32x4*)(CW + j * 256 + which * 128 + dch * 8), c = *(const LAS f32x4*)(CW + j * 256 + which * 128 + dch * 8 + 4);
          cw[j][0] = a[0]; cw[j][1] = a[1]; cw[j][2] = a[2]; cw[j][3] = a[3]; cw[j][4] = c[0]; cw[j][5] = c[1]; cw[j][6] = c[2]; cw[j][7] = c[3]; }
        float win[3][8];
#pragma unroll
        for (int r = 0; r < 3; ++r)
#pragma unroll
          for (int d = 0; d < 8; ++d) win[r][d] = bf2f((bf16_t)rqk[r][d]);
        const float osc = which ? 0.08838834764831845f : 1.0f;
        LDSP dstT = which ? Kt : Qt;
#pragma unroll
        for (int r = 0; r < 8; ++r) {
          float cur[8], y[8];
#pragma unroll
          for (int d = 0; d < 8; ++d) { cur[d] = bf2f((bf16_t)rqk[3 + r][d]); const float a = cw[0][d] * win[0][d] + cw[1][d] * win[1][d] + cw[2][d] * win[2][d] + cw[3][d] * cur[d];
            y[d] = a * sigmoidf_(a) * osc; win[0][d] = win[1][d]; win[1][d] = win[2][d]; win[2][d] = cur[d]; }
          u32x4 w; w.x = pk2(y[0], y[1]); w.y = pk2(y[2], y[3]); w.z = pk2(y[4], y[5]); w.w = pk2(y[6], y[7]);
          *(LAS u32x4*)(dstT + offb(tg * 8 + r, dch)) = w;
        }
      } else {
        const int t2 = tid - 256;
#pragma unroll
        for (int i = 0; i < 4; ++i) { const int id = t2 + 256 * i, row = id >> 4, c16 = id & 15; *(LAS u32x4*)(Vt + offb(row, c16)) = rvv[i]; }
      }
      if (wave == 0) {
        const float ig = rig + gb0;
        const float lf = log_sigmoidf_(rfg + gb1);
        float bsum = lf;
#pragma unroll
        for (int d = 1; d < 64; d <<= 1) { const float o_ = shfl_up_f(bsum, d); if (lane >= d) bsum += o_; }
        const float u = ig - bsum; float pm = u;
#pragma unroll
        for (int d = 1; d < 64; d <<= 1) { const float o_ = shfl_up_f(pm, d); if (lane >= d) pm = fmaxf(pm, o_); }
        const float Mt = fmaxf(mprev, pm);
        const float Mlast = shfl_idx_f(Mt, 63), blast = shfl_idx_f(bsum, 63);
        U[lane] = u; Mv[lane] = Mt; AT[lane] = __expf(mprev - Mt); EM[lane] = __expf(-(bsum + Mt)); WJ[lane] = __expf(u - Mlast);
        if (lane == 0) SC[0] = __expf(mprev - Mlast);
        mprev = blast + Mlast;
      }
    }
    if (ch + 1 < NCH) ML_PREFETCH(ch + 1);
    sync_threads();
    { ML_LANES();
#pragma unroll
      for (int i = 0; i < 2; ++i) { const int id = tid + 512 * i, row = id >> 4, c16 = id & 15; const float wj = WJ[row];
        const bf16x8 v = lds_ld8(Kt + offb(row, c16)); u32x4 w;
        w.x = pk2(bf2f((bf16_t)v[0]) * wj, bf2f((bf16_t)v[1]) * wj); w.y = pk2(bf2f((bf16_t)v[2]) * wj, bf2f((bf16_t)v[3]) * wj);
        w.z = pk2(bf2f((bf16_t)v[4]) * wj, bf2f((bf16_t)v[5]) * wj); w.w = pk2(bf2f((bf16_t)v[6]) * wj, bf2f((bf16_t)v[7]) * wj);
        *(LAS u32x4*)(KWt + offb(row, c16)) = w; }
    }
    sync_threads();
    if (eb == 0) {
      ML_LANES();
      f32x16 qn;
#pragma unroll
      for (int i = 0; i < 16; ++i) qn[i] = 0.f;
#pragma unroll
      for (int ks = 0; ks < 8; ++ks) qn = mfma32(frag_row(Ct, 128, ks, lane), frag_row(Qt, 32 * tb, ks, lane), qn);
      if (h2 == 0) QN[32 * tb + l31] = qn[0];
    }
    f32x16 acc;
    { ML_LANES();
#pragma unroll
      for (int i = 0; i < 16; ++i) acc[i] = 0.f;
#pragma unroll
      for (int ks = 0; ks < 8; ++ks) acc = mfma32(frag_row(Ct, 32 * eb, ks, lane), frag_row(Qt, 32 * tb, ks, lane), acc);
    }
    float rsum = 0.f;
#pragma unroll
    for (int jb = 0; jb < 2; ++jb) {
      if (jb <= tb) {
        ML_LANES();
        const int tl = 32 * tb + l31; const float Mt = Mv[tl];
        if (jb == 0) { const float at = AT[tl];
#pragma unroll
          for (int i = 0; i < 16; ++i) acc[i] *= at; }
        f32x16 s;
#pragma unroll
        for (int i = 0; i < 16; ++i) s[i] = 0.f;
#pragma unroll
        for (int ks = 0; ks < 8; ++ks) s = mfma32(frag_row(Kt, 32 * jb, ks, lane), frag_row(Qt, 32 * tb, ks, lane), s);
#pragma unroll
        for (int i = 0; i < 16; ++i) { const int j = 32 * jb + crow(i, h2); const float w = (j <= tl) ? __expf(U[j] - Mt) : 0.f; s[i] *= w; rsum += s[i]; }
#pragma unroll
        for (int s2 = 0; s2 < 2; ++s2) acc = mfma32(frag_tr(Vt, eb, 2 * jb + s2, lane, true), acc_frag(s, s2), acc);
      }
    }
    rsum += shfl_xor_f(rsum, 32);
    sync_threads();
    { ML_LANES();
      const int tl = 32 * tb + l31;
      const float den = AT[tl] * QN[tl] + rsum; const float dd = fmaxf(fabsf(den), EM[tl]); const float inv = 1.0f / dd;
      const GAS char* og = pbase + (unsigned)((tl + 3) * PW + C_MLO + h * 128 + 32 * eb + 4 * h2) * 2u; GAS char* op = (GAS char*)uptr(oall + t0 * OW) + (unsigned)(tl * OW + 512 + h * 128 + 32 * eb + 4 * h2) * 2u;
#pragma unroll
      for (int g = 0; g < 4; ++g) { const u32x2 gv2 = *(const GAS u32x2*)(og + 16 * g);
        const float g0 = sigmoidf_(bf2f((bf16_t)(gv2.x & 0xffff))), g1 = sigmoidf_(bf2f((bf16_t)(gv2.x >> 16))), g2 = sigmoidf_(bf2f((bf16_t)(gv2.y & 0xffff))), g3 = sigmoidf_(bf2f((bf16_t)(gv2.y >> 16)));
        u32x2 w; w.x = pk2(acc[4 * g] * inv * g0, acc[4 * g + 1] * inv * g1); w.y = pk2(acc[4 * g + 2] * inv * g2, acc[4 * g + 3] * inv * g3);
        *(GAS u32x2*)(op + 16 * g) = w; }
    }
    { ML_LANES();
      const float ast = SC[0]; const int db = wave >> 1;
#pragma unroll
      for (int x = 0; x < 2; ++x)
#pragma unroll
        for (int i = 0; i < 16; ++i) cst[x][i] *= ast;
#pragma unroll
      for (int ks = 0; ks < 4; ++ks) { const bf16x8 af = frag_tr(KWt, db, ks, lane, false);
#pragma unroll
        for (int x = 0; x < 2; ++x) cst[x] = mfma32(af, frag_tr(Vt, 2 * (wave & 1) + x, ks, lane, false), cst[x]); }
#pragma unroll
      for (int x = 0; x < 2; ++x) { const int e = 32 * (2 * (wave & 1) + x) + l31;
#pragma unroll
        for (int g = 0; g < 4; ++g) { const int d = 32 * db + 8 * g + 4 * h2; u32x2 w; w.x = pk2(cst[x][4 * g], cst[x][4 * g + 1]); w.y = pk2(cst[x][4 * g + 2], cst[x][4 * g + 3]);
          *(LAS u32x2*)(Ct + offb(e, d >> 3) + (d & 7) * 2) = w; } }
    }
    if ((wave & 1) == 0) {
      ML_LANES(); const int db = wave >> 1; const float ast = SC[0];
      const bf16x8 ones = (bf16x8){0x3f80, 0x3f80, 0x3f80, 0x3f80, 0x3f80, 0x3f80, 0x3f80, 0x3f80};
      f32x16 cs;
#pragma unroll
      for (int i = 0; i < 16; ++i) cs[i] = 0.f;
#pragma unroll
      for (int ks = 0; ks < 4; ++ks) cs = mfma32(frag_tr(KWt, db, ks, lane, false), ones, cs);
      if (l31 == 0) {
#pragma unroll
        for (int i = 0; i < 16; ++i) { const int d = 32 * db + crow(i, h2); const float nn = ast * NV[d] + cs[i]; NV[d] = nn; *(LAS bf16_t*)(Ct + offb(128, d >> 3) + (d & 7) * 2) = f2bf(nn); } }
    }
    sync_threads();
  }
#undef ML_LANES
#undef ML_PREFETCH
}

constexpr int ST_PITCH = 144;
DEV void gla_item(LDSP lds, const bf16_t* __restrict__ proj, const float* __restrict__ narrow, const float* __restrict__ wa2  , const float* __restrict__ ba  ,
                  bf16_t* __restrict__ oall, int b, int h) {
  const int tid = OPAQUE_TID, lane = tid & 63, wave = rfl(tid >> 6), l31 = lane & 31, h2 = lane >> 5;
  LDSP QKt = lds, KWt = lds + 16384, Vt = lds + 32768, St = lds + 49152;
  LAS float* F = (LAS float*)(lds + 69632);
  LAS float *GA = F, *TOT = F + 1024, *EL = F + 1536, *SS = F + 1600;
  const size_t rowbase = (size_t)b * SEQ;
  for (int i = tid; i < 128 * ST_PITCH / 4; i += 512) ((LAS unsigned*)St)[i] = 0u;
  for (int i = tid; i < 16384 / 4; i += 512) ((LAS unsigned*)KWt)[i] = 0u;
  const int d = tid & 63, tg = tid >> 6;
  float wcol[16];
#pragma unroll
  for (int r = 0; r < 16; ++r) wcol[r] = wa2[r * 256 + h * 64 + d];
  const float bad = ba[h * 64 + d];
  f32x16 sst;
#pragma unroll
  for (int i = 0; i < 16; ++i) sst[i] = 0.f;
  const int eb = wave & 3, tb = wave >> 2;
  float rga[2]; u32x4 rvv[2]; bf16_t rq[8], rk[8];
#define GLA_PREFETCH(chn) do { const size_t t0n = rowbase + (size_t)(chn) * 64; const GAS char* pb = uptr(proj + t0n * PW); const GAS char* nb = uptr(narrow + t0n * NWP); \
    { const int id = tid * 2, row = id >> 4, c = id & 15; const GAS float* gp = (const GAS float*)(nb + (unsigned)(row * NWP + NW_GLA + c) * 4u); rga[0] = gp[0]; rga[1] = gp[1]; } \
    _Pragma("unroll") for (int i = 0; i < 2; ++i) { const int id = tid + 512 * i, row = id >> 4, c16 = id & 15; rvv[i] = *(const GAS u32x4*)(pb + (unsigned)(row * PW + C_GLV + h * 128 + c16 * 8) * 2u); } \
    _Pragma("unroll") for (int r = 0; r < 8; ++r) { const unsigned o = (unsigned)((8 * tg + r) * PW + h * 64 + d) * 2u; rq[r] = *(const GAS bf16_t*)(pb + o + C_GLQ * 2); rk[r] = *(const GAS bf16_t*)(pb + o + C_GLK * 2); } } while (0)
  GLA_PREFETCH(0);
  sync_threads();
  for (int ch = 0; ch < NCH; ++ch) {
    const size_t t0 = rowbase + (size_t)ch * 64;
    { const int id = tid * 2; GA[id] = rga[0]; GA[id + 1] = rga[1]; }
#pragma unroll
    for (int i = 0; i < 2; ++i) { const int id = tid + 512 * i, row = id >> 4, c16 = id & 15; *(LAS u32x4*)(Vt + offb(row, c16)) = rvv[i]; }
    float qraw[8], kraw8[8];
#pragma unroll
    for (int r = 0; r < 8; ++r) { qraw[r] = bf2f(rq[r]); kraw8[r] = bf2f(rk[r]); }
    if (ch + 1 < NCH) GLA_PREFETCH(ch + 1);
    sync_threads();
    float bc[8], tot = 0.f;
#pragma unroll
    for (int r = 0; r < 8; ++r) { const int t = 8 * tg + r; float z = bad;
#pragma unroll
      for (int k = 0; k < 16; ++k) z += GA[t * 16 + k] * wcol[k];
      tot += log_sigmoidf_(z) * 0.0625f; bc[r] = tot; }
    TOT[tg * 64 + d] = tot;
    sync_threads();
    float off = 0.f, last = 0.f;
#pragma unroll
    for (int g = 0; g < 8; ++g) { const float v = TOT[g * 64 + d]; if (g < tg) off += v; last += v; }
    if (tg == 0) EL[d] = __expf(last);
#pragma unroll
    for (int r = 0; r < 8; ++r) { const int t = 8 * tg + r; const float bcv = bc[r] + off;
      const float qv = qraw[r] * 0.125f * __expf(bcv);
      const float kraw = kraw8[r];
      *(LAS bf16_t*)(QKt + offb(t, d >> 3) + (d & 7) * 2) = f2bf(qv);
      *(LAS bf16_t*)(QKt + offb(t, 8 + (d >> 3)) + (d & 7) * 2) = f2bf(kraw * __expf(-bcv));
      *(LAS bf16_t*)(KWt + offb(t, d >> 3) + (d & 7) * 2) = f2bf(kraw * __expf(last - bcv)); }
    sync_threads();
    f32x16 acc;
#pragma unroll
    for (int i = 0; i < 16; ++i) acc[i] = 0.f;
#pragma unroll
    for (int ks = 0; ks < 4; ++ks) acc = mfma32(lds_ld8(St + (32 * eb + l31) * ST_PITCH + (16 * ks + 8 * h2) * 2), frag_row(QKt, 32 * tb, ks, lane), acc);
    const int tl = 32 * tb + l31;
#pragma unroll
    for (int jb = 0; jb < 2; ++jb) {
      if (jb <= tb) {
        f32x16 s;
#pragma unroll
        for (int i = 0; i < 16; ++i) s[i] = 0.f;
#pragma unroll
        for (int ks = 0; ks < 4; ++ks) s = mfma32(frag_row(QKt, 32 * jb, 4 + ks, lane), frag_row(QKt, 32 * tb, ks, lane), s);
#pragma unroll
        for (int i = 0; i < 16; ++i) { const int j = 32 * jb + crow(i, h2); if (j > tl) s[i] = 0.f; }
#pragma unroll
        for (int s2 = 0; s2 < 2; ++s2) acc = mfma32(frag_tr(Vt, eb, 2 * jb + s2, lane, true), acc_frag(s, s2), acc);
      }
    }
    float ss = 0.f;
#pragma unroll
    for (int i = 0; i < 16; ++i) ss += acc[i] * acc[i];
    ss += shfl_xor_f(ss, 32);
    if (h2 == 0) SS[eb * 64 + tl] = ss;
    sync_threads();
    {
      const float tot2 = SS[tl] + SS[64 + tl] + SS[128 + tl] + SS[192 + tl]; const float r = 1.0f / sqrtf(tot2 * (1.0f / 128.0f) + RMS_EPS);
      const size_t row = t0 + tl; const bf16_t* gr = proj + row * PW + C_GLR + h * 128 + 32 * eb + 4 * h2; bf16_t* op = oall + row * OW + 1024 + h * 128 + 32 * eb + 4 * h2;
#pragma unroll
      for (int g = 0; g < 4; ++g) { const u32x2 gv2 = *(const u32x2*)(gr + 8 * g);
        const float r0 = bf2f((bf16_t)(gv2.x & 0xffff)), r1 = bf2f((bf16_t)(gv2.x >> 16)), r2 = bf2f((bf16_t)(gv2.y & 0xffff)), r3 = bf2f((bf16_t)(gv2.y >> 16));
        u32x2 w; w.x = pk2(acc[4 * g] * r * r0 * sigmoidf_(r0), acc[4 * g + 1] * r * r1 * sigmoidf_(r1)); w.y = pk2(acc[4 * g + 2] * r * r2 * sigmoidf_(r2), acc[4 * g + 3] * r * r3 * sigmoidf_(r3));
        *(u32x2*)(op + 8 * g) = w; }
    }
    { const int db = wave >> 2;
#pragma unroll
      for (int i = 0; i < 16; ++i) sst[i] *= EL[32 * db + crow(i, h2)];
#pragma unroll
      for (int ks = 0; ks < 4; ++ks) sst = mfma32(frag_tr(KWt, db, ks, lane, false), frag_tr(Vt, eb, ks, lane, false), sst);
      const int e = 32 * eb + l31;
#pragma unroll
      for (int g = 0; g < 4; ++g) { const int dd = 32 * db + 8 * g + 4 * h2; u32x2 w; w.x = pk2(sst[4 * g], sst[4 * g + 1]); w.y = pk2(sst[4 * g + 2], sst[4 * g + 3]);
        *(LAS u32x2*)(St + e * ST_PITCH + dd * 2) = w; } }
    sync_threads();
  }
#undef GLA_PREFETCH
}

constexpr int S5_WAVE_LDS = 12800, XS_PITCH = 272;
DEV float gelu_tanh_(float y) { const float u = 0.7978845608028654f * (y + 0.044715f * y * y * y); const float e = fast_exp2(2.0f * LOG2E * u); const float th = 1.0f - 2.0f * fast_rcp(e + 1.0f); return 0.5f * y * (1.0f + th); }
DEV void s5_wave(LDSP wl, const bf16_t* __restrict__ proj, const float* __restrict__ AB, const bf16_t* __restrict__ BT, const bf16_t* __restrict__ CT, const float* __restrict__ dskip  ,
                 bf16_t* __restrict__ zout  , int b, int g) {
  const int lane = OPAQUE_TID & 63, l15 = lane & 15, kg = lane >> 4;
  LAS float* BU = (LAS float*)wl; LDSP XS = wl + 8192;
  const float are = AB[(g * 64 + lane) * 2], aim = AB[(g * 64 + lane) * 2 + 1];
  bf16x8 bfr[8], cfr[4]; const bf16x8 zero8 = (bf16x8){0, 0, 0, 0, 0, 0, 0, 0};
#pragma unroll
  for (int nb = 0; nb < 8; ++nb) bfr[nb] = (kg < 2) ? *(const bf16x8*)(BT + ((size_t)g * 128 + 16 * nb + l15) * 16 + 8 * kg) : zero8;
#pragma unroll
  for (int ks = 0; ks < 4; ++ks) cfr[ks] = *(const bf16x8*)(CT + ((size_t)g * 16 + l15) * 128 + 32 * ks + 8 * kg);
  const float dsk = dskip[g * 16 + l15];
  float xr = 0.f, xi = 0.f;
  const size_t rowbase = (size_t)b * SEQ;
  for (int t0 = 0; t0 < SEQ; t0 += 16) {
    const bf16_t* up = proj + (rowbase + t0) * PW + C_S5U + g * 16;
    const bf16x8 ua = (kg < 2) ? *(const bf16x8*)(up + (size_t)l15 * PW + 8 * kg) : zero8;
#pragma unroll
    for (int nb = 0; nb < 8; ++nb) { f32x4 c4 = (f32x4){0.f, 0.f, 0.f, 0.f}; c4 = mfma16(ua, bfr[nb], c4);
#pragma unroll
      for (int i = 0; i < 4; ++i) BU[(4 * kg + i) * 128 + 16 * nb + l15] = c4[i]; }
    wave_sync();
#pragma unroll
    for (int j = 0; j < 16; ++j) { const float br = BU[j * 128 + lane], bi = BU[j * 128 + 64 + lane];
      const float nr = are * xr - aim * xi + br, ni = are * xi + aim * xr + bi; xr = nr; xi = ni;
      *(LAS bf16_t*)(XS + j * XS_PITCH + lane * 2) = f2bf(xr); *(LAS bf16_t*)(XS + j * XS_PITCH + (64 + lane) * 2) = f2bf(xi); }
    wave_sync();
    f32x4 y4 = (f32x4){0.f, 0.f, 0.f, 0.f};
#pragma unroll
    for (int ks = 0; ks < 4; ++ks) y4 = mfma16(lds_ld8(XS + l15 * XS_PITCH + (32 * ks + 8 * kg) * 2), cfr[ks], y4);
#pragma unroll
    for (int i = 0; i < 4; ++i) { const size_t row = rowbase + t0 + 4 * kg + i; const float uu = bf2f(proj[row * PW + C_S5U + g * 16 + l15]);
      zout[row * 512 + g * 16 + l15] = f2bf(gelu_tanh_(y4[i] + dsk * uu)); }
  }
}
constexpr int S5_LC = (SEQ >= 2048) ? 1024 : (SEQ / 2), S5_NC = SEQ / S5_LC;
template <int MODE>
DEV void s5_chunk(LDSP wl, const bf16_t* __restrict__ proj, const float* __restrict__ AB, const float* __restrict__ ABL, const bf16_t* __restrict__ BT, const bf16_t* __restrict__ CT, const float* __restrict__ dskip  ,
                  float* __restrict__ s5st  , bf16_t* __restrict__ zout  , int b, int g, int c) {
  const int lane = OPAQUE_TID & 63, l15 = lane & 15, kg = lane >> 4;
  LAS float* BU = (LAS float*)wl; LDSP XS = wl + 8192;
  const float are = AB[(g * 64 + lane) * 2], aim = AB[(g * 64 + lane) * 2 + 1];
  bf16x8 bfr[8], cfr[4]; const bf16x8 zero8 = (bf16x8){0, 0, 0, 0, 0, 0, 0, 0};
#pragma unroll
  for (int nb = 0; nb < 8; ++nb) bfr[nb] = (kg < 2) ? *(const bf16x8*)(BT + ((size_t)g * 128 + 16 * nb + l15) * 16 + 8 * kg) : zero8;
  bf16x8 dfr = zero8;
  if (MODE == 3) {
#pragma unroll
    for (int ks = 0; ks < 4; ++ks) cfr[ks] = *(const bf16x8*)(CT + ((size_t)g * 16 + l15) * 128 + 32 * ks + 8 * kg);
    const float dsk = dskip[g * 16 + l15]; const bf16_t dhi = f2bf(dsk), dlo = f2bf(dsk - bf2f(dhi));
#pragma unroll
    for (int kk = 0; kk < 8; ++kk) { const int k = 8 * kg + kk; dfr[kk] = ((k & 15) == l15) ? (short)(k < 16 ? dhi : dlo) : (short)0; } }
  float xr = 0.f, xi = 0.f;
  float* rec = s5st + ((size_t)(b * 32 + g) * S5_NC) * 128 + lane * 2;
  if (MODE == 3) { const float lr = ABL[(g * 64 + lane) * 2], li = ABL[(g * 64 + lane) * 2 + 1];
    for (int k = 0; k < c; ++k) { float er, ei; ld_wt2(rec + k * 128, er, ei); const float nr = lr * xr - li * xi + er, ni = lr * xi + li * xr + ei; xr = nr; xi = ni; } }
  const size_t rowbase = (size_t)b * SEQ + (size_t)c * S5_LC;
  const bf16_t* ubase = proj + (rowbase + l15) * PW + C_S5U + g * 16 + 8 * (kg & 1);
  constexpr int SB = 4;
  bf16x8 un[SB];
#pragma unroll
  for (int i = 0; i < SB; ++i) un[i] = *(const bf16x8*)(ubase + (size_t)(16 * i) * PW);
  for (int s0 = 0; s0 < S5_LC; s0 += 16 * SB) {
    bf16x8 uc[SB];
#pragma unroll
    for (int i = 0; i < SB; ++i) uc[i] = un[i];
    if (s0 + 16 * SB < S5_LC) {
#pragma unroll
      for (int i = 0; i < SB; ++i) un[i] = *(const bf16x8*)(ubase + (size_t)(s0 + 16 * SB + 16 * i) * PW); }
#pragma unroll
    for (int sb = 0; sb < SB; ++sb) {
      const bf16x8 ua = uc[sb];
#pragma unroll
      for (int nb = 0; nb < 8; ++nb) { f32x4 c4 = (f32x4){0.f, 0.f, 0.f, 0.f}; c4 = mfma16(ua, bfr[nb], c4);
#pragma unroll
        for (int i = 0; i < 4; ++i) BU[(4 * kg + i) * 128 + 16 * nb + l15] = c4[i]; }
      wave_sync();
#pragma unroll
      for (int j = 0; j < 16; ++j) { const float br = BU[j * 128 + lane], bi = BU[j * 128 + 64 + lane];
        const float nr = are * xr - aim * xi + br, ni = are * xi + aim * xr + bi; xr = nr; xi = ni;
        if (MODE == 3) { *(LAS bf16_t*)(XS + j * XS_PITCH + lane * 2) = f2bf(xr); *(LAS bf16_t*)(XS + j * XS_PITCH + (64 + lane) * 2) = f2bf(xi); } }
      wave_sync();
      if (MODE == 3) {
        f32x4 y4 = (f32x4){0.f, 0.f, 0.f, 0.f};
        y4 = mfma16(ua, dfr, y4);
#pragma unroll
        for (int ks = 0; ks < 4; ++ks) y4 = mfma16(lds_ld8(XS + l15 * XS_PITCH + (32 * ks + 8 * kg) * 2), cfr[ks], y4);
#pragma unroll
        for (int i = 0; i < 4; ++i) { const size_t row = rowbase + s0 + 16 * sb + 4 * kg + i; zout[row * 512 + g * 16 + l15] = f2bf(gelu_tanh_(y4[i])); }
      }
    }
  }
  if (MODE == 1) st_wt2(rec + c * 128, xr, xi);
}
DEV void s5_prep_item(int idx, const float* a_re, const float* a_im, const float* log_dt, const float* b_re, const float* b_im, const float* c_re, const float* c_im,
                      float* AB, float* ABL, int lc, bf16_t* BT, bf16_t* CT) {
  const int g = idx >> 6, p = idx & 63;
  const float are = a_re[idx], aim = a_im[idx], dt = expf(log_dt[g]);
  const float mag = expf(dt * are), abr = mag * cosf(dt * aim), abi = mag * sinf(dt * aim);
  const float nr = abr - 1.0f, ni = abi, den = are * are + aim * aim;
  const float fr = (nr * are + ni * aim) / den, fi = (ni * are - nr * aim) / den;
  AB[idx * 2] = abr; AB[idx * 2 + 1] = abi;
  { float pr = abr, pi = abi; for (int n = lc; n > 1; n >>= 1) { const float qr = pr * pr - pi * pi, t_ = pr * pi, qi = t_ + t_; pr = qr; pi = qi; } ABL[idx * 2] = pr; ABL[idx * 2 + 1] = pi; }
  for (int c = 0; c < 16; ++c) {
    const float br = b_re[(size_t)idx * 16 + c], bi = b_im[(size_t)idx * 16 + c];
    BT[((size_t)g * 128 + p) * 16 + c] = f2bf(fr * br - fi * bi); BT[((size_t)g * 128 + 64 + p) * 16 + c] = f2bf(fr * bi + fi * br);
    CT[((size_t)g * 16 + c) * 128 + p] = f2bf(c_re[((size_t)g * 16 + c) * 64 + p]); CT[((size_t)g * 16 + c) * 128 + 64 + p] = f2bf(-c_im[((size_t)g * 16 + c) * 64 + p]);
  }
}
constexpr int ML_ST_STRIDE = 16384 + 256;
constexpr int GLA_ST_STRIDE = 8192 + 64;
constexpr int ML_SO_BYTES = 32768 + 1024, GLA_SO_BYTES = 16384, GLA_P1_BYTES = 16384 + 256;
template <int MODE>
DEV void mlstm_chunk(LDSP lds, const bf16_t* __restrict__ proj, const float* __restrict__ narrow, const float* __restrict__ convw, const float* __restrict__ gateb,
                     float* __restrict__ st, bf16_t* __restrict__ oall, int b, int h, int ch) {
  const int tid0 = OPAQUE_TID, wave = rfl(tid0 >> 6);
#define ML_LANES() const int tid = opq(tid0), lane = tid & 63, l31 = lane & 31, h2 = lane >> 5; (void)l31; (void)h2; (void)lane
  LDSP Qt = lds, Kt = lds + 16384, Vt = lds + 32768, KWt = lds + 49152, Ct = lds + 65536;
  LAS float* F = (LAS float*)(lds + 106496);
  LAS float *U = F, *Mv = F + 64, *AT = F + 128, *EM = F + 192, *WJ = F + 256, *QN = F + 320, *CW = F + 520;
  const size_t t0 = (size_t)b * SEQ + (size_t)ch * 64;
  const GAS char* pbase = uptr(proj + (t0 - 3) * PW);
  char* sob = (char*)st + ((size_t)(b * 4 + h) * NCH + ch) * ML_SO_BYTES; float* sN = (float*)(sob + 32768); (void)sN;
  const int eb = wave & 3, tb = wave >> 2;
  const float gb0 = gateb[h], gb1 = gateb[4 + h];
  u32x2 ogv[4];
  { ML_LANES();
    for (int i = tid; i < 1024; i += 512) { const int j = i >> 8, r = i & 255; CW[i] = convw[j * 1024 + (r >> 7) * 512 + h * 128 + (r & 127)]; }
    constexpr int NRW = (MODE == 1) ? 4 : 8;
    const bool convt = (MODE == 3) ? (tid < 256) : ((tid & 128) != 0);
    const int ct = (MODE == 3) ? tid : ((tid & 127) | ((tid >> 8) << 7));
    bf16x8 rqk[NRW + 3]; u32x4 rvv[4];
    if (convt) { const int which = (MODE == 3) ? (ct >> 7) & 1 : 1, dch = ct & 15, tg = (MODE == 3) ? (ct & 127) >> 4 : ct >> 4; unsigned voff = (unsigned)((tg * NRW) * PW + (which ? C_MLK : C_MLQ) + h * 128 + dch * 8) * 2u;
#pragma unroll
      for (int r = 0; r < NRW + 3; ++r) { bf16x8 v = (bf16x8){0, 0, 0, 0, 0, 0, 0, 0}; if (ch * 64 + tg * NRW - 3 + r >= 0) v = *(const GAS bf16x8*)(pbase + voff); rqk[r] = v; voff += PW * 2; } }
    else { const int t2 = (MODE == 3) ? tid - 256 : ct;
#pragma unroll
      for (int i = 0; i < 4; ++i) { const int id = t2 + 256 * i, row = id >> 4, c16 = id & 15; rvv[i] = *(const GAS u32x4*)(pbase + (unsigned)((row + 3) * PW + C_MLV + h * 128 + c16 * 8) * 2u); } }
    float rig = 0.f, rfg = 0.f, mprev = 0.f;
    if (MODE == 3) {
      const GAS char* og_ = pbase + (unsigned)((32 * tb + l31 + 3) * PW + C_MLO + h * 128 + 32 * eb + 4 * h2) * 2u;
#pragma unroll
      for (int g = 0; g < 4; ++g) ogv[g] = *(const GAS u32x2*)(og_ + 16 * g); }
    if (wave == (MODE == 3 ? 4 : 0)) { const GAS char* nb = uptr(narrow + t0 * NWP); rig = *(const GAS float*)(nb + (unsigned)(lane * NWP + NW_MLI + h) * 4u); rfg = *(const GAS float*)(nb + (unsigned)(lane * NWP + NW_MLF + h) * 4u);
      if (MODE == 3) { float d_; ld_wt2(sN + 130, mprev, d_); } }
    if (MODE == 3) {
      const int db = wave >> 1;
#pragma unroll
      for (int x = 0; x < 2; ++x) { const u32x4 c0 = *(const u32x4*)(sob + ((wave * 2 + x) * 64 + lane) * 32), c1 = *(const u32x4*)(sob + ((wave * 2 + x) * 64 + lane) * 32 + 16);
        const unsigned c[8] = {c0.x, c0.y, c0.z, c0.w, c1.x, c1.y, c1.z, c1.w};
        const int e = 32 * (2 * (wave & 1) + x) + l31;
#pragma unroll
        for (int g = 0; g < 4; ++g) { const int d = 32 * db + 8 * g + 4 * h2; u32x2 w; w.x = c[2 * g]; w.y = c[2 * g + 1];
          *(LAS u32x2*)(Ct + offb(e, d >> 3) + (d & 7) * 2) = w; } }
      if (tid < 128) *(LAS bf16_t*)(Ct + offb(128, tid >> 3) + (tid & 7) * 2) = f2bf(ld_wt1(sN + tid));
      for (int i = tid; i < 31 * 64; i += 512) ((LAS unsigned*)(Ct + 129 * 256))[i] = 0u;
    }
    raw_barrier();
    if (convt) {
      const int which = (MODE == 3) ? (ct >> 7) & 1 : 1, dch = ct & 15, tg = (MODE == 3) ? (ct & 127) >> 4 : ct >> 4;
      float cw[4][8];
#pragma unroll
      for (int j = 0; j < 4; ++j) { const f32x4 a = *(const LAS f32x4*)(CW + j * 256 + which * 128 + dch * 8), c = *(const LAS f32x4*)(CW + j * 256 + which * 128 + dch * 8 + 4);
        cw[j][0] = a[0]; cw[j][1] = a[1]; cw[j][2] = a[2]; cw[j][3] = a[3]; cw[j][4] = c[0]; cw[j][5] = c[1]; cw[j][6] = c[2]; cw[j][7] = c[3]; }
      float win[3][8];
#pragma unroll
      for (int r = 0; r < 3; ++r)
#pragma unroll
        for (int d = 0; d < 8; ++d) win[r][d] = bf2f((bf16_t)rqk[r][d]);
      const float osc = which ? 0.08838834764831845f : 1.0f;
      LDSP dstT = which ? Kt : Qt;
#pragma unroll
      for (int r = 0; r < NRW; ++r) {
        float cur[8], y[8];
#pragma unroll
        for (int d = 0; d < 8; ++d) { cur[d] = bf2f((bf16_t)rqk[3 + r][d]); const float a = cw[0][d] * win[0][d] + cw[1][d] * win[1][d] + cw[2][d] * win[2][d] + cw[3][d] * cur[d];
          y[d] = a * sigmoidf_(a) * osc; win[0][d] = win[1][d]; win[1][d] = win[2][d]; win[2][d] = cur[d]; }
        u32x4 w; w.x = pk2(y[0], y[1]); w.y = pk2(y[2], y[3]); w.z = pk2(y[4], y[5]); w.w = pk2(y[6], y[7]);
        *(LAS u32x4*)(dstT + offb(tg * NRW + r, dch)) = w;
      }
    } else {
      const int t2 = (MODE == 3) ? tid - 256 : ct;
#pragma unroll
      for (int i = 0; i < 4; ++i) { const int id = t2 + 256 * i, row = id >> 4, c16 = id & 15; *(LAS u32x4*)(Vt + offb(row, c16)) = rvv[i]; }
    }
    if (wave == (MODE == 3 ? 4 : 0)) {
      const float ig = rig + gb0, lf = log_sigmoidf_(rfg + gb1);
      float bsum = lf;
#pragma unroll
      for (int d = 1; d < 64; d <<= 1) { const float o_ = shfl_up_f(bsum, d); if (lane >= d) bsum += o_; }
      const float u = ig - bsum;
      if (MODE == 1) {
        float g = u;
#pragma unroll
        for (int o = 1; o < 64; o <<= 1) g = fmaxf(g, shfl_xor_f(g, o));
        WJ[lane] = __expf(u - g);
        const float blast = shfl_idx_f(bsum, 63);
        if (lane == 0) st_wt2(sN + 128, g, blast);
      } else {
        float pm = u;
#pragma unroll
        for (int d = 1; d < 64; d <<= 1) { const float o_ = shfl_up_f(pm, d); if (lane >= d) pm = fmaxf(pm, o_); }
        const float Mt = fmaxf(mprev, pm);
        U[lane] = u; Mv[lane] = Mt; AT[lane] = __expf(mprev - Mt); EM[lane] = __expf(-(bsum + Mt));
      }
    }
  }
  raw_barrier();
  if (MODE == 1) {
    { ML_LANES();
#pragma unroll
      for (int i = 0; i < 2; ++i) { const int id = tid + 512 * i, row = id >> 4, c16 = id & 15; const float wj = WJ[row];
        const bf16x8 v = lds_ld8(Kt + offb(row, c16)); u32x4 w;
        w.x = pk2(bf2f((bf16_t)v[0]) * wj, bf2f((bf16_t)v[1]) * wj); w.y = pk2(bf2f((bf16_t)v[2]) * wj, bf2f((bf16_t)v[3]) * wj);
        w.z = pk2(bf2f((bf16_t)v[4]) * wj, bf2f((bf16_t)v[5]) * wj); w.w = pk2(bf2f((bf16_t)v[6]) * wj, bf2f((bf16_t)v[7]) * wj);
        *(LAS u32x4*)(KWt + offb(row, c16)) = w; }
    }
    raw_barrier();
    { ML_LANES();
      const int db = wave >> 1; f32x16 cst[2];
#pragma unroll
      for (int x = 0; x < 2; ++x)
#pragma unroll
        for (int i = 0; i < 16; ++i) cst[x][i] = 0.f;
#pragma unroll
      for (int ks = 0; ks < 4; ++ks) { const bf16x8 af = frag_tr(KWt, db, ks, lane, false);
#pragma unroll
        for (int x = 0; x < 2; ++x) cst[x] = mfma32(af, frag_tr(Vt, 2 * (wave & 1) + x, ks, lane, false), cst[x]); }
#pragma unroll
      for (int x = 0; x < 2; ++x) { u32x4 c0, c1; c0.x = pk2(cst[x][0], cst[x][1]); c0.y = pk2(cst[x][2], cst[x][3]); c0.z = pk2(cst[x][4], cst[x][5]); c0.w = pk2(cst[x][6], cst[x][7]);
        c1.x = pk2(cst[x][8], cst[x][9]); c1.y = pk2(cst[x][10], cst[x][11]); c1.z = pk2(cst[x][12], cst[x][13]); c1.w = pk2(cst[x][14], cst[x][15]);
        *(u32x4*)(sob + ((wave * 2 + x) * 64 + lane) * 32) = c0; *(u32x4*)(sob + ((wave * 2 + x) * 64 + lane) * 32 + 16) = c1; }
      if ((wave & 1) == 0) {
        const bf16x8 ones = (bf16x8){0x3f80, 0x3f80, 0x3f80, 0x3f80, 0x3f80, 0x3f80, 0x3f80, 0x3f80};
        f32x16 cs;
#pragma unroll
        for (int i = 0; i < 16; ++i) cs[i] = 0.f;
#pragma unroll
        for (int ks = 0; ks < 4; ++ks) cs = mfma32(frag_tr(KWt, db, ks, lane, false), ones, cs);
        if (l31 == 0) {
#pragma unroll
          for (int i = 0; i < 16; ++i) st_wt1(sN + 32 * db + crow(i, h2), cs[i]); }
      }
    }
  } else {
    if (eb == 0) {
      ML_LANES();
      f32x16 qn;
#pragma unroll
      for (int i = 0; i < 16; ++i) qn[i] = 0.f;
#pragma unroll
      for (int ks = 0; ks < 8; ++ks) qn = mfma32(frag_row(Ct, 128, ks, lane), frag_row(Qt, 32 * tb, ks, lane), qn);
      if (h2 == 0) QN[32 * tb + l31] = qn[0];
    }
    f32x16 acc;
    { ML_LANES();
#pragma unroll
      for (int i = 0; i < 16; ++i) acc[i] = 0.f;
#pragma unroll
      for (int ks = 0; ks < 8; ++ks) acc = mfma32(frag_row(Ct, 32 * eb, ks, lane), frag_row(Qt, 32 * tb, ks, lane), acc);
    }
    float rsum = 0.f;
#pragma unroll
    for (int jb = 0; jb < 2; ++jb) {
      if (jb <= tb) {
        ML_LANES();
        const int tl = 32 * tb + l31; const float Mt = Mv[tl];
        if (jb == 0) { const float at = AT[tl];
#pragma unroll
          for (int i = 0; i < 16; ++i) acc[i] *= at; }
        f32x16 s;
#pragma unroll
        for (int i = 0; i < 16; ++i) s[i] = 0.f;
#pragma unroll
        for (int ks = 0; ks < 8; ++ks) s = mfma32(frag_row(Kt, 32 * jb, ks, lane), frag_row(Qt, 32 * tb, ks, lane), s);
#pragma unroll
        for (int i = 0; i < 16; ++i) { const int j = 32 * jb + crow(i, h2); const float w = (j <= tl) ? __expf(U[j] - Mt) : 0.f; s[i] *= w; rsum += s[i]; }
#pragma unroll
        for (int s2 = 0; s2 < 2; ++s2) acc = mfma32(frag_tr(Vt, eb, 2 * jb + s2, lane, true), acc_frag(s, s2), acc);
      }
    }
    rsum += shfl_xor_f(rsum, 32);
    raw_barrier();
    { ML_LANES();
      const int tl = 32 * tb + l31;
      const float den = AT[tl] * QN[tl] + rsum; const float dd = fmaxf(fabsf(den), EM[tl]); const float inv = 1.0f / dd;
      GAS char* op = (GAS char*)uptr(oall + t0 * OW) + (unsigned)(tl * OW + 512 + h * 128 + 32 * eb + 4 * h2) * 2u;
#pragma unroll
      for (int g = 0; g < 4; ++g) { const u32x2 gv2 = ogv[g];
        const float g0 = sigmoidf_(bf2f((bf16_t)(gv2.x & 0xffff))), g1 = sigmoidf_(bf2f((bf16_t)(gv2.x >> 16))), g2 = sigmoidf_(bf2f((bf16_t)(gv2.y & 0xffff))), g3 = sigmoidf_(bf2f((bf16_t)(gv2.y >> 16)));
        u32x2 w; w.x = pk2(acc[4 * g] * inv * g0, acc[4 * g + 1] * inv * g1); w.y = pk2(acc[4 * g + 2] * inv * g2, acc[4 * g + 3] * inv * g3);
        *(GAS u32x2*)(op + 16 * g) = w; }
    }
  }
  raw_barrier();
#undef ML_LANES
}
DEV float bflo(unsigned w) { unsigned u = w << 16; float r; __builtin_memcpy(&r, &u, 4); return r; }
DEV float bfhi(unsigned w) { unsigned u = w & 0xffff0000u; float r; __builtin_memcpy(&r, &u, 4); return r; }
DEV void mlstm_scan_e(const float* __restrict__ st_bh_, float* __restrict__ so_bh_, int e) {
  const int lane = OPAQUE_TID & 63, tid = e >> 2; const bool nthr = (e < 512);
  const char* st_bh = (const char*)st_bh_; char* so_bh = (char*)so_bh_;
  f32x4 C = (f32x4){0.f, 0.f, 0.f, 0.f}; float N = 0.f, m = 0.f;
  constexpr int UN = (NCH % 32 == 0) ? 32 : 8;
  for (int k0 = 0; k0 < NCH; k0 += UN) {
    u32x2 Ch[UN]; float Nh[UN]; float gl, Bl;
    ld_wt2((const float*)(st_bh + (size_t)(k0 + (lane & (UN - 1))) * ML_SO_BYTES + 32768) + 128, gl, Bl);
#pragma unroll
    for (int u = 0; u < UN; ++u) { const char* p = st_bh + (size_t)(k0 + u) * ML_SO_BYTES; Ch[u] = *(const u32x2*)(p + (size_t)e * 2);
      Nh[u] = 0.f; if (nthr) Nh[u] = ld_wt1((const float*)(p + 32768) + tid); }
#pragma unroll
    for (int u = 0; u < UN; ++u) { char* p = so_bh + (size_t)(k0 + u) * ML_SO_BYTES; float* pn = (float*)(p + 32768);
      const float g = shfl_idx_f(gl, u), B = shfl_idx_f(Bl, u);
      const float Ml = fmaxf(m, g), a = __expf(m - Ml), bb = __expf(g - Ml);
      { u32x2 w; w.x = pk2(C[0], C[1]); w.y = pk2(C[2], C[3]); *(u32x2*)(p + (size_t)e * 2) = w; }
      C[0] = C[0] * a + bflo(Ch[u].x) * bb; C[1] = C[1] * a + bfhi(Ch[u].x) * bb; C[2] = C[2] * a + bflo(Ch[u].y) * bb; C[3] = C[3] * a + bfhi(Ch[u].y) * bb;
      if (nthr) { st_wt1(pn + tid, N); N = N * a + Nh[u] * bb; }
      if (e == 0) st_wt2(pn + 130, m, 0.f);
      m = B + Ml; }
  }
}

DEV void mlstm_scan(const float* __restrict__ st_bh, float* __restrict__ so_bh, int slice) { mlstm_scan_e(st_bh, so_bh, (slice * 512 + OPAQUE_TID) * 4); }

template <int MODE>
DEV void gla_chunk(LDSP lds, const bf16_t* __restrict__ proj, const float* __restrict__ narrow, const float* __restrict__ wa2, const float* __restrict__ ba,
                   float* __restrict__ st, bf16_t* __restrict__ oall, int b, int h, int ch) {
  const int tid = OPAQUE_TID, lane = tid & 63, wave = rfl(tid >> 6), l31 = lane & 31, h2 = lane >> 5;
  LDSP QKt = lds, KWt = lds + 16384, Vt = lds + 32768, St = lds + 49152;
  LAS float* F = (LAS float*)(lds + 69632);
  LAS float *GA = F, *TOT = F + 1024, *SS = F + 1600;
  const size_t t0 = (size_t)b * SEQ + (size_t)ch * 64;
  char* sob = (char*)st + ((size_t)(b * 4 + h) * NCH + ch) * (MODE == 1 ? GLA_P1_BYTES : GLA_SO_BYTES);
  const int d = tid & 63, tg = tid >> 6, eb = wave & 3, tb = wave >> 2;
  const GAS char* pb = uptr(proj + t0 * PW); const GAS char* nb = uptr(narrow + t0 * NWP);
  float wcol[16];
#pragma unroll
  for (int r = 0; r < 16; ++r) wcol[r] = wa2[r * 256 + h * 64 + d];
  const float bad = ba[h * 64 + d];
  { const int id = tid * 2, row = id >> 4, c = id & 15; const GAS float* gp = (const GAS float*)(nb + (unsigned)(row * NWP + NW_GLA + c) * 4u); GA[id] = gp[0]; GA[id + 1] = gp[1]; }
#pragma unroll
  for (int i = 0; i < 2; ++i) { const int id = tid + 512 * i, row = id >> 4, c16 = id & 15; *(LAS u32x4*)(Vt + offb(row, c16)) = *(const GAS u32x4*)(pb + (unsigned)(row * PW + C_GLV + h * 128 + c16 * 8) * 2u); }
  u32x2 grv[4];
  if (MODE == 3) { const GAS char* gr_ = pb + (unsigned)((32 * tb + l31) * PW + C_GLR + h * 128 + 32 * eb + 4 * h2) * 2u;
#pragma unroll
    for (int g = 0; g < 4; ++g) grv[g] = *(const GAS u32x2*)(gr_ + 16 * g); }
  float qraw[8], kraw8[8];
#pragma unroll
  for (int r = 0; r < 8; ++r) { const unsigned o = (unsigned)((8 * tg + r) * PW + h * 64 + d) * 2u; qraw[r] = (MODE == 3) ? bf2f(*(const GAS bf16_t*)(pb + o + C_GLQ * 2)) : 0.f; kraw8[r] = bf2f(*(const GAS bf16_t*)(pb + o + C_GLK * 2)); }
  if (MODE == 3) {
    const int db = wave >> 2; const u32x4 c0 = *(const u32x4*)(sob + (wave * 64 + lane) * 32), c1 = *(const u32x4*)(sob + (wave * 64 + lane) * 32 + 16);
    const unsigned c[8] = {c0.x, c0.y, c0.z, c0.w, c1.x, c1.y, c1.z, c1.w};
    const int e = 32 * eb + l31;
#pragma unroll
    for (int g = 0; g < 4; ++g) { const int dd = 32 * db + 8 * g + 4 * h2; u32x2 w; w.x = c[2 * g]; w.y = c[2 * g + 1];
      *(LAS u32x2*)(St + e * ST_PITCH + dd * 2) = w; }
  }
  raw_barrier();
  float bc[8], tot = 0.f;
#pragma unroll
  for (int r = 0; r < 8; ++r) { const int t = 8 * tg + r; float z = bad;
#pragma unroll
    for (int k = 0; k < 16; ++k) z += GA[t * 16 + k] * wcol[k];
    tot += log_sigmoidf_(z) * 0.0625f; bc[r] = tot; }
  TOT[tg * 64 + d] = tot;
  raw_barrier();
  float off = 0.f, last = 0.f;
#pragma unroll
  for (int g = 0; g < 8; ++g) { const float v = TOT[g * 64 + d]; if (g < tg) off += v; last += v; }
  if (MODE == 1 && tg == 0) st_wt1((float*)(sob + 16384) + d, __expf(last));
#pragma unroll
  for (int r = 0; r < 8; ++r) { const int t = 8 * tg + r; const float bcv = bc[r] + off;
    if (MODE == 3) { *(LAS bf16_t*)(QKt + offb(t, d >> 3) + (d & 7) * 2) = f2bf(qraw[r] * 0.125f * __expf(bcv));
      *(LAS bf16_t*)(QKt + offb(t, 8 + (d >> 3)) + (d & 7) * 2) = f2bf(kraw8[r] * __expf(-bcv)); }
    else *(LAS bf16_t*)(KWt + offb(t, d >> 3) + (d & 7) * 2) = f2bf(kraw8[r] * __expf(last - bcv)); }
  raw_barrier();
  if (MODE == 1) {
    const int db = wave >> 2; f32x16 sst;
#pragma unroll
    for (int i = 0; i < 16; ++i) sst[i] = 0.f;
#pragma unroll
    for (int ks = 0; ks < 4; ++ks) sst = mfma32(frag_tr(KWt, db, ks, lane, false), frag_tr(Vt, eb, ks, lane, false), sst);
#pragma unroll
    for (int i = 0; i < 16; ++i) (void)0;
    { u32x4 c0, c1; c0.x = pk2(sst[0], sst[1]); c0.y = pk2(sst[2], sst[3]); c0.z = pk2(sst[4], sst[5]); c0.w = pk2(sst[6], sst[7]);
      c1.x = pk2(sst[8], sst[9]); c1.y = pk2(sst[10], sst[11]); c1.z = pk2(sst[12], sst[13]); c1.w = pk2(sst[14], sst[15]);
      *(u32x4*)(sob + (wave * 64 + lane) * 32) = c0; *(u32x4*)(sob + (wave * 64 + lane) * 32 + 16) = c1; }
  } else {
    f32x16 acc;
#pragma unroll
    for (int i = 0; i < 16; ++i) acc[i] = 0.f;
#pragma unroll
    for (int ks = 0; ks < 4; ++ks) acc = mfma32(lds_ld8(St + (32 * eb + l31) * ST_PITCH + (16 * ks + 8 * h2) * 2), frag_row(QKt, 32 * tb, ks, lane), acc);
    const int tl = 32 * tb + l31;
#pragma unroll
    for (int jb = 0; jb < 2; ++jb) {
      if (jb <= tb) {
        f32x16 s;
#pragma unroll
        for (int i = 0; i < 16; ++i) s[i] = 0.f;
#pragma unroll
        for (int ks = 0; ks < 4; ++ks) s = mfma32(frag_row(QKt, 32 * jb, 4 + ks, lane), frag_row(QKt, 32 * tb, ks, lane), s);
#pragma unroll
        for (int i = 0; i < 16; ++i) { const int j = 32 * jb + crow(i, h2); if (j > tl) s[i] = 0.f; }
#pragma unroll
        for (int s2 = 0; s2 < 2; ++s2) acc = mfma32(frag_tr(Vt, eb, 2 * jb + s2, lane, true), acc_frag(s, s2), acc);
      }
    }
    float ss = 0.f;
#pragma unroll
    for (int i = 0; i < 16; ++i) ss += acc[i] * acc[i];
    ss += shfl_xor_f(ss, 32);
    if (h2 == 0) SS[eb * 64 + tl] = ss;
    raw_barrier();
    const float tot2 = SS[tl] + SS[64 + tl] + SS[128 + tl] + SS[192 + tl]; const float r = 1.0f / sqrtf(tot2 * (1.0f / 128.0f) + RMS_EPS);
    GAS char* op = (GAS char*)uptr(oall + t0 * OW) + (unsigned)(tl * OW + 1024 + h * 128 + 32 * eb + 4 * h2) * 2u;
#pragma unroll
    for (int g = 0; g < 4; ++g) { const u32x2 gv2 = grv[g];
      const float r0 = bf2f((bf16_t)(gv2.x & 0xffff)), r1 = bf2f((bf16_t)(gv2.x >> 16)), r2 = bf2f((bf16_t)(gv2.y & 0xffff)), r3 = bf2f((bf16_t)(gv2.y >> 16));
      u32x2 w; w.x = pk2(acc[4 * g] * r * r0 * sigmoidf_(r0), acc[4 * g + 1] * r * r1 * sigmoidf_(r1)); w.y = pk2(acc[4 * g + 2] * r * r2 * sigmoidf_(r2), acc[4 * g + 3] * r * r3 * sigmoidf_(r3));
      *(GAS u32x2*)(op + 16 * g) = w; }
  }
  raw_barrier();
}
DEV void gla_scan_e(const float* __restrict__ st_bh_, float* __restrict__ so_bh_, int e) {
  const int w = e >> 10, ln = (e >> 4) & 63, i0 = e & 15; const int dd = 32 * (w >> 2) + crow(i0, ln >> 5);
  const char* st_bh = (const char*)st_bh_; char* so_bh = (char*)so_bh_;
  f32x4 S = (f32x4){0.f, 0.f, 0.f, 0.f};
  constexpr int UN = (NCH % 16 == 0) ? 16 : 8;
  for (int k0 = 0; k0 < NCH; k0 += UN) {
    u32x2 Sh[UN]; f32x4 el[UN];
#pragma unroll
    for (int u = 0; u < UN; ++u) { const char* p = st_bh + (size_t)(k0 + u) * GLA_P1_BYTES; const float* pe = (const float*)(p + 16384) + dd;
      float e0, e1, e2, e3; ld_wt2(pe, e0, e1); ld_wt2(pe + 2, e2, e3); el[u] = (f32x4){e0, e1, e2, e3}; Sh[u] = *(const u32x2*)(p + (size_t)e * 2); }
#pragma unroll
    for (int u = 0; u < UN; ++u) { char* p = so_bh + (size_t)(k0 + u) * GLA_SO_BYTES; { u32x2 wv; wv.x = pk2(S[0], S[1]); wv.y = pk2(S[2], S[3]); *(u32x2*)(p + (size_t)e * 2) = wv; }
      S[0] = S[0] * el[u][0] + bflo(Sh[u].x); S[1] = S[1] * el[u][1] + bfhi(Sh[u].x); S[2] = S[2] * el[u][2] + bflo(Sh[u].y); S[3] = S[3] * el[u][3] + bfhi(Sh[u].y); }
  }
}
DEV void gla_scan(const float* __restrict__ st_bh, float* __restrict__ so_bh, int slice) { gla_scan_e(st_bh, so_bh, (slice * 512 + OPAQUE_TID) * 4); }
namespace pg8 {
#define PG8_LAS __attribute__((address_space(3)))
typedef unsigned short bf16_t;
typedef short bf16x8 __attribute__((ext_vector_type(8)));
typedef float f32x4 __attribute__((ext_vector_type(4)));
typedef unsigned u32x4 __attribute__((ext_vector_type(4)));
constexpr int BM = 256, BK = 64, HALF = 128, HTB = HALF * BK * 2  , STAGE_BYTES = 8 * HTB, NXCD = 8, WGM = 4;

__host__ __device__ __forceinline__ int lds_byte(int r, int c) { const int st = (r >> 4) * 2 + (c >> 5), rr = r & 15, cc = c & 31, ob = rr * 64 + cc * 2; return st * 1024 + (ob ^ (((ob >> 9) & 1) << 5)); }
__host__ __device__ __forceinline__ void stage_rc(int b, int& R, int& C) { const int st = b / 1024, sb = b % 1024, swz = sb ^ (((sb >> 9) & 1) << 5); R = (st >> 1) * 16 + swz / 64; C = (st & 1) * 32 + (swz % 64) / 2; }
__host__ __device__ __forceinline__ int perm32(int rho) { const int n = rho >> 4, i = rho & 15; return 8 * (i >> 2) + 4 * n + (i & 3); }

struct Unit { int pm, pn, acol, z, bcol, kind, nt; };
struct Gemm { const bf16_t* A; const bf16_t* Bt; int K, lda, ldb; const bf16_t* A1; const bf16_t* Bt1; };
typedef float f32x2 __attribute__((ext_vector_type(2)));
__device__ __forceinline__ unsigned cvt_pk_bf16(float lo, float hi) { typedef float f2_ __attribute__((ext_vector_type(2))); typedef __bf16 b2_ __attribute__((ext_vector_type(2))); const f2_ v = {lo, hi}; return __builtin_bit_cast(unsigned, __builtin_convertvector(v, b2_)); }
template <class Epi, class Sched, bool ALIGN_EPI = false, bool SP2 = false>
__device__ __forceinline__ void gemm_phase(PG8_LAS unsigned char* lds, const Gemm g, const Sched& S, const Epi& E) {
    const int tid = OPAQUE_TID, wid = __builtin_amdgcn_readfirstlane(tid >> 6), lane = tid & 63, wr = wid >> 2, wc = wid & 3, fr = lane & 15, fq = lane >> 4;
    const int K = g.K; (void)K;
    unsigned voffA[2], voffB[2];
#pragma unroll
    for (int i = 0; i < 2; ++i) { int R, C; stage_rc(tid * 16 + i * 8192, R, C); const int Rb = Epi::PERM ? ((R & ~31) + perm32(R & 31)) : R;
        voffA[i] = (unsigned)(R * g.lda + C) * 2u; voffB[i] = (unsigned)(Rb * g.ldb + C) * 2u; }
    const size_t kstep = (size_t)(BK * 2);
    const size_t hstepA = (size_t)HALF * g.lda * 2, hstepB = (size_t)HALF * g.ldb * 2;
    const size_t tstepA = 2 * hstepA, tstepB = 2 * hstepB;
    const unsigned ldsw = (unsigned)wid * 1024u;
    const int aoff = lds_byte(wr * 64 + fr, fq * 8), boff = lds_byte(wc * 32 + fr, fq * 8);
#define PG8_SA(b, h) (((b) * 2 + (h)) * HTB)
#define PG8_SB(b, h) ((4 + (b) * 2 + (h)) * HTB)
#define PG8_STAGE(bufoff, gbase, voff) do { _Pragma("unroll") for (int _i = 0; _i < 2; ++_i) \
        __builtin_amdgcn_global_load_lds((const unsigned*)((const char*)(gbase) + (voff)[_i]), (PG8_LAS unsigned*)(lds + (bufoff) + ldsw + _i * 8192), 16, 0, 0); } while (0)
#define PG8_LDA(dst, b, h) do { _Pragma("unroll") for (int m = 0; m < 4; ++m) _Pragma("unroll") for (int k = 0; k < 2; ++k) dst[m][k] = *(const PG8_LAS bf16x8*)(lds + PG8_SA(b, h) + aoff + m * 2048 + k * 1024); } while (0)
#define PG8_LDB(dst, b, h) do { _Pragma("unroll") for (int n = 0; n < 2; ++n) _Pragma("unroll") for (int k = 0; k < 2; ++k) dst[n][k] = *(const PG8_LAS bf16x8*)(lds + PG8_SB(b, h) + boff + n * 2048 + k * 1024); } while (0)
#define PG8_MMA(ai, bj, At, Bt) do { __builtin_amdgcn_s_setprio(1); _Pragma("unroll") for (int m = 0; m < 4; ++m) _Pragma("unroll") for (int n = 0; n < 2; ++n) _Pragma("unroll") for (int k = 0; k < 2; ++k) \
        acc[ai][bj][m][n] = __builtin_amdgcn_mfma_f32_16x16x32_bf16(Bt[n][k], At[m][k], acc[ai][bj][m][n], 0, 0, 0); __builtin_amdgcn_s_setprio(0); } while (0)
#define PG8_WAIT_V(n) asm volatile("s_waitcnt vmcnt(" #n ")" ::: "memory")
#define PG8_WAIT_L(n) asm volatile("s_waitcnt lgkmcnt(" #n ")" ::: "memory")
#define PG8_BAR __builtin_amdgcn_s_barrier()
#define PG8_SCHED __builtin_amdgcn_sched_barrier(0)
    Unit cur, nxt; int ui = 0;
    if (!S.next(0, cur)) return;
    f32x4 acc[2][2][4][2];
#pragma unroll
    for (int a = 0; a < 2; ++a)
#pragma unroll
        for (int b = 0; b < 2; ++b)
#pragma unroll
            for (int m = 0; m < 4; ++m)
#pragma unroll
                for (int n = 0; n < 2; ++n) acc[a][b][m][n] = (f32x4){0.f, 0.f, 0.f, 0.f};
    bf16x8 At[4][2], B0[2][2], B1[2][2];
    const char* cA = (const char*)(cur.kind ? g.A1 : g.A) + (size_t)cur.pm * tstepA + (size_t)cur.acol * 2; const char* cB = (const char*)(cur.kind ? g.Bt1 : g.Bt) + (size_t)cur.pn * tstepB + (size_t)cur.bcol * 2;
    S.a_ready(cur);
    if constexpr (SP2) {
        PG8_STAGE(PG8_SB(0, 0), cB, voffB); PG8_STAGE(PG8_SB(0, 1), cB + hstepB, voffB); PG8_STAGE(PG8_SA(0, 0), cA, voffA); PG8_STAGE(PG8_SA(0, 1), cA + hstepA, voffA);
        if (wr == 1) PG8_BAR;
        PG8_WAIT_V(2); PG8_BAR;
        PG8_STAGE(PG8_SB(1, 0), cB + kstep, voffB); PG8_STAGE(PG8_SA(1, 0), cA + kstep, voffA); PG8_STAGE(PG8_SB(1, 1), cB + hstepB + kstep, voffB);
        PG8_WAIT_V(6); PG8_BAR;
    } else {
        PG8_STAGE(PG8_SB(0, 0), cB, voffB); PG8_STAGE(PG8_SA(0, 0), cA, voffA); PG8_STAGE(PG8_SB(0, 1), cB + hstepB, voffB); PG8_STAGE(PG8_SA(0, 1), cA + hstepA, voffA);
        if (wr == 1) PG8_BAR;
        PG8_WAIT_V(4); PG8_BAR;
        PG8_STAGE(PG8_SB(1, 0), cB + kstep, voffB); PG8_STAGE(PG8_SA(1, 0), cA + kstep, voffA); PG8_STAGE(PG8_SB(1, 1), cB + hstepB + kstep, voffB);
        PG8_WAIT_V(6); PG8_BAR;
    }
    for (;;) {
        const bool has_next = S.next(ui + 1, nxt);
        const char* nA = has_next ? (const char*)(nxt.kind ? g.A1 : g.A) + (size_t)nxt.pm * tstepA + (size_t)nxt.acol * 2 : cA; const char* nB = has_next ? (const char*)(nxt.kind ? g.Bt1 : g.Bt) + (size_t)nxt.pn * tstepB + (size_t)nxt.bcol * 2 : cB;
        const int nt = cur.nt;
        for (int t = 0; t < nt; t += 2) {
            const bool last = (t == nt - 2);
            const char* a1 = cA + (size_t)(t + 1) * kstep;
            const char* a2 = last ? nA : cA + (size_t)(t + 2) * kstep; const char* b2 = last ? nB : cB + (size_t)(t + 2) * kstep;
            const char* a3 = a2 + kstep; const char* b3 = b2 + kstep;
            if (last && has_next) S.a_ready(nxt);
            if constexpr (SP2) {
            PG8_LDB(B0, 0, 0); PG8_LDB(B1, 0, 1); PG8_SCHED; PG8_LDA(At, 0, 0); PG8_STAGE(PG8_SA(1, 1), a1 + hstepA, voffA);
            PG8_WAIT_V(8); PG8_WAIT_L(0); PG8_BAR; PG8_MMA(0, 0, At, B0); PG8_MMA(0, 1, At, B1); PG8_BAR; PG8_SCHED;
            PG8_LDA(At, 0, 1); PG8_STAGE(PG8_SB(0, 0), b2, voffB); PG8_STAGE(PG8_SB(0, 1), b2 + hstepB, voffB); PG8_STAGE(PG8_SA(0, 0), a2, voffA);
            PG8_WAIT_V(8); PG8_WAIT_L(0); PG8_BAR; PG8_MMA(1, 0, At, B0); PG8_MMA(1, 1, At, B1); PG8_BAR; PG8_SCHED;
            PG8_LDB(B0, 1, 0); PG8_LDB(B1, 1, 1); PG8_SCHED; PG8_LDA(At, 1, 0); PG8_STAGE(PG8_SA(0, 1), a2 + hstepA, voffA);
            PG8_WAIT_V(8); PG8_WAIT_L(0); PG8_BAR; PG8_MMA(0, 0, At, B0); PG8_MMA(0, 1, At, B1); PG8_BAR; PG8_SCHED;
            PG8_LDA(At, 1, 1); PG8_STAGE(PG8_SB(1, 0), b3, voffB); PG8_STAGE(PG8_SB(1, 1), b3 + hstepB, voffB); PG8_STAGE(PG8_SA(1, 0), a3, voffA);
            PG8_WAIT_V(8); PG8_WAIT_L(0); PG8_BAR; PG8_MMA(1, 0, At, B0); PG8_MMA(1, 1, At, B1); PG8_BAR; PG8_SCHED;
            } else {
            PG8_LDB(B0, 0, 0); PG8_SCHED; PG8_LDA(At, 0, 0); PG8_STAGE(PG8_SA(1, 1), a1 + hstepA, voffA);
            PG8_WAIT_L(8); PG8_BAR; PG8_WAIT_L(0); PG8_MMA(0, 0, At, B0); PG8_BAR; PG8_SCHED;
            PG8_LDB(B1, 0, 1); PG8_STAGE(PG8_SB(0, 0), b2, voffB);
            PG8_BAR; PG8_WAIT_L(0); PG8_MMA(0, 1, At, B1); PG8_BAR;
            PG8_LDA(At, 0, 1); PG8_STAGE(PG8_SA(0, 0), a2, voffA);
            PG8_BAR; PG8_WAIT_L(0); PG8_MMA(1, 0, At, B0); PG8_BAR; PG8_SCHED;
            PG8_STAGE(PG8_SB(0, 1), b2 + hstepB, voffB);
            PG8_WAIT_V(6); PG8_BAR; PG8_MMA(1, 1, At, B1); PG8_BAR;
            PG8_LDB(B0, 1, 0); PG8_SCHED; PG8_LDA(At, 1, 0); PG8_STAGE(PG8_SA(0, 1), a2 + hstepA, voffA);
            PG8_WAIT_L(8); PG8_BAR; PG8_WAIT_L(0); PG8_MMA(0, 0, At, B0); PG8_BAR; PG8_SCHED;
            PG8_LDB(B1, 1, 1); PG8_STAGE(PG8_SB(1, 0), b3, voffB);
            PG8_BAR; PG8_WAIT_L(0); PG8_MMA(0, 1, At, B1); PG8_BAR;
            PG8_LDA(At, 1, 1); PG8_STAGE(PG8_SA(1, 0), a3, voffA);
            PG8_BAR; PG8_WAIT_L(0); PG8_MMA(1, 0, At, B0); PG8_BAR; PG8_SCHED;
            PG8_STAGE(PG8_SB(1, 1), b3 + hstepB, voffB);
            PG8_WAIT_V(6); PG8_BAR; PG8_MMA(1, 1, At, B1); PG8_BAR;
            }
        }
        if constexpr (ALIGN_EPI) { if (wr == 0) PG8_BAR; }
        if constexpr (!Epi::AFTER_DRAIN) { E(acc, cur, wr, wc, fr, fq); S.done(cur); }
        if (!has_next) break;
#pragma unroll
        for (int a = 0; a < 2; ++a)
#pragma unroll
            for (int b = 0; b < 2; ++b)
#pragma unroll
                for (int m = 0; m < 4; ++m)
#pragma unroll
                    for (int n = 0; n < 2; ++n) acc[a][b][m][n] = (f32x4){0.f, 0.f, 0.f, 0.f};
        cur = nxt; cA = nA; cB = nB; ++ui;
        if constexpr (ALIGN_EPI) { if (wr == 1) PG8_BAR; }
    }
    PG8_WAIT_V(0);
    if constexpr (!ALIGN_EPI) { if (wr == 0) PG8_BAR; }
    PG8_BAR;
    if constexpr (Epi::AFTER_DRAIN) { E.fused(acc, cur, wr, wc, fr, fq, lds, wid, lane); S.done(cur); }
#undef PG8_SA
#undef PG8_SB
#undef PG8_STAGE
#undef PG8_LDA
#undef PG8_LDB
#undef PG8_MMA
#undef PG8_WAIT_V
#undef PG8_WAIT_L
#undef PG8_BAR
#undef PG8_SCHED
}
}
constexpr int DM = 2048, NLAYER = 4, FFH = 5632, NPROJ = 5888, NMT = M_TOK / 256;
constexpr size_t MiB = 1u << 20;
constexpr size_t WS_CTL = 0, CTL_ZERO_BYTES = 1 * MiB;
constexpr size_t WS_MODP = 1 * MiB, WS_S5T = 8 * MiB, WS_WGLU = 9 * MiB, WS_WIN = 10 * MiB, WS_WG = 33 * MiB, WS_WB = 65 * MiB, WS_WOUT = 73 * MiB, WS_WFI = 81 * MiB, WS_WFO = 125 * MiB;
constexpr size_t WS_NAR = 147 * MiB, WS_Z = 151 * MiB, WS_H = 183 * MiB, WS_OALL = 311 * MiB, WS_PROJ = 439 * MiB, WS_P = 791 * MiB, WS_GSCR = 1303 * MiB, WS_WSET2 = 1367 * MiB, WS_END = 1505 * MiB;
constexpr size_t WS_XB = WS_P + 360 * MiB;
static_assert(WS_P + (size_t)M_TOK * 5632 * 2 <= WS_XB && WS_XB + (size_t)M_TOK * 2048 * 2 <= WS_GSCR, "XB");
constexpr size_t WS_MERGED = WS_PROJ, WS_MIXB = WS_PROJ + 128 * MiB, WS_Y = WS_PROJ, WS_HID = WS_P;
static_assert(WS_WIN + (size_t)NPROJ * DM * 2 <= WS_WG && WS_WFI + (size_t)2 * FFH * DM * 2 <= WS_WFO && WS_WFO + (size_t)DM * FFH * 2 <= WS_NAR, "weight map");
static_assert(WS_NAR + (size_t)M_TOK * NWP * 4 <= WS_Z && WS_Z + (size_t)M_TOK * 512 * 2 <= WS_H && WS_H + (size_t)M_TOK * DM * 2 <= WS_OALL && WS_OALL + (size_t)M_TOK * DM * 2 <= WS_PROJ, "act map");
static_assert(WS_PROJ + (size_t)M_TOK * PW * 2 <= WS_P && WS_P + (size_t)4 * M_TOK * DM * 2 <= WS_GSCR && WS_HID + (size_t)M_TOK * FFH * 2 <= WS_GSCR && WS_GSCR + (size_t)256 * 262144 <= WS_END, "act map 2");
constexpr size_t WSET_BYTES = WS_NAR - WS_WGLU;
static_assert(WS_WSET2 + WSET_BYTES <= WS_END, "second weight set");
constexpr int KSPLIT = 8;
constexpr int CW_TMO = 0, CW_BAR = 4096, CW_Q = 16384;
constexpr int LDS_BYTES = 147456, LDS_MISC = 131072, LDS_BIAS = 131072 + 256;
constexpr int N_PHASES = 2 + 9 * NLAYER;

__device__ const unsigned char T5_BUCKET[128] = {0,1,2,3,4,5,6,7,8,9,10,11,12,13,14,15,16,16,16,17,17,18,18,18,19,19,19,20,20,20,20,21,21,21,21,22,22,22,22,22,23,23,23,23,23,23,24,24,24,24,24,24,25,25,25,25,25,25,25,26,26,26,26,26,26,26,26,27,27,27,27,27,27,27,27,27,27,28,28,28,28,28,28,28,28,28,28,29,29,29,29,29,29,29,29,29,29,29,29,30,30,30,30,30,30,30,30,30,30,30,30,30,30,31,31,31,31,31,31,31,31,31,31,31,31,31,31,31};

#define XB_TMO      128
#define XB_XCNT(j)  (256  + 64 * (j))
#define XB_XSUB(j)  (1280 + 64 * (j))
#define XB_XGEN(j)  (2304 + 64 * (j))
#define XB_TOP      3328
#define XB_TOPGEN   3392
#define XCD_BAR_WORDS 3456
#define XB_SPIN_CAP (1u << 22)
__device__ __forceinline__ unsigned xb_ld(unsigned* p)              { return __hip_atomic_load(p, __ATOMIC_RELAXED, __HIP_MEMORY_SCOPE_AGENT); }
__device__ __forceinline__ unsigned xb_add(unsigned* p, unsigned v) { return __hip_atomic_fetch_add(p, v, __ATOMIC_RELAXED, __HIP_MEMORY_SCOPE_AGENT); }
__device__ __forceinline__ unsigned xb_xcc_id() { return (unsigned)__builtin_amdgcn_s_getreg((3 << 11) | 20) & 0xFu; }
#define XB_SPIN(cond, bar) do { unsigned _sp = 0; while (cond) { __builtin_amdgcn_s_sleep(1); \
    if ((++_sp & 255u) == 0u) { if (xb_ld(&(bar)[XB_TMO])) break; if (_sp > XB_SPIN_CAP) { atomicAdd(&(bar)[XB_TMO], 1u); break; } } } } while (0)
struct XcdBarrier { unsigned* bar; unsigned x; volatile LAS unsigned* st; };
__device__ __forceinline__ XcdBarrier xcd_barrier_post(unsigned* bar, volatile LAS unsigned* st) {
    XcdBarrier b; b.bar = bar; b.x = xb_xcc_id(); b.st = st;
    if (threadIdx.x == 0) (void)xb_add(&bar[XB_XCNT(b.x)], 1u);
    return b;
}
__device__ __forceinline__ void xcd_barrier_complete(unsigned* bar, unsigned x, unsigned& nloc, unsigned& nx) {
    const unsigned G = gridDim.x * gridDim.y * gridDim.z;
    unsigned sum, cnt, mine, sp = 0u;
    for (;;) {
        sum = 0u; cnt = 0u; mine = 0u;
#pragma unroll
        for (unsigned j = 0; j < 16; ++j) { const unsigned c = xb_ld(&bar[XB_XCNT(j)]); sum += c; cnt += (c > 0u) ? 1u : 0u; mine = (j == x) ? c : mine; }
        if (sum == G) break;
        __builtin_amdgcn_s_sleep(1);
        if ((++sp & 255u) == 0u) { if (xb_ld(&bar[XB_TMO])) break; if (sp > XB_SPIN_CAP) { atomicAdd(&bar[XB_TMO], 1u); break; } }
    }
    nloc = mine > 0u ? mine : 1u; nx = cnt > 0u ? cnt : 1u;
}
#ifndef XB_SCOPE
#define XB_SCOPE "agent"
#endif
__device__ __forceinline__ void xcd_barrier(const XcdBarrier& b) {
    asm volatile("s_waitcnt vmcnt(0)" ::: "memory");
    __syncthreads();
    if (threadIdx.x == 0) {
        unsigned* bar = b.bar;
        __builtin_amdgcn_s_waitcnt(0);
        unsigned nloc = b.st[0], nx = b.st[1];
        if (nloc == 0u) { xcd_barrier_complete(bar, b.x, nloc, nx); b.st[0] = nloc; b.st[1] = nx; }
#ifdef PROBE_WG_RELEASE
        __builtin_amdgcn_fence(__ATOMIC_RELEASE, XB_SCOPE); asm volatile("s_waitcnt vmcnt(0)" ::: "memory");
#endif
        const unsigned old = xb_add(&bar[XB_XSUB(b.x)], 1u);
        const unsigned gen = old / nloc;
        if (old + 1u == (gen + 1u) * nloc) {
            __builtin_amdgcn_fence(__ATOMIC_RELEASE, XB_SCOPE);
            asm volatile("s_waitcnt vmcnt(0)" ::: "memory");
            const unsigned og = xb_add(&bar[XB_TOP], 1u);
            const unsigned tg = og / nx;
            if (og + 1u == (tg + 1u) * nx) xb_add(&bar[XB_TOPGEN], 1u);
            else XB_SPIN(xb_ld(&bar[XB_TOPGEN]) == tg, bar);
            __builtin_amdgcn_fence(__ATOMIC_ACQUIRE, XB_SCOPE);
            xb_add(&bar[XB_XGEN(b.x)], 1u);
            asm volatile("s_waitcnt vmcnt(0)" ::: "memory");
        } else {
            XB_SPIN(xb_ld(&bar[XB_XGEN(b.x)]) == gen, bar);
            __builtin_amdgcn_fence(__ATOMIC_ACQUIRE, XB_SCOPE);
            asm volatile("s_waitcnt vmcnt(0)" ::: "memory");
        }
    }
    __syncthreads();
}

namespace pg8 {
__device__ __forceinline__ void tile_map(int nM, int nN, int L, int& pm, int& pn) {
    const int nwg = nM * nN; int wgid = L;
    { const int q = nwg / NXCD, r = nwg % NXCD, xcd = wgid % NXCD, off = wgid / NXCD; wgid = (xcd < r ? xcd * (q + 1) : r * (q + 1) + (xcd - r) * q) + off; }
    const int nig = WGM * nN, gid = wgid / nig, fm = gid * WGM, gsz = (nM - fm) < WGM ? (nM - fm) : WGM;
    pm = fm + ((wgid % nig) % gsz); pn = (wgid % nig) / gsz;
}
struct SchedPlain { int nM, nN, G, c, nt;
    __device__ __forceinline__ bool next(int i, Unit& u) const { const long L = (long)i * G + c; if (L >= (long)nM * nN) return false; tile_map(nM, nN, (int)L, u.pm, u.pn); u.acol = 0; u.z = 0; u.bcol = 0; u.kind = 0; u.nt = nt; return true; }
    __device__ __forceinline__ void a_ready(const Unit&) const {} __device__ __forceinline__ void done(const Unit&) const {} };
struct SchedGate { int nM, G, c;
    __device__ __forceinline__ bool next(int i, Unit& u) const { const long T = (long)(i >> 3) * G + c; if (T >= (long)nM * 8) return false; int pm, pn; tile_map(nM, 8, (int)T, pm, pn); const int z = (i >> 1) & 3, isg = i & 1;
        u.pm = pm; u.z = z; u.kind = isg ? 0 : 1; u.pn = isg ? z * 8 + pn : pn; u.acol = isg ? 0 : 512 * z; u.bcol = isg ? 0 : 512 * z; u.nt = isg ? 32 : 8; return true; }
    __device__ __forceinline__ void a_ready(const Unit&) const {} __device__ __forceinline__ void done(const Unit&) const {} };

__device__ __forceinline__ u32x4 pack8(const f32x4& a, const f32x4& b) { u32x4 w; w.x = cvt_pk_bf16(a[0], a[1]); w.y = cvt_pk_bf16(a[2], a[3]); w.z = cvt_pk_bf16(b[0], b[1]); w.w = cvt_pk_bf16(b[2], b[3]); return w; }
__device__ __forceinline__ void unpack8(const u32x4& w, f32x4& a, f32x4& b) {
    a[0] = __uint_as_float(w.x << 16); a[1] = __uint_as_float(w.x & 0xffff0000u); a[2] = __uint_as_float(w.y << 16); a[3] = __uint_as_float(w.y & 0xffff0000u);
    b[0] = __uint_as_float(w.z << 16); b[1] = __uint_as_float(w.z & 0xffff0000u); b[2] = __uint_as_float(w.w << 16); b[3] = __uint_as_float(w.w & 0xffff0000u); }
__device__ __forceinline__ float sigm(float x) { return __builtin_amdgcn_rcpf(1.0f + __builtin_amdgcn_exp2f(-1.4426950408889634f * x)); }

struct EpiPlain {
    static constexpr bool PERM = true, AFTER_DRAIN = false;
    bf16_t* O; int ldc; int colmask; size_t zstride;
    __device__ __forceinline__ void operator()(const f32x4 (&acc)[2][2][4][2], const Unit& u, int wr_, int wc_, int fr_, int fq_) const {
        const int tid = OPAQUE_TID, wid_ = __builtin_amdgcn_readfirstlane(tid >> 6), wr = wid_ >> 2, wc = wid_ & 3, fr = tid & 15, fq = (tid & 63) >> 4;
        const int row0 = u.pm * BM + wr * 64 + fr, col0 = (u.pn & colmask) * BM + wc * 32 + 8 * fq; bf16_t* base = O + (size_t)u.z * zstride;
#pragma unroll
        for (int ai = 0; ai < 2; ++ai)
#pragma unroll
            for (int m = 0; m < 4; ++m) { bf16_t* rowp = base + (size_t)(row0 + ai * HALF + m * 16) * ldc + col0;
#pragma unroll
                for (int bj = 0; bj < 2; ++bj) *(u32x4*)(rowp + bj * HALF) = pack8(acc[ai][bj][m][0], acc[ai][bj][m][1]); }
    }
};
struct EpiProj {
    static constexpr bool PERM = true, AFTER_DRAIN = false;
    bf16_t* P; float* NAR;
    __device__ __forceinline__ void operator()(const f32x4 (&acc)[2][2][4][2], const Unit& u, int wr_, int wc_, int fr_, int fq_) const {
        const int tid = OPAQUE_TID, wid_ = __builtin_amdgcn_readfirstlane(tid >> 6), wr = wid_ >> 2, wc = wid_ & 3, fr = tid & 15, fq = (tid & 63) >> 4;
        const int row0 = u.pm * BM + wr * 64 + fr;
        if (u.pn < 22) { const int col0 = u.pn * BM + wc * 32 + 8 * fq;
            const float sc = (u.pn < 2) ? 0.125f * LOG2E : 1.0f;
#pragma unroll
            for (int ai = 0; ai < 2; ++ai)
#pragma unroll
                for (int m = 0; m < 4; ++m) { bf16_t* rowp = P + (size_t)(row0 + ai * HALF + m * 16) * PW + col0;
#pragma unroll
                    for (int bj = 0; bj < 2; ++bj) __builtin_nontemporal_store(pack8(acc[ai][bj][m][0] * sc, acc[ai][bj][m][1] * sc), (u32x4*)(rowp + bj * HALF)); }
        } else if (wc == 0 && fq < 3) {
#pragma unroll
            for (int ai = 0; ai < 2; ++ai)
#pragma unroll
                for (int m = 0; m < 4; ++m) { float* np = NAR + (size_t)(row0 + ai * HALF + m * 16) * NWP + 8 * fq; *(f32x4*)np = acc[ai][0][m][0]; *(f32x4*)(np + 4) = acc[ai][0][m][1]; }
        }
    }
};
struct EpiGlu {
    static constexpr bool PERM = true, AFTER_DRAIN = false;
    const bf16_t* Z; const float* bias; bf16_t* O;
    __device__ __forceinline__ void operator()(const f32x4 (&acc)[2][2][4][2], const Unit& u, int wr_, int wc_, int fr_, int fq_) const {
        const int tid = OPAQUE_TID, wid_ = __builtin_amdgcn_readfirstlane(tid >> 6), wr = wid_ >> 2, wc = wid_ & 3, fr = tid & 15, fq = (tid & 63) >> 4;
        const int row0 = u.pm * BM + wr * 64 + fr, col0 = u.pn * BM + wc * 32 + 8 * fq;
#pragma unroll
        for (int bj = 0; bj < 2; ++bj) { const int c = col0 + bj * HALF; const f32x4 b0 = *(const f32x4*)(bias + c), b1 = *(const f32x4*)(bias + c + 4);
#pragma unroll
            for (int ai = 0; ai < 2; ++ai)
#pragma unroll
                for (int m = 0; m < 4; ++m) { const size_t row = (size_t)(row0 + ai * HALF + m * 16); f32x4 z0, z1; unpack8(*(const u32x4*)(Z + row * 512 + c), z0, z1);
                    f32x4 v0 = acc[ai][bj][m][0] + b0, v1 = acc[ai][bj][m][1] + b1;
#pragma unroll
                    for (int j = 0; j < 4; ++j) { v0[j] = z0[j] * sigm(v0[j]); v1[j] = z1[j] * sigm(v1[j]); }
                    *(u32x4*)(O + row * OW + 1536 + c) = pack8(v0, v1); } }
    }
};
struct EpiGate {
    static constexpr bool PERM = true, AFTER_DRAIN = false;
    const float* bias; bf16_t* scr; bf16_t* MG;
    __device__ __forceinline__ void operator()(const f32x4 (&acc)[2][2][4][2], const Unit& u, int wr_, int wc_, int fr_, int fq_) const {
        const int tid = OPAQUE_TID, wid_ = __builtin_amdgcn_readfirstlane(tid >> 6), wr = wid_ >> 2, wc = wid_ & 3, fr = tid & 15, fq = (tid & 63) >> 4;
        bf16_t* ps = scr; bf16_t* ms = scr + 65536;
        if (u.kind == 1) {
#pragma unroll
            for (int bj = 0; bj < 2; ++bj)
#pragma unroll
                for (int q = 0; q < 8; ++q) *(u32x4*)(ps + ((size_t)(q * 2 + bj) * 512 + tid) * 8) = pack8(acc[q >> 2][bj][q & 3][0], acc[q >> 2][bj][q & 3][1]);
            return;
        }
        const int z = u.z, col0 = (u.pn & 7) * BM + wc * 32 + 8 * fq;
        const float* bz = bias + z * DM; GAS char* MGp = (GAS char*)uptr(MG + (size_t)(u.pm * BM) * DM);
        const unsigned voff = (unsigned)((wr * 64 + fr) * DM + col0) * 2u;
#pragma unroll
        for (int bj = 0; bj < 2; ++bj) { const int c = col0 + bj * HALF; const f32x4 b0 = *(const f32x4*)(bz + c), b1 = *(const f32x4*)(bz + c + 4);
#pragma unroll
            for (int qh = 0; qh < 2; ++qh) {
                u32x4 pv[4], sv[4];
#pragma unroll
                for (int qq = 0; qq < 4; ++qq) { const int q = qh * 4 + qq; pv[qq] = *(const u32x4*)(ps + ((size_t)(q * 2 + bj) * 512 + tid) * 8); if (z > 0) sv[qq] = *(const u32x4*)(ms + ((size_t)(q * 2 + bj) * 512 + tid) * 8); }
#pragma unroll
                for (int qq = 0; qq < 4; ++qq) { const int q = qh * 4 + qq, ai = q >> 2, m = q & 3; f32x4 p0, p1; unpack8(pv[qq], p0, p1);
                    f32x4 v0 = acc[ai][bj][m][0] + b0, v1 = acc[ai][bj][m][1] + b1;
#pragma unroll
                    for (int j = 0; j < 4; ++j) { v0[j] = p0[j] * sigm(v0[j]); v1[j] = p1[j] * sigm(v1[j]); }
                    if (z > 0) { f32x4 s0, s1; unpack8(sv[qq], s0, s1); v0 += s0; v1 += s1; }
                    if (z < 3) *(u32x4*)(ms + ((size_t)(q * 2 + bj) * 512 + tid) * 8) = pack8(v0, v1);
                    else *(GAS u32x4*)(MGp + voff + (unsigned)((ai * HALF + m * 16) * DM + bj * HALF) * 2u) = pack8(v0, v1); }
                asm volatile("" ::: "memory");
            }
        }
    }
};
struct EpiSwiglu {
    static constexpr bool PERM = true, AFTER_DRAIN = false;
    bf16_t* Hd;
    __device__ __forceinline__ void operator()(const f32x4 (&acc)[2][2][4][2], const Unit& u, int wr_, int wc_, int fr_, int fq_) const {
        const int tid = OPAQUE_TID, wid_ = __builtin_amdgcn_readfirstlane(tid >> 6), wr = wid_ >> 2, wc = wid_ & 3, fr = tid & 15, fq = (tid & 63) >> 4;
        const int row0 = u.pm * BM + wr * 64 + fr, col0 = u.pn * HALF + wc * 32 + 8 * fq;
#pragma unroll
        for (int ai = 0; ai < 2; ++ai)
#pragma unroll
            for (int m = 0; m < 4; ++m) { f32x4 v0, v1;
#pragma unroll
                for (int j = 0; j < 4; ++j) { const float a0 = acc[ai][0][m][0][j], a1 = acc[ai][0][m][1][j]; v0[j] = a0 * sigm(a0) * acc[ai][1][m][0][j]; v1[j] = a1 * sigm(a1) * acc[ai][1][m][1][j]; }
                __builtin_nontemporal_store(pack8(v0, v1), (u32x4*)(Hd + (size_t)(row0 + ai * HALF + m * 16) * FFH + col0)); }
    }
};
}

struct Args { const float* in[28]; float* out; unsigned char* ws; int ph_lo, ph_hi; };
enum { I_X = 0, I_C, I_ADAW, I_ADAB, I_NORMG, I_WIN, I_RELB, I_DLAM, I_MLCONV, I_MLGB, I_GLAWA2, I_GLABA, I_S5ARE, I_S5AIM, I_S5DT, I_S5BRE, I_S5BIM, I_S5CRE, I_S5CIM, I_S5D, I_GLUW, I_GLUB, I_WBR, I_WGATE, I_BGATE, I_WOUT, I_FFIN, I_FFOUT };

typedef const __attribute__((address_space(4))) unsigned char* kaptr_t;
__device__ __forceinline__ kaptr_t ka_base() { kaptr_t p = (kaptr_t)__builtin_amdgcn_kernarg_segment_ptr(); asm volatile("" : "+s"(p)); return p; }
__device__ __forceinline__ const float* INP(int i) { return *(const float* const __attribute__((address_space(4)))*)(ka_base() + 8 * i); }
__device__ __forceinline__ float* OUTP() { return *(float* const __attribute__((address_space(4)))*)(ka_base() + 224); }
__device__ __forceinline__ unsigned char* WSB() { return *(unsigned char* const __attribute__((address_space(4)))*)(ka_base() + 232); }
static_assert(sizeof(Args) == 248, "Args layout");
template <class RowMap>
__device__ __forceinline__ void conv_item(const float* __restrict__ W, int K, int N, bf16_t* __restrict__ WT, int ldk, int koff, const RowMap& rm, LAS float* scr, int item, int lane) {
    const int nblk = (N + 31) / 32, kb = item / nblk, nb = item % nblk, k0 = 64 * kb, n0 = 32 * nb;
    const int nn = n0 + 4 * (lane & 7); const bool okn = nn < N;
    f32x4 v[8];
#pragma unroll
    for (int i = 0; i < 8; ++i) v[i] = okn ? *(const f32x4*)(W + (size_t)(k0 + (lane >> 3) + 8 * i) * N + nn) : (f32x4){0.f, 0.f, 0.f, 0.f};
#pragma unroll
    for (int i = 0; i < 8; ++i) { LAS float* s = scr + ((lane >> 3) + 8 * i) * 33 + 4 * (lane & 7); s[0] = v[i][0]; s[1] = v[i][1]; s[2] = v[i][2]; s[3] = v[i][3]; }
    asm volatile("s_waitcnt lgkmcnt(0)" ::: "memory");
    const int c = lane & 7;
#pragma unroll
    for (int j = 0; j < 4; ++j) { const int n = (lane >> 3) + 8 * j; const LAS float* s = scr + (8 * c) * 33 + n;
        u32x4 o; o.x = pk2(s[0 * 33], s[1 * 33]); o.y = pk2(s[2 * 33], s[3 * 33]); o.z = pk2(s[4 * 33], s[5 * 33]); o.w = pk2(s[6 * 33], s[7 * 33]);
        if (n0 + n < N) *(u32x4*)(WT + (size_t)rm(n0 + n) * ldk + koff + k0 + 8 * c) = o; }
    asm volatile("s_waitcnt lgkmcnt(0)" ::: "memory");
}
struct RmIdent { int off; __device__ __forceinline__ int operator()(int n) const { return off + n; } };
struct RmWin { __device__ __forceinline__ int operator()(int n) const { return n < 3584 ? n : (n < 3592 ? 5632 + (n - 3584) : (n < 5128 ? n - 8 : (n < 5144 ? 5640 + (n - 5128) : n - 24))); } };
struct RmFfi { __device__ __forceinline__ int operator()(int n) const { const int g = n >= FFH, j = g ? n - FFH : n; return (j >> 7) * 256 + g * 128 + (j & 127); } };

__device__ __forceinline__ void convert_layer(int l, LDSP lds, int wg, int G, bool with_s5) {
    const int tid_ = OPAQUE_TID, lane = tid_ & 63, gw = wg * 8 + __builtin_amdgcn_readfirstlane(tid_ >> 6), NGW = G * 8, gtid = wg * 512 + tid_, NT = G * 512;
    unsigned char* ws = WSB() + ((l & 1) ? (WS_WSET2 - WS_WGLU) : 0);
    LAS float* scr = (LAS float*)(lds + (tid_ >> 6) * 16384);
    bf16_t* Win = (bf16_t*)(ws + WS_WIN); bf16_t* Wg = (bf16_t*)(ws + WS_WG); bf16_t* Wb = (bf16_t*)(ws + WS_WB); bf16_t* Wo = (bf16_t*)(ws + WS_WOUT); bf16_t* Wfi = (bf16_t*)(ws + WS_WFI); bf16_t* Wfo = (bf16_t*)(ws + WS_WFO); bf16_t* Wglu = (bf16_t*)(ws + WS_WGLU);
    constexpr int I_IN = 32 * 177, I_G1 = 32 * 64, I_G = 4 * I_G1, I_B1 = 8 * 64, I_B = 4 * I_B1, I_O = 32 * 64, I_FI = 32 * 352, I_FO = 88 * 64, I_GL = 8 * 16;
    constexpr int NIT = I_IN + I_G + I_B + I_O + I_FI + I_FO + I_GL;
    struct Dec { const float* W; bf16_t* WT; int N, ldk, koff, kind, off, r; };
    auto decode = [&](int it) { Dec d; int r = it;
        if (r < I_IN) { d = Dec{INP(I_WIN) + (size_t)l * DM * 5656, Win, 5656, DM, 0, 1, 0, r}; return d; } r -= I_IN;
        if (r < I_G) { const int z = r / I_G1; d = Dec{INP(I_WGATE) + ((size_t)l * 4 + z) * DM * DM, Wg, DM, DM, 0, 0, z * DM, r % I_G1}; return d; } r -= I_G;
        if (r < I_B) { const int z = r / I_B1; d = Dec{INP(I_WBR) + ((size_t)l * 4 + z) * 512 * DM, Wb, DM, DM, 512 * z, 0, 0, r % I_B1}; return d; } r -= I_B;
        if (r < I_O) { d = Dec{INP(I_WOUT) + (size_t)l * DM * DM, Wo, DM, DM, 0, 0, 0, r}; return d; } r -= I_O;
        if (r < I_FI) { d = Dec{INP(I_FFIN) + (size_t)l * DM * 2 * FFH, Wfi, 2 * FFH, DM, 0, 2, 0, r}; return d; } r -= I_FI;
        if (r < I_FO) { d = Dec{INP(I_FFOUT) + (size_t)l * FFH * DM, Wfo, DM, FFH, 0, 0, 0, r}; return d; } r -= I_FO;
        d = Dec{INP(I_GLUW) + (size_t)l * 512 * 512, Wglu, 512, 512, 0, 0, 0, r}; return d; };
    f32x4 v[8];
#define CONV_LOAD(D) { const int nblk_ = ((D).N + 31) / 32, k0_ = 64 * ((D).r / nblk_), nn_ = 32 * ((D).r % nblk_) + 4 * (lane & 7); const bool okn_ = nn_ < (D).N; \
        _Pragma("unroll") for (int i = 0; i < 8; ++i) v[i] = okn_ ? *(const f32x4*)((D).W + (size_t)(k0_ + (lane >> 3) + 8 * i) * (D).N + nn_) : (f32x4){0.f, 0.f, 0.f, 0.f}; }
    int it = gw; Dec cur{}; if (it < NIT) { cur = decode(it); CONV_LOAD(cur); }
    for (; it < NIT; it += NGW) {
#pragma unroll
        for (int i = 0; i < 8; ++i) { LAS float* s = scr + ((lane >> 3) + 8 * i) * 33 + 4 * (lane & 7); s[0] = v[i][0]; s[1] = v[i][1]; s[2] = v[i][2]; s[3] = v[i][3]; }
        Dec nxt = cur; if (it + NGW < NIT) { nxt = decode(it + NGW); CONV_LOAD(nxt); }
        asm volatile("s_waitcnt lgkmcnt(0)" ::: "memory");
        const int nblk = (cur.N + 31) / 32, k0 = 64 * (cur.r / nblk), n0 = 32 * (cur.r % nblk), c = lane & 7;
#pragma unroll
        for (int j = 0; j < 4; ++j) { const int n = (lane >> 3) + 8 * j; const LAS float* s = scr + (8 * c) * 33 + n;
            u32x4 o; o.x = pk2(s[0 * 33], s[1 * 33]); o.y = pk2(s[2 * 33], s[3 * 33]); o.z = pk2(s[4 * 33], s[5 * 33]); o.w = pk2(s[6 * 33], s[7 * 33]);
            const int ng = n0 + n; const int row = cur.kind == 0 ? cur.off + ng : (cur.kind == 1 ? RmWin{}(ng) : RmFfi{}(ng));
            if (ng < cur.N) *(u32x4*)(cur.WT + (size_t)row * cur.ldk + cur.koff + k0 + 8 * c) = o; }
        asm volatile("s_waitcnt lgkmcnt(0)" ::: "memory");
        cur = nxt;
    }
#undef CONV_LOAD
    for (int i = gtid; i < 232 * 256; i += NT) ((u32x4*)(Win + (size_t)5656 * DM))[i] = (u32x4){0u, 0u, 0u, 0u};
    ws = WSB();
    if (with_s5 && gtid < 2048) s5_prep_item(gtid, INP(I_S5ARE) + l * 2048, INP(I_S5AIM) + l * 2048, INP(I_S5DT) + l * 32, INP(I_S5BRE) + (size_t)l * 32768, INP(I_S5BIM) + (size_t)l * 32768,
                                  INP(I_S5CRE) + (size_t)l * 32768, INP(I_S5CIM) + (size_t)l * 32768, (float*)(ws + WS_S5T), (float*)(ws + WS_S5T + 16384), S5_LC, (bf16_t*)(ws + WS_S5T + 65536), (bf16_t*)(ws + WS_S5T + 65536 + 262144));
}

__device__ __forceinline__ void mod_partials(LDSP lds, int wg, int G) {
    LAS float* cs = (LAS float*)lds;
    const int tid = OPAQUE_TID;
    for (int it = wg; it < KSPLIT * NLAYER * 6; it += G) {
        const int ks = it / (NLAYER * 6), l = (it / 6) % NLAYER, cg = it % 6;
        __syncthreads();
        for (int i = tid; i < BATCH * 256; i += 512) { const int b = i >> 8, k = ks * 256 + (i & 255); const float c = INP(I_C)[b * DM + k]; cs[i] = c * sigmoidf_(c); }
        __syncthreads();
        const float* wp = INP(I_ADAW) + ((size_t)l * DM + ks * 256) * (6 * DM) + cg * DM + 4 * tid;
        f32x4 s[BATCH];
#pragma unroll
        for (int b = 0; b < BATCH; ++b) s[b] = (f32x4){0.f, 0.f, 0.f, 0.f};
#pragma unroll 16
        for (int k = 0; k < 256; ++k) { const f32x4 w = *(const f32x4*)(wp + (size_t)k * (6 * DM));
#pragma unroll
            for (int b = 0; b < BATCH; ++b) s[b] += w * cs[b * 256 + k]; }
        float* mp = (float*)(WSB() + WS_MODP);
#pragma unroll
        for (int b = 0; b < BATCH; ++b) *(f32x4*)(mp + (((size_t)ks * NLAYER + l) * BATCH + b) * (6 * DM) + cg * DM + 4 * tid) = s[b];
    }
}
__device__ __forceinline__ f32x4 mod_vec(int l, int b, int idx, int tid) {
    f32x4 s = *(const f32x4*)(INP(I_ADAB) + (size_t)l * 6 * DM + idx * DM + 4 * tid);
    const float* mp = (const float*)(WSB() + WS_MODP);
#pragma unroll
    for (int ks = 0; ks < KSPLIT; ++ks) s += *(const f32x4*)(mp + (((size_t)ks * NLAYER + l) * BATCH + b) * (6 * DM) + idx * DM + 4 * tid);
    return s;
}
__device__ __forceinline__ void norm_phase(LDSP lds, int wg, int G, const void* xin_, int xin_bf, void* xout_, int xout_bf, const bf16_t* ysrc, int l_res, int i_gate, int i_ga, bf16_t* hout, int l_h, int i_scale, int i_shift, int i_gb) {
    LAS f32x4* VA = (LAS f32x4*)lds; LAS f32x4* VB = (LAS f32x4*)(lds + 8192); LAS f32x4* VC = (LAS f32x4*)(lds + 16384);
    const int tid = OPAQUE_TID, lane = tid & 63, wave = tid >> 6;
    for (int chunk = wg; chunk < M_TOK / 128; chunk += G) {
        const int b = (chunk * 128) / SEQ;
        __syncthreads();
        if (ysrc) VA[tid] = mod_vec(l_res, b, i_gate, tid) * *(const f32x4*)(INP(I_NORMG) + ((size_t)l_res * 4 + i_ga) * DM + 4 * tid);
        if (hout) { VB[tid] = (mod_vec(l_h, b, i_scale, tid) + 1.0f) * *(const f32x4*)(INP(I_NORMG) + ((size_t)l_h * 4 + i_gb) * DM + 4 * tid); VC[tid] = mod_vec(l_h, b, i_shift, tid); }
        __syncthreads();
        u32x2 xb[8], yb[8];
#define NP_LOAD(ROW) { const size_t rw_ = (ROW); \
            _Pragma("unroll") for (int j = 0; j < 8; ++j) { if (xin_bf) xb[j] = *((const u32x2*)((const bf16_t*)xin_ + rw_ * DM) + lane + 64 * j); \
                if (ysrc) yb[j] = *((const u32x2*)(ysrc + rw_ * DM) + lane + 64 * j); } }
        NP_LOAD((size_t)chunk * 128 + wave);
        for (int r = wave; r < 128; r += 8) {
            const size_t row = (size_t)chunk * 128 + r;
            f32x4 x[8], y[8];
#pragma unroll
            for (int j = 0; j < 8; ++j) {
                if (xin_bf) { const u32x2 w = xb[j]; x[j][0] = __uint_as_float(w.x << 16); x[j][1] = __uint_as_float(w.x & 0xffff0000u); x[j][2] = __uint_as_float(w.y << 16); x[j][3] = __uint_as_float(w.y & 0xffff0000u); }
                else x[j] = *((const f32x4*)((const float*)xin_ + row * DM) + lane + 64 * j);
                if (ysrc) { const u32x2 w = yb[j]; y[j][0] = __uint_as_float(w.x << 16); y[j][1] = __uint_as_float(w.x & 0xffff0000u); y[j][2] = __uint_as_float(w.y << 16); y[j][3] = __uint_as_float(w.y & 0xffff0000u); } }
            sched_fence();
            if (r + 8 < 128) NP_LOAD(row + 8);
            if (ysrc) {
                float ss = 0.f;
#pragma unroll
                for (int j = 0; j < 8; ++j) ss += (y[j][0] * y[j][0] + y[j][1] * y[j][1]) + (y[j][2] * y[j][2] + y[j][3] * y[j][3]);
                ss = wave_sum_f(ss); const float rn = 1.0f / sqrtf(ss * (1.0f / DM) + RMS_EPS);
#pragma unroll
                for (int j = 0; j < 8; ++j) { x[j] += y[j] * rn * VA[lane + 64 * j];
                    if (xout_bf) { u32x2 w; w.x = pk2(x[j][0], x[j][1]); w.y = pk2(x[j][2], x[j][3]); *((u32x2*)((bf16_t*)xout_ + row * DM) + lane + 64 * j) = w; }
                    else *((f32x4*)((float*)xout_ + row * DM) + lane + 64 * j) = x[j]; }
            }
            if (hout) {
                float ss = 0.f;
#pragma unroll
                for (int j = 0; j < 8; ++j) ss += (x[j][0] * x[j][0] + x[j][1] * x[j][1]) + (x[j][2] * x[j][2] + x[j][3] * x[j][3]);
                ss = wave_sum_f(ss); const float rn = 1.0f / sqrtf(ss * (1.0f / DM) + RMS_EPS);
#pragma unroll
                for (int j = 0; j < 8; ++j) { const f32x4 hv = x[j] * rn * VB[lane + 64 * j] + VC[lane + 64 * j]; u32x2 w; w.x = pk2(hv[0], hv[1]); w.y = pk2(hv[2], hv[3]);
                    *((u32x2*)(hout + row * DM) + lane + 64 * j) = w; }
            }
        }
    }
}

#undef NP_LOAD
#ifndef REP_G1
#define REP_G1 1
#endif
#ifndef REP_A
#define REP_A 1
#endif
#ifndef REP_B
#define REP_B 1
#endif
#ifndef REP_MIX
#define REP_MIX 1
#endif
#ifndef REP_G2
#define REP_G2 1
#endif
#ifndef REP_G3
#define REP_G3 1
#endif
#ifndef REP_G4
#define REP_G4 1
#endif
#ifndef REP_G5
#define REP_G5 1
#endif
#ifndef REP_G6
#define REP_G6 1
#endif
#ifndef REP_G7
#define REP_G7 1
#endif
#ifndef DBL_ATT
#define DBL_ATT 1
#endif
#ifndef DBL_S5
#define DBL_S5 1
#endif
#ifndef DBL_P1
#define DBL_P1 1
#endif
#ifndef DBL_P3
#define DBL_P3 1
#endif
#ifndef S5_STATIC
#define S5_STATIC 0
#endif
#ifndef PROBE_ITEMS
#define PROBE_ITEMS 15
#endif
#ifndef MX_ML
#define MX_ML 1
#endif
#ifndef MX_GLA
#define MX_GLA 1
#endif
#ifndef MX_S5
#define MX_S5 1
#endif
#ifndef MX_ATT
#define MX_ATT 1
#endif
#ifndef PH_G1
#define PH_G1 1
#endif
#ifndef PH_MIX
#define PH_MIX 1
#endif
#ifndef PH_G2
#define PH_G2 1
#endif
#ifndef PH_G3
#define PH_G3 1
#endif
#ifndef PH_G4
#define PH_G4 1
#endif
#ifndef PH_G5
#define PH_G5 1
#endif
#ifndef PH_N2
#define PH_N2 1
#endif
#ifndef PH_G6
#define PH_G6 1
#endif
#ifndef PH_G7
#define PH_G7 1
#endif
#ifndef PH_N3
#define PH_N3 1
#endif
__global__ void __launch_bounds__(512, 2) fwd_kernel(Args a) {
    extern __shared__ __attribute__((aligned(16))) unsigned char lds_raw[];
    LDSP lds = (LDSP)lds_raw;
    const int G = gridDim.x, wg = blockIdx.x;
#define ws WSB()
#define ctl ((unsigned*)(WSB() + WS_CTL))
    volatile LAS unsigned* MISC = (volatile LAS unsigned*)(lds + LDS_MISC);
    if (threadIdx.x < 64) MISC[threadIdx.x] = 0u;
    __syncthreads();
    XcdBarrier bar = xcd_barrier_post(ctl + CW_BAR, MISC);
    const int lo = a.ph_lo, hi = a.ph_hi;
    int ph = 0;
#define IN(k) (lo <= (k) && (k) < hi)
#ifndef NBARPASS
#define NBARPASS 1
#endif
#define GRID_SYNC() do { _Pragma("unroll") for (int bp_ = 0; bp_ < NBARPASS; ++bp_) xcd_barrier(bar); } while (0)
#define SEAM(k) do { if (IN(k) && IN((k) + 1)) GRID_SYNC(); } while (0)
#define Hb ((bf16_t*)(ws + WS_H))
#define PROJ ((bf16_t*)(ws + WS_PROJ))
#define NAR ((float*)(ws + WS_NAR))
#define OALL ((bf16_t*)(ws + WS_OALL))
#define Zb ((bf16_t*)(ws + WS_Z))
#define Pb ((bf16_t*)(ws + WS_P))
#define MG ((bf16_t*)(ws + WS_MERGED))
#define MIXB ((bf16_t*)(ws + WS_MIXB))
#define Yb ((bf16_t*)(ws + WS_Y))
#define HID ((bf16_t*)(ws + WS_HID))
#define XB ((bf16_t*)(ws + WS_XB))

    if (IN(ph)) { mod_partials(lds, wg, G); __syncthreads(); convert_layer(0, lds, wg, G, true);
#ifdef PROBE_NAN_FILL
        { u32x4* p_ = (u32x4*)(ws + WS_NAR); const size_t n_ = (WS_END - WS_NAR) / 16; for (size_t i_ = (size_t)wg * 512 + threadIdx.x; i_ < n_; i_ += (size_t)G * 512) p_[i_] = (u32x4){0x7FC07FC0u, 0x7FC07FC0u, 0x7FC07FC0u, 0x7FC07FC0u}; }
#endif
    }
    SEAM(ph); ++ph;
    if (IN(ph)) norm_phase(lds, wg, G, INP(I_X), 0, nullptr, 0, nullptr, 0, 0, 0, Hb, 0, 1, 0, 0);
    SEAM(ph); ++ph;

    for (int l = 0; l < NLAYER; ++l) {
#define wsw (ws + ((l & 1) ? (WS_WSET2 - WS_WGLU) : 0))
        if (IN(ph) && PH_G1) for (int rep = 0; rep < REP_G1; ++rep) { pg8::Gemm g{Hb, (const bf16_t*)(wsw + WS_WIN), DM, DM, DM, nullptr, nullptr}; pg8::SchedPlain S{NMT, NPROJ / 256, G, wg, DM / 64}; pg8::EpiProj E{PROJ, NAR};
            pg8::gemm_phase<pg8::EpiProj, pg8::SchedPlain, true, true>((PG8_LAS unsigned char*)lds, g, S, E);
            { constexpr int NU = NMT * (NPROJ / 256); const int busy = NU % G; if (l + 1 < NLAYER && busy != 0 && wg >= busy) { __syncthreads(); convert_layer(l + 1, lds, wg - busy, G - busy, false); } } }
        SEAM(ph); ++ph;
        if (IN(ph) && PH_MIX) for (int rep = 0; rep < REP_MIX; ++rep) {
            const int tid = OPAQUE_TID, lane = tid & 63, wave = __builtin_amdgcn_readfirstlane(tid >> 6);
            LAS float* biasT = (LAS float*)(lds + LDS_BIAS);
            if (tid < 512) { const int h = tid >> 7, d = tid & 127; biasT[tid] = INP(I_RELB)[T5_BUCKET[d] * 4 + h] * LOG2E; }
            const float* dl = INP(I_DLAM) + l * 256;
            const float s1 = wave_sum_f(dl[lane] * dl[64 + lane]), s2 = wave_sum_f(dl[128 + lane] * dl[192 + lane]);
            const float lam_init = 0.8f - 0.6f * __expf(-0.3f * (float)l), lam = __expf(s1) - __expf(s2) + lam_init;
            __syncthreads();
            float* MLST = (float*)(ws + WS_P); float* MLST2 = (float*)(ws + WS_P + 68 * MiB); float* GLST = (float*)(ws + WS_P + 136 * MiB); float* GLST2 = (float*)(ws + WS_P + 170 * MiB);
            static_assert((size_t)BATCH * 4 * NCH * ML_SO_BYTES <= 68 * MiB && (size_t)BATCH * 4 * NCH * GLA_P1_BYTES <= 34 * MiB, "state records");
            constexpr int NIT = BATCH * 4 * NCH;
            float* S5ST = (float*)(ws + WS_P + 204 * MiB);
            constexpr int NS5P1 = BATCH * 4 * (S5_NC - 1), NS5P3 = BATCH * 4 * S5_NC;
            for (int ra_ = 0; ra_ < REP_A; ++ra_) {
                unsigned* qa = ctl + CW_Q + 64 * (l + 4 * rep) + 32 + 8 * ra_;
                unsigned qn = 0; if (tid == 0) qn = __hip_atomic_fetch_add(qa, 1u, __ATOMIC_RELAXED, __HIP_MEMORY_SCOPE_AGENT);
                for (;;) {
                    if (tid == 0) { MISC[16] = qn; qn = __hip_atomic_fetch_add(qa, 1u, __ATOMIC_RELAXED, __HIP_MEMORY_SCOPE_AGENT); }
                    __syncthreads();
                    const int item = (int)MISC[16];
                    if (item >= NS5P1 + 2 * NIT) break;
                    if (item < NS5P1) { const int j = item, c = j % (S5_NC - 1), gb = (j / (S5_NC - 1)) & 3, b = j / (4 * (S5_NC - 1));
                        s5_chunk<1>(lds + wave * S5_WAVE_LDS, PROJ, (const float*)(ws + WS_S5T), (const float*)(ws + WS_S5T + 16384), (const bf16_t*)(ws + WS_S5T + 65536), (const bf16_t*)(ws + WS_S5T + 65536 + 262144),
                                    INP(I_S5D) + l * 512, S5ST, Zb, b, gb * 8 + wave, c); }
                    else { const int it = item - NS5P1;
                        if (it < NIT) mlstm_chunk<1>(lds, PROJ, NAR, INP(I_MLCONV) + l * 4096, INP(I_MLGB) + l * 8, MLST, OALL, (it / NCH) >> 2, (it / NCH) & 3, it % NCH);
                        else { const int j = it - NIT; gla_chunk<1>(lds, PROJ, NAR, INP(I_GLAWA2) + l * 4096, INP(I_GLABA) + l * 256, GLST, OALL, (j / NCH) >> 2, (j / NCH) & 3, j % NCH); } }
                    __syncthreads();
                }
            }
            GRID_SYNC();
            for (int rb_ = 0; rb_ < REP_B; ++rb_) {
            { constexpr int NQ_ML = BATCH * 4 * 4096, NQ = NQ_ML + BATCH * 4 * 2048; const int per = ((NQ + G - 1) / G + 63) & ~63;
              for (int t_ = tid; t_ < per; t_ += 512) { const int q = wg * per + t_;
                if (q < NQ_ML) mlstm_scan_e((float*)((char*)MLST + (size_t)(q >> 12) * NCH * ML_SO_BYTES), (float*)((char*)MLST2 + (size_t)(q >> 12) * NCH * ML_SO_BYTES), (q & 4095) * 4);
                else if (q < NQ) { const int v = q - NQ_ML; gla_scan_e((float*)((char*)GLST + (size_t)(v >> 11) * NCH * GLA_P1_BYTES), (float*)((char*)GLST2 + (size_t)(v >> 11) * NCH * GLA_SO_BYTES), (v & 2047) * 4); } } }
            }
            GRID_SYNC();
            constexpr unsigned NATT = BATCH * 4 * (SEQ / 128);
            if ((S5_STATIC == 1 || S5_STATIC == 2) && wg >= 32 && wg < 32 + BATCH * 4) { const int pair = (wg - 32) * 8 + wave; s5_wave(lds + wave * S5_WAVE_LDS, PROJ, (const float*)(ws + WS_S5T), (const bf16_t*)(ws + WS_S5T + 65536), (const bf16_t*)(ws + WS_S5T + 65536 + 262144),
                                                                                      INP(I_S5D) + l * 512, Zb, pair >> 5, pair & 31); __syncthreads(); }
            if (S5_STATIC == 3) { for (int j = wg; j < (int)NS5P3; j += G) { const int c = j % S5_NC, gb = (j / S5_NC) & 3, b = j / (4 * S5_NC);
                    s5_chunk<3>(lds + wave * S5_WAVE_LDS, PROJ, (const float*)(ws + WS_S5T), (const float*)(ws + WS_S5T + 16384), (const bf16_t*)(ws + WS_S5T + 65536), (const bf16_t*)(ws + WS_S5T + 65536 + 262144),
                                INP(I_S5D) + l * 512, S5ST, Zb, b, gb * 8 + wave, c); __syncthreads(); } }
            unsigned qnext = 0; if (tid == 0) qnext = __hip_atomic_fetch_add(ctl + CW_Q + 64 * (l + 4 * rep), 1u, __ATOMIC_RELAXED, __HIP_MEMORY_SCOPE_AGENT);
            for (;;) {
                if (tid == 0) { MISC[16] = qnext; qnext = __hip_atomic_fetch_add(ctl + CW_Q + 64 * (l + 4 * rep), 1u, __ATOMIC_RELAXED, __HIP_MEMORY_SCOPE_AGENT); }
                __syncthreads();
                const unsigned item = MISC[16] + (S5_STATIC ? NS5P3 : 0);
                if (item >= NS5P3 + NATT + 2 * NIT) break;
                if (item < NS5P3) { if (!S5_STATIC) { const int j = (int)item, c = j % S5_NC, gb = (j / S5_NC) & 3, b = j / (4 * S5_NC);
                    s5_chunk<3>(lds + wave * S5_WAVE_LDS, PROJ, (const float*)(ws + WS_S5T), (const float*)(ws + WS_S5T + 16384), (const bf16_t*)(ws + WS_S5T + 65536), (const bf16_t*)(ws + WS_S5T + 65536 + 262144),
                                INP(I_S5D) + l * 512, S5ST, Zb, b, gb * 8 + wave, c); } }
                else if (item < NS5P3 + NATT) { const int a_ = (int)(item - NS5P3), qb = (SEQ / 128 - 1) - a_ / (BATCH * 4), bh = a_ % (BATCH * 4); for (int dd_ = 0; dd_ < DBL_ATT; ++dd_) attn_unit(lds, biasT, PROJ, OALL, lam, lam_init, bh >> 2, bh & 3, qb); }
                else { const int j = (int)(item - NS5P3 - NATT);
                    for (int dd_ = 0; dd_ < DBL_P3; ++dd_) if (j < NIT) mlstm_chunk<3>(lds, PROJ, NAR, INP(I_MLCONV) + l * 4096, INP(I_MLGB) + l * 8, MLST2, OALL, (j / NCH) >> 2, (j / NCH) & 3, j % NCH);
                    else { const int k = j - NIT; gla_chunk<3>(lds, PROJ, NAR, INP(I_GLAWA2) + l * 4096, INP(I_GLABA) + l * 256, GLST2, OALL, (k / NCH) >> 2, (k / NCH) & 3, k % NCH); } }
                __syncthreads();
            }
        }
        SEAM(ph); ++ph;
        if (IN(ph) && PH_G2) for (int rep = 0; rep < REP_G2; ++rep) { pg8::Gemm g{Zb, (const bf16_t*)(wsw + WS_WGLU), 512, 512, 512, nullptr, nullptr}; pg8::SchedPlain S{NMT, 2, G, wg, 512 / 64}; pg8::EpiGlu E{Zb, INP(I_GLUB) + l * 512, OALL};
            pg8::gemm_phase<pg8::EpiGlu, pg8::SchedPlain, true, true>((PG8_LAS unsigned char*)lds, g, S, E); }
        SEAM(ph); ++ph;
        if (IN(ph) && PH_G4) for (int rep = 0; rep < REP_G4; ++rep) { pg8::Gemm g{Hb, (const bf16_t*)(wsw + WS_WG), DM, DM, DM, OALL, (const bf16_t*)(wsw + WS_WB)}; pg8::SchedGate S{NMT, G, wg};
            pg8::EpiGate E{INP(I_BGATE) + (size_t)l * 4 * DM, (bf16_t*)(ws + WS_GSCR) + (size_t)wg * 131072, MG};
            pg8::gemm_phase<pg8::EpiGate, pg8::SchedGate, true, true>((PG8_LAS unsigned char*)lds, g, S, E); }
        SEAM(ph); ++ph;
        if (IN(ph) && PH_G5) for (int rep = 0; rep < REP_G5; ++rep) {
#ifdef PROBE_DELAY_G5
            if (wg >= 32 && wg < 48) { const unsigned long long t0_ = __builtin_amdgcn_s_memrealtime(); while (__builtin_amdgcn_s_memrealtime() - t0_ < 40000ull) __builtin_amdgcn_s_sleep(8); }
#endif
 pg8::Gemm g{MG, (const bf16_t*)(wsw + WS_WOUT), DM, DM, DM, nullptr, nullptr}; pg8::SchedPlain S{NMT, 8, G, wg, DM / 64}; pg8::EpiPlain E{MIXB, DM, 0xffff, 0};
            pg8::gemm_phase<pg8::EpiPlain, pg8::SchedPlain, true, true>((PG8_LAS unsigned char*)lds, g, S, E); }
        SEAM(ph); ++ph;
        if (IN(ph) && PH_N2) {
#ifdef PROBE_DUP_N2
            norm_phase(lds, wg, G, l == 0 ? (const void*)INP(I_X) : (const void*)XB, l != 0, (float*)(ws + WS_P), 0, MIXB, l, 2, 1, (bf16_t*)(ws + WS_P + 256 * MiB), l, 4, 3, 2); __syncthreads();
#endif
            norm_phase(lds, wg, G, l == 0 ? (const void*)INP(I_X) : (const void*)XB, l != 0, XB, 1, MIXB, l, 2, 1, Hb, l, 4, 3, 2); }
        SEAM(ph); ++ph;
        if (IN(ph) && PH_G6) for (int rep = 0; rep < REP_G6; ++rep) { pg8::Gemm g{Hb, (const bf16_t*)(wsw + WS_WFI), DM, DM, DM, nullptr, nullptr}; pg8::SchedPlain S{NMT, 2 * FFH / 256, G, wg, DM / 64}; pg8::EpiSwiglu E{HID};
            pg8::gemm_phase<pg8::EpiSwiglu, pg8::SchedPlain, true, true>((PG8_LAS unsigned char*)lds, g, S, E); }
        SEAM(ph); ++ph;
        if (IN(ph) && PH_G7) for (int rep = 0; rep < REP_G7; ++rep) { pg8::Gemm g{HID, (const bf16_t*)(wsw + WS_WFO), FFH, FFH, FFH, nullptr, nullptr}; pg8::SchedPlain S{NMT, 8, G, wg, FFH / 64}; pg8::EpiPlain E{Yb, DM, 0xffff, 0};
            pg8::gemm_phase<pg8::EpiPlain, pg8::SchedPlain, true, true>((PG8_LAS unsigned char*)lds, g, S, E); }
        SEAM(ph); ++ph;
        if (IN(ph) && PH_N3) { norm_phase(lds, wg, G, XB, 1, (l + 1 < NLAYER) ? (void*)XB : (void*)OUTP(), (l + 1 < NLAYER), Yb, l, 5, 3, (l + 1 < NLAYER) ? Hb : nullptr, l + 1, 1, 0, 0);
            if (l + 1 < NLAYER) { constexpr int NU = NMT * (NPROJ / 256);
                if (NU % G == 0) { __syncthreads(); convert_layer(l + 1, lds, wg, G, true); }
                else { const int gtid_ = wg * 512 + OPAQUE_TID; unsigned char* ws_ = WSB();
                    if (gtid_ < 2048) s5_prep_item(gtid_, INP(I_S5ARE) + (l + 1) * 2048, INP(I_S5AIM) + (l + 1) * 2048, INP(I_S5DT) + (l + 1) * 32, INP(I_S5BRE) + (size_t)(l + 1) * 32768, INP(I_S5BIM) + (size_t)(l + 1) * 32768,
                                                   INP(I_S5CRE) + (size_t)(l + 1) * 32768, INP(I_S5CIM) + (size_t)(l + 1) * 32768, (float*)(ws_ + WS_S5T), (float*)(ws_ + WS_S5T + 16384), S5_LC, (bf16_t*)(ws_ + WS_S5T + 65536), (bf16_t*)(ws_ + WS_S5T + 65536 + 262144)); } } }
        SEAM(ph); ++ph;
    }
#undef wsw
#undef IN
#undef SEAM
#undef GRID_SYNC
#undef ws
#undef ctl
#undef Hb
#undef PROJ
#undef NAR
#undef OALL
#undef Zb
#undef Pb
#undef MG
#undef MIXB
#undef Yb
#undef HID
#undef XB
}

#ifndef ONE_LAUNCH
#define ONE_LAUNCH 1
#endif
extern "C" void kernel_launch(void* const* d_in, const int* in_sizes, int n_in, void* d_out, int out_size, void* d_ws, size_t ws_size, hipStream_t stream) {
    static int grid = 0;
    if (grid == 0) {
        if (n_in != 28 || in_sizes[0] != M_TOK * DM || out_size != M_TOK * DM || ws_size < WS_END) { fprintf(stderr, "kernel_launch: unexpected shapes/workspace (n_in %d, ws %zu < %zu)\n", n_in, ws_size, (size_t)WS_END); grid = -1; return; }
        int dev = 0, cus = 0, per_cu = 0;
        if (hipGetDevice(&dev) != hipSuccess || hipDeviceGetAttribute(&cus, hipDeviceAttributeMultiprocessorCount, dev) != hipSuccess) { grid = -1; return; }
        if (hipFuncSetAttribute((const void*)fwd_kernel, hipFuncAttributeMaxDynamicSharedMemorySize, LDS_BYTES) != hipSuccess) { fprintf(stderr, "kernel_launch: hipFuncSetAttribute failed\n"); grid = -1; return; }
        if (hipOccupancyMaxActiveBlocksPerMultiprocessor(&per_cu, (const void*)fwd_kernel, 512, LDS_BYTES) != hipSuccess || per_cu < 1) fprintf(stderr, "kernel_launch: occupancy query says %d\n", per_cu);
        (void)hipGetLastError();
        grid = cus;
        if (grid > 256) grid = 256;
    }
    if (grid < 0) return;
    if (hipMemsetAsync((char*)d_ws + WS_CTL, 0, CTL_ZERO_BYTES, stream) != hipSuccess) return;
    Args a{};
    for (int i = 0; i < 28; ++i) a.in[i] = (const float*)d_in[i];
    a.out = (float*)d_out; a.ws = (unsigned char*)d_ws;
#if ONE_LAUNCH
    a.ph_lo = 0; a.ph_hi = N_PHASES;
    hipLaunchKernelGGL(fwd_kernel, dim3(grid), dim3(512), LDS_BYTES, stream, a);
#ifdef PROBE_TWICE
    (void)hipMemsetAsync((char*)d_ws + WS_CTL, 0, CTL_ZERO_BYTES, stream);
    hipLaunchKernelGGL(fwd_kernel, dim3(grid), dim3(512), LDS_BYTES, stream, a);
#endif
#else
    for (int p = 0; p < N_PHASES; ++p) { a.ph_lo = p; a.ph_hi = p + 1; hipLaunchKernelGGL(fwd_kernel, dim3(grid), dim3(512), LDS_BYTES, stream, a); }
#endif
}
```

```cpp
#define ONE_LAUNCH 1

#include <hip/hip_runtime.h>
#include <cstdio>
#include <cstdint>
typedef unsigned short bf16_t;
typedef short bf16x8 __attribute__((ext_vector_type(8)));
typedef short s16x4 __attribute__((ext_vector_type(4)));
typedef float f32x4 __attribute__((ext_vector_type(4)));
typedef float f32x16 __attribute__((ext_vector_type(16)));
typedef unsigned u32x4 __attribute__((ext_vector_type(4)));
typedef unsigned u32x2 __attribute__((ext_vector_type(2)));

#ifdef HOST_EMU
#include <cmath>
#include <cstring>
#include <cstdint>
#include <pthread.h>
#define LAS
#define GAS
#define DEV static inline
#define GLOBAL_FN
struct EmuWave { pthread_barrier_t bar; float fa[64][8], fb[64][8]; uintptr_t addr[64]; float v[64]; };
struct EmuBlock { pthread_barrier_t bar; EmuWave wv[8]; };
extern EmuBlock* g_blk;
extern thread_local int emu_tid;
extern thread_local int emu_bid;
#define THREAD_IDX emu_tid
#define OPAQUE_TID emu_tid
DEV int opq(int x) { return x; }
#define BLOCK_IDX emu_bid
DEV void sync_threads() { pthread_barrier_wait(&g_blk->bar); }
DEV void wave_bar() { pthread_barrier_wait(&g_blk->wv[emu_tid >> 6].bar); }
DEV float bf2f(bf16_t b) { unsigned u = (unsigned)b << 16; float f; memcpy(&f, &u, 4); return f; }
DEV bf16_t f2bf(float f) { unsigned u; memcpy(&u, &f, 4); return (bf16_t)((u + 0x7fffu + ((u >> 16) & 1u)) >> 16); }
DEV f32x16 mfma32(bf16x8 a, bf16x8 b, f32x16 c) {
  EmuWave& w = g_blk->wv[emu_tid >> 6]; const int l = emu_tid & 63;
  for (int j = 0; j < 8; ++j) { w.fa[l][j] = bf2f((bf16_t)a[j]); w.fb[l][j] = bf2f((bf16_t)b[j]); }
  wave_bar();
  const int col = l & 31, hi = l >> 5;
  for (int i = 0; i < 16; ++i) { const int row = (i & 3) + 8 * (i >> 2) + 4 * hi; float s = c[i];
    for (int k = 0; k < 16; ++k) s += w.fa[row + 32 * (k >> 3)][k & 7] * w.fb[col + 32 * (k >> 3)][k & 7];
    c[i] = s; }
  wave_bar();
  return c;
}
DEV f32x4 mfma16(bf16x8 a, bf16x8 b, f32x4 c) {
  EmuWave& w = g_blk->wv[emu_tid >> 6]; const int l = emu_tid & 63;
  for (int j = 0; j < 8; ++j) { w.fa[l][j] = bf2f((bf16_t)a[j]); w.fb[l][j] = bf2f((bf16_t)b[j]); }
  wave_bar();
  const int col = l & 15, g = l >> 4;
  for (int i = 0; i < 4; ++i) { const int row = 4 * g + i; float s = c[i];
    for (int k = 0; k < 32; ++k) s += w.fa[row + 16 * (k >> 3)][k & 7] * w.fb[col + 16 * (k >> 3)][k & 7];
    c[i] = s; }
  wave_bar();
  return c;
}
DEV s16x4 lds_tr(const char* p) {
  EmuWave& w = g_blk->wv[emu_tid >> 6]; const int l = emu_tid & 63;
  w.addr[l] = (uintptr_t)p; wave_bar();
  const int g = l >> 4, i = l & 15; s16x4 r;
  for (int q = 0; q < 4; ++q) { const char* src = (const char*)w.addr[16 * g + 4 * q + (i >> 2)] + 2 * (i & 3); short s; memcpy(&s, src, 2); r[q] = s; }
  wave_bar();
  return r;
}
DEV float shfl_xor_f(float v, int m) { EmuWave& w = g_blk->wv[emu_tid >> 6]; const int l = emu_tid & 63; w.v[l] = v; wave_bar(); float r = w.v[l ^ m]; wave_bar(); return r; }
DEV float shfl_up_f(float v, int d) { EmuWave& w = g_blk->wv[emu_tid >> 6]; const int l = emu_tid & 63; w.v[l] = v; wave_bar(); float r = (l >= d) ? w.v[l - d] : v; wave_bar(); return r; }
DEV float shfl_idx_f(float v, int s) { EmuWave& w = g_blk->wv[emu_tid >> 6]; const int l = emu_tid & 63; w.v[l] = v; wave_bar(); float r = w.v[s]; wave_bar(); return r; }
DEV float fast_exp2(float x) { return exp2f(x); }
DEV float fast_rcp(float x) { return 1.0f / x; }
DEV float fast_rsq(float x) { return 1.0f / sqrtf(x); }
DEV int rfl(int x) { return x; }
DEV void wave_sync() { wave_bar(); }
DEV bool wave_any(bool v) { EmuWave& w = g_blk->wv[emu_tid >> 6]; const int l = emu_tid & 63; w.v[l] = v ? 1.f : 0.f; wave_bar(); bool r = false; for (int i = 0; i < 64; ++i) r |= (w.v[i] != 0.f); wave_bar(); return r; }
DEV void sched_fence() {}
DEV void lds_dma16(const void* g, char* l) { memcpy(l + 16 * (emu_tid & 63), g, 16); }
#define WAIT_VM(n) do {} while (0)
DEV void raw_barrier() { sync_threads(); }
DEV const char* uptr(const void* q) { return (const char*)q; }
DEV void st_wt2(float* p_, float a, float b) { p_[0] = a; p_[1] = b; }
DEV void ld_wt2(const float* p_, float& a, float& b) { a = p_[0]; b = p_[1]; }
DEV void st_wt1(float* p_, float a) { p_[0] = a; }
DEV float ld_wt1(const float* p_) { return p_[0]; }
#define __expf expf
#else
#include <hip/hip_runtime.h>
#define LAS __attribute__((address_space(3)))
#define GAS __attribute__((address_space(1)))
#define DEV __device__ __forceinline__
#define THREAD_IDX ((int)threadIdx.x)
DEV int opaque_tid_() { int t = (int)threadIdx.x; asm volatile("" : "+v"(t)); return t; }
#define OPAQUE_TID opaque_tid_()
DEV int opq(int x) { asm volatile("" : "+v"(x)); return x; }
#define BLOCK_IDX ((int)blockIdx.x)
DEV void sync_threads() { __syncthreads(); }
DEV float bf2f(bf16_t b) { return __uint_as_float((unsigned)b << 16); }
DEV bf16_t f2bf(float f) { unsigned u = __float_as_uint(f); return (bf16_t)((u + 0x7fffu + ((u >> 16) & 1u)) >> 16); }
DEV f32x16 mfma32(bf16x8 a, bf16x8 b, f32x16 c) { return __builtin_amdgcn_mfma_f32_32x32x16_bf16(a, b, c, 0, 0, 0); }
DEV f32x4 mfma16(bf16x8 a, bf16x8 b, f32x4 c) { return __builtin_amdgcn_mfma_f32_16x16x32_bf16(a, b, c, 0, 0, 0); }
typedef short v4i16_t __attribute__((ext_vector_type(4)));
DEV s16x4 lds_tr(const LAS char* p) { return __builtin_bit_cast(s16x4, __builtin_amdgcn_ds_read_tr16_b64_v4i16((LAS v4i16_t*)p)); }
DEV float shfl_xor_f(float v, int m) { return __shfl_xor(v, m); }
DEV float shfl_up_f(float v, int d) { return __shfl_up(v, d); }
DEV float shfl_idx_f(float v, int s) { return __shfl(v, s); }
DEV float fast_exp2(float x) { return __builtin_amdgcn_exp2f(x); }
DEV float fast_rcp(float x) { return __builtin_amdgcn_rcpf(x); }
DEV float fast_rsq(float x) { return __builtin_amdgcn_rsqf(x); }
DEV int rfl(int x) { return __builtin_amdgcn_readfirstlane(x); }
DEV void wave_sync() { asm volatile("s_waitcnt lgkmcnt(0)" ::: "memory"); }
DEV bool wave_any(bool v) { return __any(v); }
DEV void sched_fence() { __builtin_amdgcn_sched_barrier(0); }
DEV void lds_dma16(const GAS void* g, LAS char* l) { __builtin_amdgcn_global_load_lds((const GAS unsigned*)g, (LAS unsigned*)l, 16, 0, 0); }
#define WAIT_VM(n) asm volatile("s_waitcnt vmcnt(" #n ")" ::: "memory")
DEV void raw_barrier() { asm volatile("s_waitcnt lgkmcnt(0)" ::: "memory"); __builtin_amdgcn_s_barrier(); asm volatile("" ::: "memory"); }
DEV void st_wt2(float* p_, float a, float b) { __hip_atomic_store((unsigned long long*)p_, ((unsigned long long)__float_as_uint(b) << 32) | __float_as_uint(a), __ATOMIC_RELAXED, __HIP_MEMORY_SCOPE_AGENT); }
DEV void ld_wt2(const float* p_, float& a, float& b) { const unsigned long long v = __hip_atomic_load((unsigned long long*)p_, __ATOMIC_RELAXED, __HIP_MEMORY_SCOPE_AGENT); a = __uint_as_float((unsigned)v); b = __uint_as_float((unsigned)(v >> 32)); }
DEV void st_wt1(float* p_, float a) { __hip_atomic_store((unsigned*)p_, __float_as_uint(a), __ATOMIC_RELAXED, __HIP_MEMORY_SCOPE_AGENT); }
DEV float ld_wt1(const float* p_) { return __uint_as_float(__hip_atomic_load((unsigned*)p_, __ATOMIC_RELAXED, __HIP_MEMORY_SCOPE_AGENT)); }
DEV const GAS char* uptr(const void* q) { const unsigned long long v = (unsigned long long)q; const unsigned lo = __builtin_amdgcn_readfirstlane((unsigned)v), hi = __builtin_amdgcn_readfirstlane((unsigned)(v >> 32)); return (const GAS char*)(((unsigned long long)hi << 32) | lo); }
#endif
typedef LAS char* LDSP;
#ifdef HOST_EMU
DEV unsigned pk2(float lo, float hi) { return (unsigned)f2bf(lo) | ((unsigned)f2bf(hi) << 16); }
#else
typedef float f32x2_t_ __attribute__((ext_vector_type(2))); typedef __bf16 bf16x2_t_ __attribute__((ext_vector_type(2)));
DEV unsigned pk2(float lo, float hi) { const f32x2_t_ v = {lo, hi}; const bf16x2_t_ b = __builtin_convertvector(v, bf16x2_t_); return __builtin_bit_cast(unsigned, b); }
#endif
DEV int crow(int i, int hi) { return (i & 3) + 8 * (i >> 2) + 4 * hi; }
DEV unsigned offb(unsigned row, unsigned ch) { return 256u * row + 16u * (ch ^ (((row & 3u) << 2) | ((row >> 2) & 3u))); }
DEV bf16x8 lds_ld8(LDSP p) { return *(const LAS bf16x8*)p; }
DEV bf16x8 frag_row(LDSP tile, int rb, int ks, int lane) { return lds_ld8(tile + offb(rb + (lane & 31), 2 * ks + (lane >> 5))); }
DEV bf16x8 frag_tr(LDSP tile, int cb, int ks, int lane, bool perm) {
  const int h2 = lane >> 5, blk = (lane >> 4) & 1, q = (lane & 15) >> 2, p = lane & 3;
  const int r0 = perm ? (16 * ks + 4 * h2) : (16 * ks + 8 * h2), dr = perm ? 8 : 4;
  const unsigned ch = 4 * cb + 2 * blk + (p >> 1), bo = 8 * (p & 1);
  const s16x4 a = lds_tr(tile + offb(r0 + q, ch) + bo), b = lds_tr(tile + offb(r0 + dr + q, ch) + bo);
  return (bf16x8){a[0], a[1], a[2], a[3], b[0], b[1], b[2], b[3]};
}
DEV bf16x8 acc_frag(const f32x16& x, int s) {
  u32x4 w; w.x = pk2(x[8 * s + 0], x[8 * s + 1]); w.y = pk2(x[8 * s + 2], x[8 * s + 3]); w.z = pk2(x[8 * s + 4], x[8 * s + 5]); w.w = pk2(x[8 * s + 6], x[8 * s + 7]);
  return __builtin_bit_cast(bf16x8, w);
}
#ifndef SEQ
#define SEQ 8192
#endif
#ifndef BATCH
#define BATCH 4
#endif
constexpr int M_TOK = BATCH * SEQ, PW = 5632, OW = 2048, NCH = SEQ / 64;
constexpr int C_DAQ = 0, C_DAK = 512, C_DAV = 1024, C_MLQ = 1536, C_MLK = 2048, C_MLV = 2560, C_MLO = 3072, C_GLQ = 3584, C_GLK = 3840, C_GLV = 4096, C_GLR = 4608, C_S5U = 5120;
constexpr int NW_MLI = 0, NW_MLF = 4, NW_GLA = 8, NWP = 32;
constexpr float LOG2E = 1.4426950408889634f, RMS_EPS = 1e-6f;
#define NEG_INF (-__builtin_inff())

DEV float sigmoidf_(float x) { return fast_rcp(1.0f + fast_exp2(-x * LOG2E)); }
DEV float log_sigmoidf_(float x) {
  const float ax = x < 0.f ? -x : x; return (x < 0.f ? x : 0.f) - log1pf(__expf(-ax)); }
DEV float wave_sum_f(float v) { for (int o = 1; o < 64; o <<= 1) v += shfl_xor_f(v, o); return v; }

DEV void attn_unit(LDSP lds, const LAS float* biasT, const bf16_t* __restrict__ proj, bf16_t* __restrict__ oall, float lam, float lam_init, int b, int h, int qb) {
  const int tid = OPAQUE_TID, lane = tid & 63, wave = rfl(tid >> 6), l31 = lane & 31, h2 = lane >> 5;
  const int mp = wave >> 2, wq = wave & 3, q0 = qb * 128, r0 = q0 + 32 * wq;
  const size_t rowbase = (size_t)b * SEQ;
  bf16x8 qf[4];
  { const bf16_t* qp = proj + (rowbase + r0 + l31) * PW + C_DAQ + h * 128 + mp * 64 + 8 * h2;
#pragma unroll
    for (int ks = 0; ks < 4; ++ks) qf[ks] = *(const bf16x8*)(qp + 16 * ks); }
  f32x16 o[4];
#pragma unroll
  for (int c = 0; c < 4; ++c)
#pragma unroll
    for (int i = 0; i < 16; ++i) o[c][i] = 0.f;
  float mrun = 0.f, lpart = 0.f;
  const int nt = 2 * qb + 2, tlast = (r0 + 31) >> 6;
  const float THR = 8.0f;
  const LAS float* bt = biasT + h * 128;
  const float bfar = bt[127];
  unsigned koff[4], vb[2][4];
  { const int blk = (lane >> 4) & 1, q = (lane & 15) >> 2, p = lane & 3;
#pragma unroll
    for (int ks = 0; ks < 4; ++ks) koff[ks] = offb(l31, 8 * mp + 2 * ks + h2);
#pragma unroll
    for (int tt = 0; tt < 2; ++tt)
#pragma unroll
      for (int c = 0; c < 4; ++c) vb[tt][c] = 256u * (8 * tt + 4 * h2 + q) + 16u * ((2 * blk + (p >> 1)) ^ ((2 * tt + h2) & 3)) + 8u * (p & 1) + 64u * (c ^ q); }
  u32x4 rk[2], rv[2];
  const GAS char* gk = uptr(proj + rowbase * PW + C_DAK + h * 128); const unsigned goff = (unsigned)((tid >> 4) * PW + (tid & 15) * 8) * 2u, soff = offb(tid >> 4, tid & 15);
#define ATT_LOAD(t) do { _Pragma("unroll") for (int i = 0; i < 2; ++i) { const unsigned o_ = goff + (unsigned)((64 * (t) + 32 * i) * PW) * 2u; \
    rk[i] = *(const GAS u32x4*)(gk + o_); rv[i] = *(const GAS u32x4*)(gk + o_ + (C_DAV - C_DAK) * 2); } } while (0)
#define ATT_STORE(buf) do { _Pragma("unroll") for (int i = 0; i < 2; ++i) { \
    *(LAS u32x4*)(lds + (buf) * 16384 + soff + 8192 * i) = rk[i]; *(LAS u32x4*)(lds + 32768 + (buf) * 16384 + soff + 8192 * i) = rv[i]; } } while (0)
  ATT_LOAD(0); ATT_STORE(0); sync_threads();
  for (int t = 0; t < nt; ++t) {
    if (t + 1 < nt) ATT_LOAD(t + 1);
    if (t <= tlast) {
      LDSP Kt = lds + (t & 1) * 16384, Vt = lds + 32768 + (t & 1) * 16384;
      const int qabs = r0 + l31, j0 = 64 * t;
      const bool far = (r0 - (j0 + 63)) >= 127;
      const float cinit = (far ? bfar : 0.f) - mrun;
      f32x16 p[2];
#pragma unroll
      for (int kb = 0; kb < 2; ++kb) {
#pragma unroll
        for (int i = 0; i < 16; ++i) p[kb][i] = cinit;
#pragma unroll
        for (int ks = 0; ks < 4; ++ks) p[kb] = mfma32(lds_ld8(Kt + koff[ks] + 8192 * kb), qf[ks], p[kb]);
      }
      float mx = NEG_INF;
      if (far) {
#pragma unroll
        for (int kb = 0; kb < 2; ++kb)
#pragma unroll
          for (int i = 0; i < 16; i += 2) mx = fmaxf(fmaxf(mx, p[kb][i]), p[kb][i + 1]);
      } else {
#pragma unroll
        for (int kb = 0; kb < 2; ++kb)
#pragma unroll
          for (int i = 0; i < 16; ++i) {
            const int dist = qabs - (j0 + 32 * kb + crow(i, h2));
            float s = p[kb][i] + bt[dist < 0 ? 0 : (dist > 127 ? 127 : dist)]; if (dist < 0) s = NEG_INF;
            p[kb][i] = s; mx = fmaxf(mx, s);
          }
      }
      mx = fmaxf(mx, shfl_xor_f(mx, 32));
      if (__builtin_expect(wave_any(mx > THR) || t == 0, 0)) {
        const float delta = (mx > THR || t == 0) ? mx : 0.f, alpha = fast_exp2(-delta);
        mrun += delta; lpart *= alpha;
#pragma unroll
        for (int c = 0; c < 4; ++c)
#pragma unroll
          for (int i = 0; i < 16; ++i) o[c][i] *= alpha;
#pragma unroll
        for (int kb = 0; kb < 2; ++kb)
#pragma unroll
          for (int i = 0; i < 16; ++i) p[kb][i] -= delta;
      }
      float rs = 0.f;
#pragma unroll
      for (int kb = 0; kb < 2; ++kb)
#pragma unroll
        for (int i = 0; i < 16; ++i) { const float e = fast_exp2(p[kb][i]); p[kb][i] = e; rs += e; }
      lpart += rs;
#pragma unroll
      for (int ks = 0; ks < 4; ++ks) {
        const bf16x8 pf = acc_frag(p[ks >> 1], ks & 1);
#pragma unroll
        for (int c = 0; c < 4; ++c) { const s16x4 va = lds_tr(Vt + vb[0][c] + 4096 * ks), vc = lds_tr(Vt + vb[1][c] + 4096 * ks);
          o[c] = mfma32((bf16x8){va[0], va[1], va[2], va[3], vc[0], vc[1], vc[2], vc[3]}, pf, o[c]); }
      }
    }
    if (t + 1 < nt) ATT_STORE((t + 1) & 1);
    sync_threads();
  }
#undef ATT_LOAD
#undef ATT_STORE
  { const float ltot = lpart + shfl_xor_f(lpart, 32), inv = 1.0f / ltot;
#pragma unroll
    for (int c = 0; c < 4; ++c)
#pragma unroll
      for (int i = 0; i < 16; ++i) o[c][i] *= inv; }
  LAS float* X = (LAS float*)lds;
  if (mp == 1) {
#pragma unroll
    for (int c = 0; c < 4; ++c)
#pragma unroll
      for (int i = 0; i < 16; ++i) X[((wq * 4 + c) * 16 + i) * 64 + lane] = o[c][i];
  }
  sync_threads();
  if (mp == 0) {
    float ss = 0.f;
#pragma unroll
    for (int c = 0; c < 4; ++c)
#pragma unroll
      for (int i = 0; i < 16; ++i) { const float d = o[c][i] - lam * X[((wq * 4 + c) * 16 + i) * 64 + lane]; o[c][i] = d; ss += d * d; }
    ss += shfl_xor_f(ss, 32);
    const float r = (1.0f - lam_init) / sqrtf(ss * (1.0f / 128.0f) + RMS_EPS);
    bf16_t* op = oall + (rowbase + r0 + l31) * OW + 0 + h * 128 + 4 * h2;
#pragma unroll
    for (int c = 0; c < 4; ++c)
#pragma unroll
      for (int g = 0; g < 4; ++g) { u32x2 w; w.x = pk2(o[c][4 * g] * r, o[c][4 * g + 1] * r); w.y = pk2(o[c][4 * g + 2] * r, o[c][4 * g + 3] * r);
        *(u32x2*)(op + 32 * c + 8 * g) = w; }
  }
  sync_threads();
}

DEV void mlstm_item(LDSP lds, const bf16_t* __restrict__ proj, const float* __restrict__ narrow, const float* __restrict__ convw  , const float* __restrict__ gateb  ,
                    bf16_t* __restrict__ oall, int b, int h) {
  const int tid0 = OPAQUE_TID, wave = rfl(tid0 >> 6);
#define ML_LANES() const int tid = opq(tid0), lane = tid & 63, l31 = lane & 31, h2 = lane >> 5; (void)l31; (void)h2; (void)lane
  LDSP Qt = lds, Kt = lds + 16384, Vt = lds + 32768, KWt = lds + 49152, Ct = lds + 65536;
  LAS float* F = (LAS float*)(lds + 106496);
  LAS float *U = F, *Mv = F + 64, *AT = F + 128, *EM = F + 192, *WJ = F + 256, *QN = F + 320, *SC = F + 384, *NV = F + 392, *CW = F + 520;
  const size_t rowbase = (size_t)b * SEQ;
  { ML_LANES();
    for (int i = tid; i < 40960 / 4; i += 512) ((LAS unsigned*)Ct)[i] = 0u;
    if (tid < 128) NV[tid] = 0.f;
    for (int i = tid; i < 1024; i += 512) { const int j = i >> 8, r = i & 255; CW[i] = convw[j * 1024 + (r >> 7) * 512 + h * 128 + (r & 127)]; }
  }
  const float gb0 = gateb[h], gb1 = gateb[4 + h];
  f32x16 cst[2];
#pragma unroll
  for (int x = 0; x < 2; ++x)
#pragma unroll
    for (int i = 0; i < 16; ++i) cst[x][i] = 0.f;
  float mprev = 0.f;
  const int eb = wave & 3, tb = wave >> 2;
  bf16x8 rqk[11]; u32x4 rvv[4]; float rig = 0.f, rfg = 0.f;
#define ML_PREFETCH(chn) do { ML_LANES(); const size_t t0n = rowbase + (size_t)(chn) * 64; const GAS char* pb = uptr(proj + (t0n - 3) * PW); \
    if (tid < 256) { const int which = (tid >> 7) & 1, dch = tid & 15, tg = (tid & 127) >> 4; unsigned voff = (unsigned)((tg * 8) * PW + (which ? C_MLK : C_MLQ) + h * 128 + dch * 8) * 2u; \
      _Pragma("unroll") for (int r = 0; r < 11; ++r) { bf16x8 v = (bf16x8){0, 0, 0, 0, 0, 0, 0, 0}; if ((chn) * 64 + tg * 8 - 3 + r >= 0) v = *(const GAS bf16x8*)(pb + voff); rqk[r] = v; voff += PW * 2; } } \
    else { const int t2 = tid - 256; _Pragma("unroll") for (int i = 0; i < 4; ++i) { const int id = t2 + 256 * i, row = id >> 4, c16 = id & 15; rvv[i] = *(const GAS u32x4*)(pb + (unsigned)((row + 3) * PW + C_MLV + h * 128 + c16 * 8) * 2u); } } \
    if (wave == 0) { const GAS char* nb = uptr(narrow + t0n * NWP); rig = *(const GAS float*)(nb + (unsigned)(lane * NWP + NW_MLI + h) * 4u); rfg = *(const GAS float*)(nb + (unsigned)(lane * NWP + NW_MLF + h) * 4u); } } while (0)
  ML_PREFETCH(0);
  sync_threads();
  for (int ch = 0; ch < NCH; ++ch) {
    const size_t t0 = rowbase + (size_t)ch * 64;
    const GAS char* pbase = uptr(proj + (t0 - 3) * PW);
    { ML_LANES();
      if (tid < 256) {
        const int which = (tid >> 7) & 1, dch = tid & 15, tg = (tid & 127) >> 4;
        float cw[4][8];
#pragma unroll
        for (int j = 0; j < 4; ++j) { const f32x4 a = *(const LAS f32x4*)(CW + j * 256 + which * 128 + dch * 8), c = *(const LAS f32x4*)(CW + j * 256 + which * 128 + dch * 8 + 4);
          cw[j][0] = a[0]; cw[j][1] = a[1]; cw[j][2] = a[2]; cw[j][3] = a[3]; cw[j][4] = c[0]; cw[j][5] = c[1]; cw[j][6] = c[2]; cw[j][7] = c[3]; }
        float win[3][8];
#pragma unroll
        for (int r = 0; r < 3; ++r)
#pragma unroll
          for (int d = 0; d < 8; ++d) win[r][d] = bf2f((bf16_t)rqk[r][d]);
        const float osc = which ? 0.08838834764831845f : 1.0f;
        LDSP dstT = which ? Kt : Qt;
#pragma unroll
        for (int r = 0; r < 8; ++r) {
          float cur[8], y[8];
#pragma unroll
          for (int d = 0; d < 8; ++d) { cur[d] = bf2f((bf16_t)rqk[3 + r][d]); const float a = cw[0][d] * win[0][d] + cw[1][d] * win[1][d] + cw[2][d] * win[2][d] + cw[3][d] * cur[d];
            y[d] = a * sigmoidf_(a) * osc; win[0][d] = win[1][d]; win[1][d] = win[2][d]; win[2][d] = cur[d]; }
          u32x4 w; w.x = pk2(y[0], y[1]); w.y = pk2(y[2], y[3]); w.z = pk2(y[4], y[5]); w.w = pk2(y[6], y[7]);
          *(LAS u32x4*)(dstT + offb(tg * 8 + r, dch)) = w;
        }
      } else {
        const int t2 = tid - 256;
#pragma unroll
        for (int i = 0; i < 4; ++i) { const int id = t2 + 256 * i, row = id >> 4, c16 = id & 15; *(LAS u32x4*)(Vt + offb(row, c16)) = rvv[i]; }
      }
      if (wave == 0) {
        const float ig = rig + gb0;
        const float lf = log_sigmoidf_(rfg + gb1);
        float bsum = lf;
#pragma unroll
        for (int d = 1; d < 64; d <<= 1) { const float o_ = shfl_up_f(bsum, d); if (lane >= d) bsum += o_; }
        const float u = ig - bsum; float pm = u;
#pragma unroll
        for (int d = 1; d < 64; d <<= 1) { const float o_ = shfl_up_f(pm, d); if (lane >= d) pm = fmaxf(pm, o_); }
        const float Mt = fmaxf(mprev, pm);
        const float Mlast = shfl_idx_f(Mt, 63), blast = shfl_idx_f(bsum, 63);
        U[lane] = u; Mv[lane] = Mt; AT[lane] = __expf(mprev - Mt); EM[lane] = __expf(-(bsum + Mt)); WJ[lane] = __expf(u - Mlast);
        if (lane == 0) SC[0] = __expf(mprev - Mlast);
        mprev = blast + Mlast;
      }
    }
    if (ch + 1 < NCH) ML_PREFETCH(ch + 1);
    sync_threads();
    { ML_LANES();
#pragma unroll
      for (int i = 0; i < 2; ++i) { const int id = tid + 512 * i, row = id >> 4, c16 = id & 15; const float wj = WJ[row];
        const bf16x8 v = lds_ld8(Kt + offb(row, c16)); u32x4 w;
        w.x = pk2(bf2f((bf16_t)v[0]) * wj, bf2f((bf16_t)v[1]) * wj); w.y = pk2(bf2f((bf16_t)v[2]) * wj, bf2f((bf16_t)v[3]) * wj);
        w.z = pk2(bf2f((bf16_t)v[4]) * wj, bf2f((bf16_t)v[5]) * wj); w.w = pk2(bf2f((bf16_t)v[6]) * wj, bf2f((bf16_t)v[7]) * wj);
        *(LAS u32x4*)(KWt + offb(row, c16)) = w; }
    }
    sync_threads();
    if (eb == 0) {
      ML_LANES();
      f32x16 qn;
#pragma unroll
      for (int i = 0; i < 16; ++i) qn[i] = 0.f;
#pragma unroll
      for (int ks = 0; ks < 8; ++ks) qn = mfma32(frag_row(Ct, 128, ks, lane), frag_row(Qt, 32 * tb, ks, lane), qn);
      if (h2 == 0) QN[32 * tb + l31] = qn[0];
    }
    f32x16 acc;
    { ML_LANES();
#pragma unroll
      for (int i = 0; i < 16; ++i) acc[i] = 0.f;
#pragma unroll
      for (int ks = 0; ks < 8; ++ks) acc = mfma32(frag_row(Ct, 32 * eb, ks, lane), frag_row(Qt, 32 * tb, ks, lane), acc);
    }
    float rsum = 0.f;
#pragma unroll
    for (int jb = 0; jb < 2; ++jb) {
      if (jb <= tb) {
        ML_LANES();
        const int tl = 32 * tb + l31; const float Mt = Mv[tl];
        if (jb == 0) { const float at = AT[tl];
#pragma unroll
          for (int i = 0; i < 16; ++i) acc[i] *= at; }
        f32x16 s;
#pragma unroll
        for (int i = 0; i < 16; ++i) s[i] = 0.f;
#pragma unroll
        for (int ks = 0; ks < 8; ++ks) s = mfma32(frag_row(Kt, 32 * jb, ks, lane), frag_row(Qt, 32 * tb, ks, lane), s);
#pragma unroll
        for (int i = 0; i < 16; ++i) { const int j = 32 * jb + crow(i, h2); const float w = (j <= tl) ? __expf(U[j] - Mt) : 0.f; s[i] *= w; rsum += s[i]; }
#pragma unroll
        for (int s2 = 0; s2 < 2; ++s2) acc = mfma32(frag_tr(Vt, eb, 2 * jb + s2, lane, true), acc_frag(s, s2), acc);
      }
    }
    rsum += shfl_xor_f(rsum, 32);
    sync_threads();
    { ML_LANES();
      const int tl = 32 * tb + l31;
      const float den = AT[tl] * QN[tl] + rsum; const float dd = fmaxf(fabsf(den), EM[tl]); const float inv = 1.0f / dd;
      const GAS char* og = pbase + (unsigned)((tl + 3) * PW + C_MLO + h * 128 + 32 * eb + 4 * h2) * 2u; GAS char* op = (GAS char*)uptr(oall + t0 * OW) + (unsigned)(tl * OW + 512 + h * 128 + 32 * eb + 4 * h2) * 2u;
#pragma unroll
      for (int g = 0; g < 4; ++g) { const u32x2 gv2 = *(const GAS u32x2*)(og + 16 * g);
        const float g0 = sigmoidf_(bf2f((bf16_t)(gv2.x & 0xffff))), g1 = sigmoidf_(bf2f((bf16_t)(gv2.x >> 16))), g2 = sigmoidf_(bf2f((bf16_t)(gv2.y & 0xffff))), g3 = sigmoidf_(bf2f((bf16_t)(gv2.y >> 16)));
        u32x2 w; w.x = pk2(acc[4 * g] * inv * g0, acc[4 * g + 1] * inv * g1); w.y = pk2(acc[4 * g + 2] * inv * g2, acc[4 * g + 3] * inv * g3);
        *(GAS u32x2*)(op + 16 * g) = w; }
    }
    { ML_LANES();
      const float ast = SC[0]; const int db = wave >> 1;
#pragma unroll
      for (int x = 0; x < 2; ++x)
#pragma unroll
        for (int i = 0; i < 16; ++i) cst[x][i] *= ast;
#pragma unroll
      for (int ks = 0; ks < 4; ++ks) { const bf16x8 af = frag_tr(KWt, db, ks, lane, false);
#pragma unroll
        for (int x = 0; x < 2; ++x) cst[x] = mfma32(af, frag_tr(Vt, 2 * (wave & 1) + x, ks, lane, false), cst[x]); }
#pragma unroll
      for (int x = 0; x < 2; ++x) { const int e = 32 * (2 * (wave & 1) + x) + l31;
#pragma unroll
        for (int g = 0; g < 4; ++g) { const int d = 32 * db + 8 * g + 4 * h2; u32x2 w; w.x = pk2(cst[x][4 * g], cst[x][4 * g + 1]); w.y = pk2(cst[x][4 * g + 2], cst[x][4 * g + 3]);
          *(LAS u32x2*)(Ct + offb(e, d >> 3) + (d & 7) * 2) = w; } }
    }
    if ((wave & 1) == 0) {
      ML_LANES(); const int db = wave >> 1; const float ast = SC[0];
      const bf16x8 ones = (bf16x8){0x3f80, 0x3f80, 0x3f80, 0x3f80, 0x3f80, 0x3f80, 0x3f80, 0x3f80};
      f32x16 cs;
#pragma unroll
      for (int i = 0; i < 16; ++i) cs[i] = 0.f;
#pragma unroll
      for (int ks = 0; ks < 4; ++ks) cs = mfma32(frag_tr(KWt, db, ks, lane, false), ones, cs);
      if (l31 == 0) {
#pragma unroll
        for (int i = 0; i < 16; ++i) { const int d = 32 * db + crow(i, h2); const float nn = ast * NV[d] + cs[i]; NV[d] = nn; *(LAS bf16_t*)(Ct + offb(128, d >> 3) + (d & 7) * 2) = f2bf(nn); } }
    }
    sync_threads();
  }
#undef ML_LANES
#undef ML_PREFETCH
}

constexpr int ST_PITCH = 144;
DEV void gla_item(LDSP lds, const bf16_t* __restrict__ proj, const float* __restrict__ narrow, const float* __restrict__ wa2  , const float* __restrict__ ba  ,
                  bf16_t* __restrict__ oall, int b, int h) {
  const int tid = OPAQUE_TID, lane = tid & 63, wave = rfl(tid >> 6), l31 = lane & 31, h2 = lane >> 5;
  LDSP QKt = lds, KWt = lds + 16384, Vt = lds + 32768, St = lds + 49152;
  LAS float* F = (LAS float*)(lds + 69632);
  LAS float *GA = F, *TOT = F + 1024, *EL = F + 1536, *SS = F + 1600;
  const size_t rowbase = (size_t)b * SEQ;
  for (int i = tid; i < 128 * ST_PITCH / 4; i += 512) ((LAS unsigned*)St)[i] = 0u;
  for (int i = tid; i < 16384 / 4; i += 512) ((LAS unsigned*)KWt)[i] = 0u;
  const int d = tid & 63, tg = tid >> 6;
  float wcol[16];
#pragma unroll
  for (int r = 0; r < 16; ++r) wcol[r] = wa2[r * 256 + h * 64 + d];
  const float bad = ba[h * 64 + d];
  f32x16 sst;
#pragma unroll
  for (int i = 0; i < 16; ++i) sst[i] = 0.f;
  const int eb = wave & 3, tb = wave >> 2;
  float rga[2]; u32x4 rvv[2]; bf16_t rq[8], rk[8];
#define GLA_PREFETCH(chn) do { const size_t t0n = rowbase + (size_t)(chn) * 64; const GAS char* pb = uptr(proj + t0n * PW); const GAS char* nb = uptr(narrow + t0n * NWP); \
    { const int id = tid * 2, row = id >> 4, c = id & 15; const GAS float* gp = (const GAS float*)(nb + (unsigned)(row * NWP + NW_GLA + c) * 4u); rga[0] = gp[0]; rga[1] = gp[1]; } \
    _Pragma("unroll") for (int i = 0; i < 2; ++i) { const int id = tid + 512 * i, row = id >> 4, c16 = id & 15; rvv[i] = *(const GAS u32x4*)(pb + (unsigned)(row * PW + C_GLV + h * 128 + c16 * 8) * 2u); } \
    _Pragma("unroll") for (int r = 0; r < 8; ++r) { const unsigned o = (unsigned)((8 * tg + r) * PW + h * 64 + d) * 2u; rq[r] = *(const GAS bf16_t*)(pb + o + C_GLQ * 2); rk[r] = *(const GAS bf16_t*)(pb + o + C_GLK * 2); } } while (0)
  GLA_PREFETCH(0);
  sync_threads();
  for (int ch = 0; ch < NCH; ++ch) {
    const size_t t0 = rowbase + (size_t)ch * 64;
    { const int id = tid * 2; GA[id] = rga[0]; GA[id + 1] = rga[1]; }
#pragma unroll
    for (int i = 0; i < 2; ++i) { const int id = tid + 512 * i, row = id >> 4, c16 = id & 15; *(LAS u32x4*)(Vt + offb(row, c16)) = rvv[i]; }
    float qraw[8], kraw8[8];
#pragma unroll
    for (int r = 0; r < 8; ++r) { qraw[r] = bf2f(rq[r]); kraw8[r] = bf2f(rk[r]); }
    if (ch + 1 < NCH) GLA_PREFETCH(ch + 1);
    sync_threads();
    float bc[8], tot = 0.f;
#pragma unroll
    for (int r = 0; r < 8; ++r) { const int t = 8 * tg + r; float z = bad;
#pragma unroll
      for (int k = 0; k < 16; ++k) z += GA[t * 16 + k] * wcol[k];
      tot += log_sigmoidf_(z) * 0.0625f; bc[r] = tot; }
    TOT[tg * 64 + d] = tot;
    sync_threads();
    float off = 0.f, last = 0.f;
#pragma unroll
    for (int g = 0; g < 8; ++g) { const float v = TOT[g * 64 + d]; if (g < tg) off += v; last += v; }
    if (tg == 0) EL[d] = __expf(last);
#pragma unroll
    for (int r = 0; r < 8; ++r) { const int t = 8 * tg + r; const float bcv = bc[r] + off;
      const float qv = qraw[r] * 0.125f * __expf(bcv);
      const float kraw = kraw8[r];
      *(LAS bf16_t*)(QKt + offb(t, d >> 3) + (d & 7) * 2) = f2bf(qv);
      *(LAS bf16_t*)(QKt + offb(t, 8 + (d >> 3)) + (d & 7) * 2) = f2bf(kraw * __expf(-bcv));
      *(LAS bf16_t*)(KWt + offb(t, d >> 3) + (d & 7) * 2) = f2bf(kraw * __expf(last - bcv)); }
    sync_threads();
    f32x16 acc;
#pragma unroll
    for (int i = 0; i < 16; ++i) acc[i] = 0.f;
#pragma unroll
    for (int ks = 0; ks < 4; ++ks) acc = mfma32(lds_ld8(St + (32 * eb + l31) * ST_PITCH + (16 * ks + 8 * h2) * 2), frag_row(QKt, 32 * tb, ks, lane), acc);
    const int tl = 32 * tb + l31;
#pragma unroll
    for (int jb = 0; jb < 2; ++jb) {
      if (jb <= tb) {
        f32x16 s;
#pragma unroll
        for (int i = 0; i < 16; ++i) s[i] = 0.f;
#pragma unroll
        for (int ks = 0; ks < 4; ++ks) s = mfma32(frag_row(QKt, 32 * jb, 4 + ks, lane), frag_row(QKt, 32 * tb, ks, lane), s);
#pragma unroll
        for (int i = 0; i < 16; ++i) { const int j = 32 * jb + crow(i, h2); if (j > tl) s[i] = 0.f; }
#pragma unroll
        for (int s2 = 0; s2 < 2; ++s2) acc = mfma32(frag_tr(Vt, eb, 2 * jb + s2, lane, true), acc_frag(s, s2), acc);
      }
    }
    float ss = 0.f;
#pragma unroll
    for (int i = 0; i < 16; ++i) ss += acc[i] * acc[i];
    ss += shfl_xor_f(ss, 32);
    if (h2 == 0) SS[eb * 64 + tl] = ss;
    sync_threads();
    {
      const float tot2 = SS[tl] + SS[64 + tl] + SS[128 + tl] + SS[192 + tl]; const float r = 1.0f / sqrtf(tot2 * (1.0f / 128.0f) + RMS_EPS);
      const size_t row = t0 + tl; const bf16_t* gr = proj + row * PW + C_GLR + h * 128 + 32 * eb + 4 * h2; bf16_t* op = oall + row * OW + 1024 + h * 128 + 32 * eb + 4 * h2;
#pragma unroll
      for (int g = 0; g < 4; ++g) { const u32x2 gv2 = *(const u32x2*)(gr + 8 * g);
        const float r0 = bf2f((bf16_t)(gv2.x & 0xffff)), r1 = bf2f((bf16_t)(gv2.x >> 16)), r2 = bf2f((bf16_t)(gv2.y & 0xffff)), r3 = bf2f((bf16_t)(gv2.y >> 16));
        u32x2 w; w.x = pk2(acc[4 * g] * r * r0 * sigmoidf_(r0), acc[4 * g + 1] * r * r1 * sigmoidf_(r1)); w.y = pk2(acc[4 * g + 2] * r * r2 * sigmoidf_(r2), acc[4 * g + 3] * r * r3 * sigmoidf_(r3));
        *(u32x2*)(op + 8 * g) = w; }
    }
    { const int db = wave >> 2;
#pragma unroll
      for (int i = 0; i < 16; ++i) sst[i] *= EL[32 * db + crow(i, h2)];
#pragma unroll
      for (int ks = 0; ks < 4; ++ks) sst = mfma32(frag_tr(KWt, db, ks, lane, false), frag_tr(Vt, eb, ks, lane, false), sst);
      const int e = 32 * eb + l31;
#pragma unroll
      for (int g = 0; g < 4; ++g) { const int dd = 32 * db + 8 * g + 4 * h2; u32x2 w; w.x = pk2(sst[4 * g], sst[4 * g + 1]); w.y = pk2(sst[4 * g + 2], sst[4 * g + 3]);
        *(LAS u32x2*)(St + e * ST_PITCH + dd * 2) = w; } }
    sync_threads();
  }
#undef GLA_PREFETCH
}

constexpr int S5_WAVE_LDS = 12800, XS_PITCH = 272;
DEV float gelu_tanh_(float y) { const float u = 0.7978845608028654f * (y + 0.044715f * y * y * y); const float e = fast_exp2(2.0f * LOG2E * u); const float th = 1.0f - 2.0f * fast_rcp(e + 1.0f); return 0.5f * y * (1.0f + th); }
DEV void s5_wave(LDSP wl, const bf16_t* __restrict__ proj, const float* __restrict__ AB, const bf16_t* __restrict__ BT, const bf16_t* __restrict__ CT, const float* __restrict__ dskip  ,
                 bf16_t* __restrict__ zout  , int b, int g) {
  const int lane = OPAQUE_TID & 63, l15 = lane & 15, kg = lane >> 4;
  LAS float* BU = (LAS float*)wl; LDSP XS = wl + 8192;
  const float are = AB[(g * 64 + lane) * 2], aim = AB[(g * 64 + lane) * 2 + 1];
  bf16x8 bfr[8], cfr[4]; const bf16x8 zero8 = (bf16x8){0, 0, 0, 0, 0, 0, 0, 0};
#pragma unroll
  for (int nb = 0; nb < 8; ++nb) bfr[nb] = (kg < 2) ? *(const bf16x8*)(BT + ((size_t)g * 128 + 16 * nb + l15) * 16 + 8 * kg) : zero8;
#pragma unroll
  for (int ks = 0; ks < 4; ++ks) cfr[ks] = *(const bf16x8*)(CT + ((size_t)g * 16 + l15) * 128 + 32 * ks + 8 * kg);
  const float dsk = dskip[g * 16 + l15];
  float xr = 0.f, xi = 0.f;
  const size_t rowbase = (size_t)b * SEQ;
  for (int t0 = 0; t0 < SEQ; t0 += 16) {
    const bf16_t* up = proj + (rowbase + t0) * PW + C_S5U + g * 16;
    const bf16x8 ua = (kg < 2) ? *(const bf16x8*)(up + (size_t)l15 * PW + 8 * kg) : zero8;
#pragma unroll
    for (int nb = 0; nb < 8; ++nb) { f32x4 c4 = (f32x4){0.f, 0.f, 0.f, 0.f}; c4 = mfma16(ua, bfr[nb], c4);
#pragma unroll
      for (int i = 0; i < 4; ++i) BU[(4 * kg + i) * 128 + 16 * nb + l15] = c4[i]; }
    wave_sync();
#pragma unroll
    for (int j = 0; j < 16; ++j) { const float br = BU[j * 128 + lane], bi = BU[j * 128 + 64 + lane];
      const float nr = are * xr - aim * xi + br, ni = are * xi + aim * xr + bi; xr = nr; xi = ni;
      *(LAS bf16_t*)(XS + j * XS_PITCH + lane * 2) = f2bf(xr); *(LAS bf16_t*)(XS + j * XS_PITCH + (64 + lane) * 2) = f2bf(xi); }
    wave_sync();
    f32x4 y4 = (f32x4){0.f, 0.f, 0.f, 0.f};
#pragma unroll
    for (int ks = 0; ks < 4; ++ks) y4 = mfma16(lds_ld8(XS + l15 * XS_PITCH + (32 * ks + 8 * kg) * 2), cfr[ks], y4);
#pragma unroll
    for (int i = 0; i < 4; ++i) { const size_t row = rowbase + t0 + 4 * kg + i; const float uu = bf2f(proj[row * PW + C_S5U + g * 16 + l15]);
      zout[row * 512 + g * 16 + l15] = f2bf(gelu_tanh_(y4[i] + dsk * uu)); }
  }
}
constexpr int S5_LC = (SEQ >= 2048) ? 1024 : (SEQ / 2), S5_NC = SEQ / S5_LC;
template <int MODE>
DEV void s5_chunk(LDSP wl, const bf16_t* __restrict__ proj, const float* __restrict__ AB, const float* __restrict__ ABL, const bf16_t* __restrict__ BT, const bf16_t* __restrict__ CT, const float* __restrict__ dskip  ,
                  float* __restrict__ s5st  , bf16_t* __restrict__ zout  , int b, int g, int c) {
  const int lane = OPAQUE_TID & 63, l15 = lane & 15, kg = lane >> 4;
  LAS float* BU = (LAS float*)wl; LDSP XS = wl + 8192;
  const float are = AB[(g * 64 + lane) * 2], aim = AB[(g * 64 + lane) * 2 + 1];
  bf16x8 bfr[8], cfr[4]; const bf16x8 zero8 = (bf16x8){0, 0, 0, 0, 0, 0, 0, 0};
#pragma unroll
  for (int nb = 0; nb < 8; ++nb) bfr[nb] = (kg < 2) ? *(const bf16x8*)(BT + ((size_t)g * 128 + 16 * nb + l15) * 16 + 8 * kg) : zero8;
  bf16x8 dfr = zero8;
  if (MODE == 3) {
#pragma unroll
    for (int ks = 0; ks < 4; ++ks) cfr[ks] = *(const bf16x8*)(CT + ((size_t)g * 16 + l15) * 128 + 32 * ks + 8 * kg);
    const float dsk = dskip[g * 16 + l15]; const bf16_t dhi = f2bf(dsk), dlo = f2bf(dsk - bf2f(dhi));
#pragma unroll
    for (int kk = 0; kk < 8; ++kk) { const int k = 8 * kg + kk; dfr[kk] = ((k & 15) == l15) ? (short)(k < 16 ? dhi : dlo) : (short)0; } }
  float xr = 0.f, xi = 0.f;
  float* rec = s5st + ((size_t)(b * 32 + g) * S5_NC) * 128 + lane * 2;
  if (MODE == 3) { const float lr = ABL[(g * 64 + lane) * 2], li = ABL[(g * 64 + lane) * 2 + 1];
    for (int k = 0; k < c; ++k) { float er, ei; ld_wt2(rec + k * 128, er, ei); const float nr = lr * xr - li * xi + er, ni = lr * xi + li * xr + ei; xr = nr; xi = ni; } }
  const size_t rowbase = (size_t)b * SEQ + (size_t)c * S5_LC;
  const bf16_t* ubase = proj + (rowbase + l15) * PW + C_S5U + g * 16 + 8 * (kg & 1);
  constexpr int SB = 4;
  bf16x8 un[SB];
#pragma unroll
  for (int i = 0; i < SB; ++i) un[i] = *(const bf16x8*)(ubase + (size_t)(16 * i) * PW);
  for (int s0 = 0; s0 < S5_LC; s0 += 16 * SB) {
    bf16x8 uc[SB];
#pragma unroll
    for (int i = 0; i < SB; ++i) uc[i] = un[i];
    if (s0 + 16 * SB < S5_LC) {
#pragma unroll
      for (int i = 0; i < SB; ++i) un[i] = *(const bf16x8*)(ubase + (size_t)(s0 + 16 * SB + 16 * i) * PW); }
#pragma unroll
    for (int sb = 0; sb < SB; ++sb) {
      const bf16x8 ua = uc[sb];
#pragma unroll
      for (int nb = 0; nb < 8; ++nb) { f32x4 c4 = (f32x4){0.f, 0.f, 0.f, 0.f}; c4 = mfma16(ua, bfr[nb], c4);
#pragma unroll
        for (int i = 0; i < 4; ++i) BU[(4 * kg + i) * 128 + 16 * nb + l15] = c4[i]; }
      wave_sync();
#pragma unroll
      for (int j = 0; j < 16; ++j) { const float br = BU[j * 128 + lane], bi = BU[j * 128 + 64 + lane];
        const float nr = are * xr - aim * xi + br, ni = are * xi + aim * xr + bi; xr = nr; xi = ni;
        if (MODE == 3) { *(LAS bf16_t*)(XS + j * XS_PITCH + lane * 2) = f2bf(xr); *(LAS bf16_t*)(XS + j * XS_PITCH + (64 + lane) * 2) = f2bf(xi); } }
      wave_sync();
      if (MODE == 3) {
        f32x4 y4 = (f32x4){0.f, 0.f, 0.f, 0.f};
        y4 = mfma16(ua, dfr, y4);
#pragma unroll
        for (int ks = 0; ks < 4; ++ks) y4 = mfma16(lds_ld8(XS + l15 * XS_PITCH + (32 * ks + 8 * kg) * 2), cfr[ks], y4);
#pragma unroll
        for (int i = 0; i < 4; ++i) { const size_t row = rowbase + s0 + 16 * sb + 4 * kg + i; zout[row * 512 + g * 16 + l15] = f2bf(gelu_tanh_(y4[i])); }
      }
    }
  }
  if (MODE == 1) st_wt2(rec + c * 128, xr, xi);
}
DEV void s5_prep_item(int idx, const float* a_re, const float* a_im, const float* log_dt, const float* b_re, const float* b_im, const float* c_re, const float* c_im,
                      float* AB, float* ABL, int lc, bf16_t* BT, bf16_t* CT) {
  const int g = idx >> 6, p = idx & 63;
  const float are = a_re[idx], aim = a_im[idx], dt = expf(log_dt[g]);
  const float mag = expf(dt * are), abr = mag * cosf(dt * aim), abi = mag * sinf(dt * aim);
  const float nr = abr - 1.0f, ni = abi, den = are * are + aim * aim;
  const float fr = (nr * are + ni * aim) / den, fi = (ni * are - nr * aim) / den;
  AB[idx * 2] = abr; AB[idx * 2 + 1] = abi;
  { float pr = abr, pi = abi; for (int n = lc; n > 1; n >>= 1) { const float qr = pr * pr - pi * pi, t_ = pr * pi, qi = t_ + t_; pr = qr; pi = qi; } ABL[idx * 2] = pr; ABL[idx * 2 + 1] = pi; }
  for (int c = 0; c < 16; ++c) {
    const float br = b_re[(size_t)idx * 16 + c], bi = b_im[(size_t)idx * 16 + c];
    BT[((size_t)g * 128 + p) * 16 + c] = f2bf(fr * br - fi * bi); BT[((size_t)g * 128 + 64 + p) * 16 + c] = f2bf(fr * bi + fi * br);
    CT[((size_t)g * 16 + c) * 128 + p] = f2bf(c_re[((size_t)g * 16 + c) * 64 + p]); CT[((size_t)g * 16 + c) * 128 + 64 + p] = f2bf(-c_im[((size_t)g * 16 + c) * 64 + p]);
  }
}
constexpr int ML_ST_STRIDE = 16384 + 256;
constexpr int GLA_ST_STRIDE = 8192 + 64;
constexpr int ML_SO_BYTES = 32768 + 1024, GLA_SO_BYTES = 16384, GLA_P1_BYTES = 16384 + 256;
template <int MODE>
DEV void mlstm_chunk(LDSP lds, const bf16_t* __restrict__ proj, const float* __restrict__ narrow, const float* __restrict__ convw, const float* __restrict__ gateb,
                     float* __restrict__ st, bf16_t* __restrict__ oall, int b, int h, int ch) {
  const int tid0 = OPAQUE_TID, wave = rfl(tid0 >> 6);
#define ML_LANES() const int tid = opq(tid0), lane = tid & 63, l31 = lane & 31, h2 = lane >> 5; (void)l31; (void)h2; (void)lane
  LDSP Qt = lds, Kt = lds + 16384, Vt = lds + 32768, KWt = lds + 49152, Ct = lds + 65536;
  LAS float* F = (LAS float*)(lds + 106496);
  LAS float *U = F, *Mv = F + 64, *AT = F + 128, *EM = F + 192, *WJ = F + 256, *QN = F + 320, *CW = F + 520;
  const size_t t0 = (size_t)b * SEQ + (size_t)ch * 64;
  const GAS char* pbase = uptr(proj + (t0 - 3) * PW);
  char* sob = (char*)st + ((size_t)(b * 4 + h) * NCH + ch) * ML_SO_BYTES; float* sN = (float*)(sob + 32768); (void)sN;
  const int eb = wave & 3, tb = wave >> 2;
  const float gb0 = gateb[h], gb1 = gateb[4 + h];
  u32x2 ogv[4];
  { ML_LANES();
    for (int i = tid; i < 1024; i += 512) { const int j = i >> 8, r = i & 255; CW[i] = convw[j * 1024 + (r >> 7) * 512 + h * 128 + (r & 127)]; }
    constexpr int NRW = (MODE == 1) ? 4 : 8;
    const bool convt = (MODE == 3) ? (tid < 256) : ((tid & 128) != 0);
    const int ct = (MODE == 3) ? tid : ((tid & 127) | ((tid >> 8) << 7));
    bf16x8 rqk[NRW + 3]; u32x4 rvv[4];
    if (convt) { const int which = (MODE == 3) ? (ct >> 7) & 1 : 1, dch = ct & 15, tg = (MODE == 3) ? (ct & 127) >> 4 : ct >> 4; unsigned voff = (unsigned)((tg * NRW) * PW + (which ? C_MLK : C_MLQ) + h * 128 + dch * 8) * 2u;
#pragma unroll
      for (int r = 0; r < NRW + 3; ++r) { bf16x8 v = (bf16x8){0, 0, 0, 0, 0, 0, 0, 0}; if (ch * 64 + tg * NRW - 3 + r >= 0) v = *(const GAS bf16x8*)(pbase + voff); rqk[r] = v; voff += PW * 2; } }
    else { const int t2 = (MODE == 3) ? tid - 256 : ct;
#pragma unroll
      for (int i = 0; i < 4; ++i) { const int id = t2 + 256 * i, row = id >> 4, c16 = id & 15; rvv[i] = *(const GAS u32x4*)(pbase + (unsigned)((row + 3) * PW + C_MLV + h * 128 + c16 * 8) * 2u); } }
    float rig = 0.f, rfg = 0.f, mprev = 0.f;
    if (MODE == 3) {
      const GAS char* og_ = pbase + (unsigned)((32 * tb + l31 + 3) * PW + C_MLO + h * 128 + 32 * eb + 4 * h2) * 2u;
#pragma unroll
      for (int g = 0; g < 4; ++g) ogv[g] = *(const GAS u32x2*)(og_ + 16 * g); }
    if (wave == (MODE == 3 ? 4 : 0)) { const GAS char* nb = uptr(narrow + t0 * NWP); rig = *(const GAS float*)(nb + (unsigned)(lane * NWP + NW_MLI + h) * 4u); rfg = *(const GAS float*)(nb + (unsigned)(lane * NWP + NW_MLF + h) * 4u);
      if (MODE == 3) { float d_; ld_wt2(sN + 130, mprev, d_); } }
    if (MODE == 3) {
      const int db = wave >> 1;
#pragma unroll
      for (int x = 0; x < 2; ++x) { const u32x4 c0 = *(const u32x4*)(sob + ((wave * 2 + x) * 64 + lane) * 32), c1 = *(const u32x4*)(sob + ((wave * 2 + x) * 64 + lane) * 32 + 16);
        const unsigned c[8] = {c0.x, c0.y, c0.z, c0.w, c1.x, c1.y, c1.z, c1.w};
        const int e = 32 * (2 * (wave & 1) + x) + l31;
#pragma unroll
        for (int g = 0; g < 4; ++g) { const int d = 32 * db + 8 * g + 4 * h2; u32x2 w; w.x = c[2 * g]; w.y = c[2 * g + 1];
          *(LAS u32x2*)(Ct + offb(e, d >> 3) + (d & 7) * 2) = w; } }
      if (tid < 128) *(LAS bf16_t*)(Ct + offb(128, tid >> 3) + (tid & 7) * 2) = f2bf(ld_wt1(sN + tid));
      for (int i = tid; i < 31 * 64; i += 512) ((LAS unsigned*)(Ct + 129 * 256))[i] = 0u;
    }
    raw_barrier();
    if (convt) {
      const int which = (MODE == 3) ? (ct >> 7) & 1 : 1, dch = ct & 15, tg = (MODE == 3) ? (ct & 127) >> 4 : ct >> 4;
      float cw[4][8];
#pragma unroll
      for (int j = 0; j < 4; ++j) { const f32x4 a = *(const LAS f32x4*)(CW + j * 256 + which * 128 + dch * 8), c = *(const LAS f32x4*)(CW + j * 256 + which * 128 + dch * 8 + 4);
        cw[j][0] = a[0]; cw[j][1] = a[1]; cw[j][2] = a[2]; cw[j][3] = a[3]; cw[j][4] = c[0]; cw[j][5] = c[1]; cw[j][6] = c[2]; cw[j][7] = c[3]; }
      float win[3][8];
#pragma unroll
      for (int r = 0; r < 3; ++r)
#pragma unroll
        for (int d = 0; d < 8; ++d) win[r][d] = bf2f((bf16_t)rqk[r][d]);
      const float osc = which ? 0.08838834764831845f : 1.0f;
      LDSP dstT = which ? Kt : Qt;
#pragma unroll
      for (int r = 0; r < NRW; ++r) {
        float cur[8], y[8];
#pragma unroll
        for (int d = 0; d < 8; ++d) { cur[d] = bf2f((bf16_t)rqk[3 + r][d]); const float a = cw[0][d] * win[0][d] + cw[1][d] * win[1][d] + cw[2][d] * win[2][d] + cw[3][d] * cur[d];
          y[d] = a * sigmoidf_(a) * osc; win[0][d] = win[1][d]; win[1][d] = win[2][d]; win[2][d] = cur[d]; }
        u32x4 w; w.x = pk2(y[0], y[1]); w.y = pk2(y[2], y[3]); w.z = pk2(y[4], y[5]); w.w = pk2(y[6], y[7]);
        *(LAS u32x4*)(dstT + offb(tg * NRW + r, dch)) = w;
      }
    } else {
      const int t2 = (MODE == 3) ? tid - 256 : ct;
#pragma unroll
      for (int i = 0; i < 4; ++i) { const int id = t2 + 256 * i, row = id >> 4, c16 = id & 15; *(LAS u32x4*)(Vt + offb(row, c16)) = rvv[i]; }
    }
    if (wave == (MODE == 3 ? 4 : 0)) {
      const float ig = rig + gb0, lf = log_sigmoidf_(rfg + gb1);
      float bsum = lf;
#pragma unroll
      for (int d = 1; d < 64; d <<= 1) { const float o_ = shfl_up_f(bsum, d); if (lane >= d) bsum += o_; }
      const float u = ig - bsum;
      if (MODE == 1) {
        float g = u;
#pragma unroll
        for (int o = 1; o < 64; o <<= 1) g = fmaxf(g, shfl_xor_f(g, o));
        WJ[lane] = __expf(u - g);
        const float blast = shfl_idx_f(bsum, 63);
        if (lane == 0) st_wt2(sN + 128, g, blast);
      } else {
        float pm = u;
#pragma unroll
        for (int d = 1; d < 64; d <<= 1) { const float o_ = shfl_up_f(pm, d); if (lane >= d) pm = fmaxf(pm, o_); }
        const float Mt = fmaxf(mprev, pm);
        U[lane] = u; Mv[lane] = Mt; AT[lane] = __expf(mprev - Mt); EM[lane] = __expf(-(bsum + Mt));
      }
    }
  }
  raw_barrier();
  if (MODE == 1) {
    { ML_LANES();
#pragma unroll
      for (int i = 0; i < 2; ++i) { const int id = tid + 512 * i, row = id >> 4, c16 = id & 15; const float wj = WJ[row];
        const bf16x8 v = lds_ld8(Kt + offb(row, c16)); u32x4 w;
        w.x = pk2(bf2f((bf16_t)v[0]) * wj, bf2f((bf16_t)v[1]) * wj); w.y = pk2(bf2f((bf16_t)v[2]) * wj, bf2f((bf16_t)v[3]) * wj);
        w.z = pk2(bf2f((bf16_t)v[4]) * wj, bf2f((bf16_t)v[5]) * wj); w.w = pk2(bf2f((bf16_t)v[6]) * wj, bf2f((bf16_t)v[7]) * wj);
        *(LAS u32x4*)(KWt + offb(row, c16)) = w; }
    }
    raw_barrier();
    { ML_LANES();
      const int db = wave >> 1; f32x16 cst[2];
#pragma unroll
      for (int x = 0; x < 2; ++x)
#pragma unroll
        for (int i = 0; i < 16; ++i) cst[x][i] = 0.f;
#pragma unroll
      for (int ks = 0; ks < 4; ++ks) { const bf16x8 af = frag_tr(KWt, db, ks, lane, false);
#pragma unroll
        for (int x = 0; x < 2; ++x) cst[x] = mfma32(af, frag_tr(Vt, 2 * (wave & 1) + x, ks, lane, false), cst[x]); }
#pragma unroll
      for (int x = 0; x < 2; ++x) { u32x4 c0, c1; c0.x = pk2(cst[x][0], cst[x][1]); c0.y = pk2(cst[x][2], cst[x][3]); c0.z = pk2(cst[x][4], cst[x][5]); c0.w = pk2(cst[x][6], cst[x][7]);
        c1.x = pk2(cst[x][8], cst[x][9]); c1.y = pk2(cst[x][10], cst[x][11]); c1.z = pk2(cst[x][12], cst[x][13]); c1.w = pk2(cst[x][14], cst[x][15]);
        *(u32x4*)(sob + ((wave * 2 + x) * 64 + lane) * 32) = c0; *(u32x4*)(sob + ((wave * 2 + x) * 64 + lane) * 32 + 16) = c1; }
      if ((wave & 1) == 0) {
        const bf16x8 ones = (bf16x8){0x3f80, 0x3f80, 0x3f80, 0x3f80, 0x3f80, 0x3f80, 0x3f80, 0x3f80};
        f32x16 cs;
#pragma unroll
        for (int i = 0; i < 16; ++i) cs[i] = 0.f;
#pragma unroll
        for (int ks = 0; ks < 4; ++ks) cs = mfma32(frag_tr(KWt, db, ks, lane, false), ones, cs);
        if (l31 == 0) {
#pragma unroll
          for (int i = 0; i < 16; ++i) st_wt1(sN + 32 * db + crow(i, h2), cs[i]); }
      }
    }
  } else {
    if (eb == 0) {
      ML_LANES();
      f32x16 qn;
#pragma unroll
      for (int i = 0; i < 16; ++i) qn[i] = 0.f;
#pragma unroll
      for (int ks = 0; ks < 8; ++ks) qn = mfma32(frag_row(Ct, 128, ks, lane), frag_row(Qt, 32 * tb, ks, lane), qn);
      if (h2 == 0) QN[32 * tb + l31] = qn[0];
    }
    f32x16 acc;
    { ML_LANES();
#pragma unroll
      for (int i = 0; i < 16; ++i) acc[i] = 0.f;
#pragma unroll
      for (int ks = 0; ks < 8; ++ks) acc = mfma32(frag_row(Ct, 32 * eb, ks, lane), frag_row(Qt, 32 * tb, ks, lane), acc);
    }
    float rsum = 0.f;
#pragma unroll
    for (int jb = 0; jb < 2; ++jb) {
      if (jb <= tb) {
        ML_LANES();
        const int tl = 32 * tb + l31; const float Mt = Mv[tl];
        if (jb == 0) { const float at = AT[tl];
#pragma unroll
          for (int i = 0; i < 16; ++i) acc[i] *= at; }
        f32x16 s;
#pragma unroll
        for (int i = 0; i < 16; ++i) s[i] = 0.f;
#pragma unroll
        for (int ks = 0; ks < 8; ++ks) s = mfma32(frag_row(Kt, 32 * jb, ks, lane), frag_row(Qt, 32 * tb, ks, lane), s);
#pragma unroll
        for (int i = 0; i < 16; ++i) { const int j = 32 * jb + crow(i, h2); const float w = (j <= tl) ? __expf(U[j] - Mt) : 0.f; s[i] *= w; rsum += s[i]; }
#pragma unroll
        for (int s2 = 0; s2 < 2; ++s2) acc = mfma32(frag_tr(Vt, eb, 2 * jb + s2, lane, true), acc_frag(s, s2), acc);
      }
    }
    rsum += shfl_xor_f(rsum, 32);
    raw_barrier();
    { ML_LANES();
      const int tl = 32 * tb + l31;
      const float den = AT[tl] * QN[tl] + rsum; const float dd = fmaxf(fabsf(den), EM[tl]); const float inv = 1.0f / dd;
      GAS char* op = (GAS char*)uptr(oall + t0 * OW) + (unsigned)(tl * OW + 512 + h * 128 + 32 * eb + 4 * h2) * 2u;
#pragma unroll
      for (int g = 0; g < 4; ++g) { const u32x2 gv2 = ogv[g];
        const float g0 = sigmoidf_(bf2f((bf16_t)(gv2.x & 0xffff))), g1 = sigmoidf_(bf2f((bf16_t)(gv2.x >> 16))), g2 = sigmoidf_(bf2f((bf16_t)(gv2.y & 0xffff))), g3 = sigmoidf_(bf2f((bf16_t)(gv2.y >> 16)));
        u32x2 w; w.x = pk2(acc[4 * g] * inv * g0, acc[4 * g + 1] * inv * g1); w.y = pk2(acc[4 * g + 2] * inv * g2, acc[4 * g + 3] * inv * g3);
        *(GAS u32x2*)(op + 16 * g) = w; }
    }
  }
  raw_barrier();
#undef ML_LANES
}
DEV float bflo(unsigned w) { unsigned u = w << 16; float r; __builtin_memcpy(&r, &u, 4); return r; }
DEV float bfhi(unsigned w) { unsigned u = w & 0xffff0000u; float r; __builtin_memcpy(&r, &u, 4); return r; }
DEV void mlstm_scan_e(const float* __restrict__ st_bh_, float* __restrict__ so_bh_, int e) {
  const int lane = OPAQUE_TID & 63, tid = e >> 2; const bool nthr = (e < 512);
  const char* st_bh = (const char*)st_bh_; char* so_bh = (char*)so_bh_;
  f32x4 C = (f32x4){0.f, 0.f, 0.f, 0.f}; float N = 0.f, m = 0.f;
  constexpr int UN = (NCH % 32 == 0) ? 32 : 8;
  for (int k0 = 0; k0 < NCH; k0 += UN) {
    u32x2 Ch[UN]; float Nh[UN]; float gl, Bl;
    ld_wt2((const float*)(st_bh + (size_t)(k0 + (lane & (UN - 1))) * ML_SO_BYTES + 32768) + 128, gl, Bl);
#pragma unroll
    for (int u = 0; u < UN; ++u) { const char* p = st_bh + (size_t)(k0 + u) * ML_SO_BYTES; Ch[u] = *(const u32x2*)(p + (size_t)e * 2);
      Nh[u] = 0.f; if (nthr) Nh[u] = ld_wt1((const float*)(p + 32768) + tid); }
#pragma unroll
    for (int u = 0; u < UN; ++u) { char* p = so_bh + (size_t)(k0 + u) * ML_SO_BYTES; float* pn = (float*)(p + 32768);
      const float g = shfl_idx_f(gl, u), B = shfl_idx_f(Bl, u);
      const float Ml = fmaxf(m, g), a = __expf(m - Ml), bb = __expf(g - Ml);
      { u32x2 w; w.x = pk2(C[0], C[1]); w.y = pk2(C[2], C[3]); *(u32x2*)(p + (size_t)e * 2) = w; }
      C[0] = C[0] * a + bflo(Ch[u].x) * bb; C[1] = C[1] * a + bfhi(Ch[u].x) * bb; C[2] = C[2] * a + bflo(Ch[u].y) * bb; C[3] = C[3] * a + bfhi(Ch[u].y) * bb;
      if (nthr) { st_wt1(pn + tid, N); N = N * a + Nh[u] * bb; }
      if (e == 0) st_wt2(pn + 130, m, 0.f);
      m = B + Ml; }
  }
}

DEV void mlstm_scan(const float* __restrict__ st_bh, float* __restrict__ so_bh, int slice) { mlstm_scan_e(st_bh, so_bh, (slice * 512 + OPAQUE_TID) * 4); }

template <int MODE>
DEV void gla_chunk(LDSP lds, const bf16_t* __restrict__ proj, const float* __restrict__ narrow, const float* __restrict__ wa2, const float* __restrict__ ba,
                   float* __restrict__ st, bf16_t* __restrict__ oall, int b, int h, int ch) {
  const int tid = OPAQUE_TID, lane = tid & 63, wave = rfl(tid >> 6), l31 = lane & 31, h2 = lane >> 5;
  LDSP QKt = lds, KWt = lds + 16384, Vt = lds + 32768, St = lds + 49152;
  LAS float* F = (LAS float*)(lds + 69632);
  LAS float *GA = F, *TOT = F + 1024, *SS = F + 1600;
  const size_t t0 = (size_t)b * SEQ + (size_t)ch * 64;
  char* sob = (char*)st + ((size_t)(b * 4 + h) * NCH + ch) * (MODE == 1 ? GLA_P1_BYTES : GLA_SO_BYTES);
  const int d = tid & 63, tg = tid >> 6, eb = wave & 3, tb = wave >> 2;
  const GAS char* pb = uptr(proj + t0 * PW); const GAS char* nb = uptr(narrow + t0 * NWP);
  float wcol[16];
#pragma unroll
  for (int r = 0; r < 16; ++r) wcol[r] = wa2[r * 256 + h * 64 + d];
  const float bad = ba[h * 64 + d];
  { const int id = tid * 2, row = id >> 4, c = id & 15; const GAS float* gp = (const GAS float*)(nb + (unsigned)(row * NWP + NW_GLA + c) * 4u); GA[id] = gp[0]; GA[id + 1] = gp[1]; }
#pragma unroll
  for (int i = 0; i < 2; ++i) { const int id = tid + 512 * i, row = id >> 4, c16 = id & 15; *(LAS u32x4*)(Vt + offb(row, c16)) = *(const GAS u32x4*)(pb + (unsigned)(row * PW + C_GLV + h * 128 + c16 * 8) * 2u); }
  u32x2 grv[4];
  if (MODE == 3) { const GAS char* gr_ = pb + (unsigned)((32 * tb + l31) * PW + C_GLR + h * 128 + 32 * eb + 4 * h2) * 2u;
#pragma unroll
    for (int g = 0; g < 4; ++g) grv[g] = *(const GAS u32x2*)(gr_ + 16 * g); }
  float qraw[8], kraw8[8];
#pragma unroll
  for (int r = 0; r < 8; ++r) { const unsigned o = (unsigned)((8 * tg + r) * PW + h * 64 + d) * 2u; qraw[r] = (MODE == 3) ? bf2f(*(const GAS bf16_t*)(pb + o + C_GLQ * 2)) : 0.f; kraw8[r] = bf2f(*(const GAS bf16_t*)(pb + o + C_GLK * 2)); }
  if (MODE == 3) {
    const int db = wave >> 2; const u32x4 c0 = *(const u32x4*)(sob + (wave * 64 + lane) * 32), c1 = *(const u32x4*)(sob + (wave * 64 + lane) * 32 + 16);
    const unsigned c[8] = {c0.x, c0.y, c0.z, c0.w, c1.x, c1.y, c1.z, c1.w};
    const int e = 32 * eb + l31;
#pragma unroll
    for (int g = 0; g < 4; ++g) { const int dd = 32 * db + 8 * g + 4 * h2; u32x2 w; w.x = c[2 * g]; w.y = c[2 * g + 1];
      *(LAS u32x2*)(St + e * ST_PITCH + dd * 2) = w; }
  }
  raw_barrier();
  float bc[8], tot = 0.f;
#pragma unroll
  for (int r = 0; r < 8; ++r) { const int t = 8 * tg + r; float z = bad;
#pragma unroll
    for (int k = 0; k < 16; ++k) z += GA[t * 16 + k] * wcol[k];
    tot += log_sigmoidf_(z) * 0.0625f; bc[r] = tot; }
  TOT[tg * 64 + d] = tot;
  raw_barrier();
  float off = 0.f, last = 0.f;
#pragma unroll
  for (int g = 0; g < 8; ++g) { const float v = TOT[g * 64 + d]; if (g < tg) off += v; last += v; }
  if (MODE == 1 && tg == 0) st_wt1((float*)(sob + 16384) + d, __expf(last));
#pragma unroll
  for (int r = 0; r < 8; ++r) { const int t = 8 * tg + r; const float bcv = bc[r] + off;
    if (MODE == 3) { *(LAS bf16_t*)(QKt + offb(t, d >> 3) + (d & 7) * 2) = f2bf(qraw[r] * 0.125f * __expf(bcv));
      *(LAS bf16_t*)(QKt + offb(t, 8 + (d >> 3)) + (d & 7) * 2) = f2bf(kraw8[r] * __expf(-bcv)); }
    else *(LAS bf16_t*)(KWt + offb(t, d >> 3) + (d & 7) * 2) = f2bf(kraw8[r] * __expf(last - bcv)); }
  raw_barrier();
  if (MODE == 1) {
    const int db = wave >> 2; f32x16 sst;
#pragma unroll
    for (int i = 0; i < 16; ++i) sst[i] = 0.f;
#pragma unroll
    for (int ks = 0; ks < 4; ++ks) sst = mfma32(frag_tr(KWt, db, ks, lane, false), frag_tr(Vt, eb, ks, lane, false), sst);
#pragma unroll
    for (int i = 0; i < 16; ++i) (void)0;
    { u32x4 c0, c1; c0.x = pk2(sst[0], sst[1]); c0.y = pk2(sst[2], sst[3]); c0.z = pk2(sst[4], sst[5]); c0.w = pk2(sst[6], sst[7]);
      c1.x = pk2(sst[8], sst[9]); c1.y = pk2(sst[10], sst[11]); c1.z = pk2(sst[12], sst[13]); c1.w = pk2(sst[14], sst[15]);
      *(u32x4*)(sob + (wave * 64 + lane) * 32) = c0; *(u32x4*)(sob + (wave * 64 + lane) * 32 + 16) = c1; }
  } else {
    f32x16 acc;
#pragma unroll
    for (int i = 0; i < 16; ++i) acc[i] = 0.f;
#pragma unroll
    for (int ks = 0; ks < 4; ++ks) acc = mfma32(lds_ld8(St + (32 * eb + l31) * ST_PITCH + (16 * ks + 8 * h2) * 2), frag_row(QKt, 32 * tb, ks, lane), acc);
    const int tl = 32 * tb + l31;
#pragma unroll
    for (int jb = 0; jb < 2; ++jb) {
      if (jb <= tb) {
        f32x16 s;
#pragma unroll
        for (int i = 0; i < 16; ++i) s[i] = 0.f;
#pragma unroll
        for (int ks = 0; ks < 4; ++ks) s = mfma32(frag_row(QKt, 32 * jb, 4 + ks, lane), frag_row(QKt, 32 * tb, ks, lane), s);
#pragma unroll
        for (int i = 0; i < 16; ++i) { const int j = 32 * jb + crow(i, h2); if (j > tl) s[i] = 0.f; }
#pragma unroll
        for (int s2 = 0; s2 < 2; ++s2) acc = mfma32(frag_tr(Vt, eb, 2 * jb + s2, lane, true), acc_frag(s, s2), acc);
      }
    }
    float ss = 0.f;
#pragma unroll
    for (int i = 0; i < 16; ++i) ss += acc[i] * acc[i];
    ss += shfl_xor_f(ss, 32);
    if (h2 == 0) SS[eb * 64 + tl] = ss;
    raw_barrier();
    const float tot2 = SS[tl] + SS[64 + tl] + SS[128 + tl] + SS[192 + tl]; const float r = 1.0f / sqrtf(tot2 * (1.0f / 128.0f) + RMS_EPS);
    GAS char* op = (GAS char*)uptr(oall + t0 * OW) + (unsigned)(tl * OW + 1024 + h * 128 + 32 * eb + 4 * h2) * 2u;
#pragma unroll
    for (int g = 0; g < 4; ++g) { const u32x2 gv2 = grv[g];
      const float r0 = bf2f((bf16_t)(gv2.x & 0xffff)), r1 = bf2f((bf16_t)(gv2.x >> 16)), r2 = bf2f((bf16_t)(gv2.y & 0xffff)), r3 = bf2f((bf16_t)(gv2.y >> 16));
      u32x2 w; w.x = pk2(acc[4 * g] * r * r0 * sigmoidf_(r0), acc[4 * g + 1] * r * r1 * sigmoidf_(r1)); w.y = pk2(acc[4 * g + 2] * r * r2 * sigmoidf_(r2), acc[4 * g + 3] * r * r3 * sigmoidf_(r3));
      *(GAS u32x2*)(op + 16 * g) = w; }
  }
  raw_barrier();
}
DEV void gla_scan_e(const float* __restrict__ st_bh_, float* __restrict__ so_bh_, int e) {
  const int w = e >> 10, ln = (e >> 4) & 63, i0 = e & 15; const int dd = 32 * (w >> 2) + crow(i0, ln >> 5);
  const char* st_bh = (const char*)st_bh_; char* so_bh = (char*)so_bh_;
  f32x4 S = (f32x4){0.f, 0.f, 0.f, 0.f};
  constexpr int UN = (NCH % 16 == 0) ? 16 : 8;
  for (int k0 = 0; k0 < NCH; k0 += UN) {
    u32x2 Sh[UN]; f32x4 el[UN];
#pragma unroll
    for (int u = 0; u < UN; ++u) { const char* p = st_bh + (size_t)(k0 + u) * GLA_P1_BYTES; const float* pe = (const float*)(p + 16384) + dd;
      float e0, e1, e2, e3; ld_wt2(pe, e0, e1); ld_wt2(pe + 2, e2, e3); el[u] = (f32x4){e0, e1, e2, e3}; Sh[u] = *(const u32x2*)(p + (size_t)e * 2); }
#pragma unroll
    for (int u = 0; u < UN; ++u) { char* p = so_bh + (size_t)(k0 + u) * GLA_SO_BYTES; { u32x2 wv; wv.x = pk2(S[0], S[1]); wv.y = pk2(S[2], S[3]); *(u32x2*)(p + (size_t)e * 2) = wv; }
      S[0] = S[0] * el[u][0] + bflo(Sh[u].x); S[1] = S[1] * el[u][1] + bfhi(Sh[u].x); S[2] = S[2] * el[u][2] + bflo(Sh[u].y); S[3] = S[3] * el[u][3] + bfhi(Sh[u].y); }
  }
}
DEV void gla_scan(const float* __restrict__ st_bh, float* __restrict__ so_bh, int slice) { gla_scan_e(st_bh, so_bh, (slice * 512 + OPAQUE_TID) * 4); }
namespace pg8 {
#define PG8_LAS __attribute__((address_space(3)))
typedef unsigned short bf16_t;
typedef short bf16x8 __attribute__((ext_vector_type(8)));
typedef float f32x4 __attribute__((ext_vector_type(4)));
typedef unsigned u32x4 __attribute__((ext_vector_type(4)));
constexpr int BM = 256, BK = 64, HALF = 128, HTB = HALF * BK * 2  , STAGE_BYTES = 8 * HTB, NXCD = 8, WGM = 4;

__host__ __device__ __forceinline__ int lds_byte(int r, int c) { const int st = (r >> 4) * 2 + (c >> 5), rr = r & 15, cc = c & 31, ob = rr * 64 + cc * 2; return st * 1024 + (ob ^ (((ob >> 9) & 1) << 5)); }
__host__ __device__ __forceinline__ void stage_rc(int b, int& R, int& C) { const int st = b / 1024, sb = b % 1024, swz = sb ^ (((sb >> 9) & 1) << 5); R = (st >> 1) * 16 + swz / 64; C = (st & 1) * 32 + (swz % 64) / 2; }
__host__ __device__ __forceinline__ int perm32(int rho) { const int n = rho >> 4, i = rho & 15; return 8 * (i >> 2) + 4 * n + (i & 3); }

struct Unit { int pm, pn, acol, z, bcol, kind, nt; };
struct Gemm { const bf16_t* A; const bf16_t* Bt; int K, lda, ldb; const bf16_t* A1; const bf16_t* Bt1; };
typedef float f32x2 __attribute__((ext_vector_type(2)));
__device__ __forceinline__ unsigned cvt_pk_bf16(float lo, float hi) { typedef float f2_ __attribute__((ext_vector_type(2))); typedef __bf16 b2_ __attribute__((ext_vector_type(2))); const f2_ v = {lo, hi}; return __builtin_bit_cast(unsigned, __builtin_convertvector(v, b2_)); }
template <class Epi, class Sched, bool ALIGN_EPI = false, bool SP2 = false>
__device__ __forceinline__ void gemm_phase(PG8_LAS unsigned char* lds, const Gemm g, const Sched& S, const Epi& E) {
    const int tid = OPAQUE_TID, wid = __builtin_amdgcn_readfirstlane(tid >> 6), lane = tid & 63, wr = wid >> 2, wc = wid & 3, fr = lane & 15, fq = lane >> 4;
    const int K = g.K; (void)K;
    unsigned voffA[2], voffB[2];
#pragma unroll
    for (int i = 0; i < 2; ++i) { int R, C; stage_rc(tid * 16 + i * 8192, R, C); const int Rb = Epi::PERM ? ((R & ~31) + perm32(R & 31)) : R;
        voffA[i] = (unsigned)(R * g.lda + C) * 2u; voffB[i] = (unsigned)(Rb * g.ldb + C) * 2u; }
    const size_t kstep = (size_t)(BK * 2);
    const size_t hstepA = (size_t)HALF * g.lda * 2, hstepB = (size_t)HALF * g.ldb * 2;
    const size_t tstepA = 2 * hstepA, tstepB = 2 * hstepB;
    const unsigned ldsw = (unsigned)wid * 1024u;
    const int aoff = lds_byte(wr * 64 + fr, fq * 8), boff = lds_byte(wc * 32 + fr, fq * 8);
#define PG8_SA(b, h) (((b) * 2 + (h)) * HTB)
#define PG8_SB(b, h) ((4 + (b) * 2 + (h)) * HTB)
#define PG8_STAGE(bufoff, gbase, voff) do { _Pragma("unroll") for (int _i = 0; _i < 2; ++_i) \
        __builtin_amdgcn_global_load_lds((const unsigned*)((const char*)(gbase) + (voff)[_i]), (PG8_LAS unsigned*)(lds + (bufoff) + ldsw + _i * 8192), 16, 0, 0); } while (0)
#define PG8_LDA(dst, b, h) do { _Pragma("unroll") for (int m = 0; m < 4; ++m) _Pragma("unroll") for (int k = 0; k < 2; ++k) dst[m][k] = *(const PG8_LAS bf16x8*)(lds + PG8_SA(b, h) + aoff + m * 2048 + k * 1024); } while (0)
#define PG8_LDB(dst, b, h) do { _Pragma("unroll") for (int n = 0; n < 2; ++n) _Pragma("unroll") for (int k = 0; k < 2; ++k) dst[n][k] = *(const PG8_LAS bf16x8*)(lds + PG8_SB(b, h) + boff + n * 2048 + k * 1024); } while (0)
#define PG8_MMA(ai, bj, At, Bt) do { __builtin_amdgcn_s_setprio(1); _Pragma("unroll") for (int m = 0; m < 4; ++m) _Pragma("unroll") for (int n = 0; n < 2; ++n) _Pragma("unroll") for (int k = 0; k < 2; ++k) \
        acc[ai][bj][m][n] = __builtin_amdgcn_mfma_f32_16x16x32_bf16(Bt[n][k], At[m][k], acc[ai][bj][m][n], 0, 0, 0); __builtin_amdgcn_s_setprio(0); } while (0)
#define PG8_WAIT_V(n) asm volatile("s_waitcnt vmcnt(" #n ")" ::: "memory")
#define PG8_WAIT_L(n) asm volatile("s_waitcnt lgkmcnt(" #n ")" ::: "memory")
#define PG8_BAR __builtin_amdgcn_s_barrier()
#define PG8_SCHED __builtin_amdgcn_sched_barrier(0)
    Unit cur, nxt; int ui = 0;
    if (!S.next(0, cur)) return;
    f32x4 acc[2][2][4][2];
#pragma unroll
    for (int a = 0; a < 2; ++a)
#pragma unroll
        for (int b = 0; b < 2; ++b)
#pragma unroll
            for (int m = 0; m < 4; ++m)
#pragma unroll
                for (int n = 0; n < 2; ++n) acc[a][b][m][n] = (f32x4){0.f, 0.f, 0.f, 0.f};
    bf16x8 At[4][2], B0[2][2], B1[2][2];
    const char* cA = (const char*)(cur.kind ? g.A1 : g.A) + (size_t)cur.pm * tstepA + (size_t)cur.acol * 2; const char* cB = (const char*)(cur.kind ? g.Bt1 : g.Bt) + (size_t)cur.pn * tstepB + (size_t)cur.bcol * 2;
    S.a_ready(cur);
    if constexpr (SP2) {
        PG8_STAGE(PG8_SB(0, 0), cB, voffB); PG8_STAGE(PG8_SB(0, 1), cB + hstepB, voffB); PG8_STAGE(PG8_SA(0, 0), cA, voffA); PG8_STAGE(PG8_SA(0, 1), cA + hstepA, voffA);
        if (wr == 1) PG8_BAR;
        PG8_WAIT_V(2); PG8_BAR;
        PG8_STAGE(PG8_SB(1, 0), cB + kstep, voffB); PG8_STAGE(PG8_SA(1, 0), cA + kstep, voffA); PG8_STAGE(PG8_SB(1, 1), cB + hstepB + kstep, voffB);
        PG8_WAIT_V(6); PG8_BAR;
    } else {
        PG8_STAGE(PG8_SB(0, 0), cB, voffB); PG8_STAGE(PG8_SA(0, 0), cA, voffA); PG8_STAGE(PG8_SB(0, 1), cB + hstepB, voffB); PG8_STAGE(PG8_SA(0, 1), cA + hstepA, voffA);
        if (wr == 1) PG8_BAR;
        PG8_WAIT_V(4); PG8_BAR;
        PG8_STAGE(PG8_SB(1, 0), cB + kstep, voffB); PG8_STAGE(PG8_SA(1, 0), cA + kstep, voffA); PG8_STAGE(PG8_SB(1, 1), cB + hstepB + kstep, voffB);
        PG8_WAIT_V(6); PG8_BAR;
    }
    for (;;) {
        const bool has_next = S.next(ui + 1, nxt);
        const char* nA = has_next ? (const char*)(nxt.kind ? g.A1 : g.A) + (size_t)nxt.pm * tstepA + (size_t)nxt.acol * 2 : cA; const char* nB = has_next ? (const char*)(nxt.kind ? g.Bt1 : g.Bt) + (size_t)nxt.pn * tstepB + (size_t)nxt.bcol * 2 : cB;
        const int nt = cur.nt;
        for (int t = 0; t < nt; t += 2) {
            const bool last = (t == nt - 2);
            const char* a1 = cA + (size_t)(t + 1) * kstep;
            const char* a2 = last ? nA : cA + (size_t)(t + 2) * kstep; const char* b2 = last ? nB : cB + (size_t)(t + 2) * kstep;
            const char* a3 = a2 + kstep; const char* b3 = b2 + kstep;
            if (last && has_next) S.a_ready(nxt);
            if constexpr (SP2) {
            PG8_LDB(B0, 0, 0); PG8_LDB(B1, 0, 1); PG8_SCHED; PG8_LDA(At, 0, 0); PG8_STAGE(PG8_SA(1, 1), a1 + hstepA, voffA);
            PG8_WAIT_V(8); PG8_WAIT_L(0); PG8_BAR; PG8_MMA(0, 0, At, B0); PG8_MMA(0, 1, At, B1); PG8_BAR; PG8_SCHED;
            PG8_LDA(At, 0, 1); PG8_STAGE(PG8_SB(0, 0), b2, voffB); PG8_STAGE(PG8_SB(0, 1), b2 + hstepB, voffB); PG8_STAGE(PG8_SA(0, 0), a2, voffA);
            PG8_WAIT_V(8); PG8_WAIT_L(0); PG8_BAR; PG8_MMA(1, 0, At, B0); PG8_MMA(1, 1, At, B1); PG8_BAR; PG8_SCHED;
            PG8_LDB(B0, 1, 0); PG8_LDB(B1, 1, 1); PG8_SCHED; PG8_LDA(At, 1, 0); PG8_STAGE(PG8_SA(0, 1), a2 + hstepA, voffA);
            PG8_WAIT_V(8); PG8_WAIT_L(0); PG8_BAR; PG8_MMA(0, 0, At, B0); PG8_MMA(0, 1, At, B1); PG8_BAR; PG8_SCHED;
            PG8_LDA(At, 1, 1); PG8_STAGE(PG8_SB(1, 0), b3, voffB); PG8_STAGE(PG8_SB(1, 1), b3 + hstepB, voffB); PG8_STAGE(PG8_SA(1, 0), a3, voffA);
            PG8_WAIT_V(8); PG8_WAIT_L(0); PG8_BAR; PG8_MMA(1, 0, At, B0); PG8_MMA(1, 1, At, B1); PG8_BAR; PG8_SCHED;
            } else {
            PG8_LDB(B0, 0, 0); PG8_SCHED; PG8_LDA(At, 0, 0); PG8_STAGE(PG8_SA(1, 1), a1 + hstepA, voffA);
            PG8_WAIT_L(8); PG8_BAR; PG8_WAIT_L(0); PG8_MMA(0, 0, At, B0); PG8_BAR; PG8_SCHED;
            PG8_LDB(B1, 0, 1); PG8_STAGE(PG8_SB(0, 0), b2, voffB);
            PG8_BAR; PG8_WAIT_L(0); PG8_MMA(0, 1, At, B1); PG8_BAR;
            PG8_LDA(At, 0, 1); PG8_STAGE(PG8_SA(0, 0), a2, voffA);
            PG8_BAR; PG8_WAIT_L(0); PG8_MMA(1, 0, At, B0); PG8_BAR; PG8_SCHED;
            PG8_STAGE(PG8_SB(0, 1), b2 + hstepB, voffB);
            PG8_WAIT_V(6); PG8_BAR; PG8_MMA(1, 1, At, B1); PG8_BAR;
            PG8_LDB(B0, 1, 0); PG8_SCHED; PG8_LDA(At, 1, 0); PG8_STAGE(PG8_SA(0, 1), a2 + hstepA, voffA);
            PG8_WAIT_L(8); PG8_BAR; PG8_WAIT_L(0); PG8_MMA(0, 0, At, B0); PG8_BAR; PG8_SCHED;
            PG8_LDB(B1, 1, 1); PG8_STAGE(PG8_SB(1, 0), b3, voffB);
            PG8_BAR; PG8_WAIT_L(0); PG8_MMA(0, 1, At, B1); PG8_BAR;
            PG8_LDA(At, 1, 1); PG8_STAGE(PG8_SA(1, 0), a3, voffA);
            PG8_BAR; PG8_WAIT_L(0); PG8_MMA(1, 0, At, B0); PG8_BAR; PG8_SCHED;
            PG8_STAGE(PG8_SB(1, 1), b3 + hstepB, voffB);
            PG8_WAIT_V(6); PG8_BAR; PG8_MMA(1, 1, At, B1); PG8_BAR;
            }
        }
        if constexpr (ALIGN_EPI) { if (wr == 0) PG8_BAR; }
        if constexpr (!Epi::AFTER_DRAIN) { E(acc, cur, wr, wc, fr, fq); S.done(cur); }
        if (!has_next) break;
#pragma unroll
        for (int a = 0; a < 2; ++a)
#pragma unroll
            for (int b = 0; b < 2; ++b)
#pragma unroll
                for (int m = 0; m < 4; ++m)
#pragma unroll
                    for (int n = 0; n < 2; ++n) acc[a][b][m][n] = (f32x4){0.f, 0.f, 0.f, 0.f};
        cur = nxt; cA = nA; cB = nB; ++ui;
        if constexpr (ALIGN_EPI) { if (wr == 1) PG8_BAR; }
    }
    PG8_WAIT_V(0);
    if constexpr (!ALIGN_EPI) { if (wr == 0) PG8_BAR; }
    PG8_BAR;
    if constexpr (Epi::AFTER_DRAIN) { E.fused(acc, cur, wr, wc, fr, fq, lds, wid, lane); S.done(cur); }
#undef PG8_SA
#undef PG8_SB
#undef PG8_STAGE
#undef PG8_LDA
#undef PG8_LDB
#undef PG8_MMA
#undef PG8_WAIT_V
#undef PG8_WAIT_L
#undef PG8_BAR
#undef PG8_SCHED
}
}
constexpr int DM = 2048, NLAYER = 4, FFH = 5632, NPROJ = 5888, NMT = M_TOK / 256;
constexpr size_t MiB = 1u << 20;
constexpr size_t WS_CTL = 0, CTL_ZERO_BYTES = 1 * MiB;
constexpr size_t WS_MODP = 1 * MiB, WS_S5T = 8 * MiB, WS_WGLU = 9 * MiB, WS_WIN = 10 * MiB, WS_WG = 33 * MiB, WS_WB = 65 * MiB, WS_WOUT = 73 * MiB, WS_WFI = 81 * MiB, WS_WFO = 125 * MiB;
constexpr size_t WS_NAR = 147 * MiB, WS_Z = 151 * MiB, WS_H = 183 * MiB, WS_OALL = 311 * MiB, WS_PROJ = 439 * MiB, WS_P = 791 * MiB, WS_GSCR = 1303 * MiB, WS_WSET2 = 1367 * MiB, WS_END = 1505 * MiB;
constexpr size_t WS_XB = WS_P + 360 * MiB;
static_assert(WS_P + (size_t)M_TOK * 5632 * 2 <= WS_XB && WS_XB + (size_t)M_TOK * 2048 * 2 <= WS_GSCR, "XB");
constexpr size_t WS_MERGED = WS_PROJ, WS_MIXB = WS_PROJ + 128 * MiB, WS_Y = WS_PROJ, WS_HID = WS_P;
static_assert(WS_WIN + (size_t)NPROJ * DM * 2 <= WS_WG && WS_WFI + (size_t)2 * FFH * DM * 2 <= WS_WFO && WS_WFO + (size_t)DM * FFH * 2 <= WS_NAR, "weight map");
static_assert(WS_NAR + (size_t)M_TOK * NWP * 4 <= WS_Z && WS_Z + (size_t)M_TOK * 512 * 2 <= WS_H && WS_H + (size_t)M_TOK * DM * 2 <= WS_OALL && WS_OALL + (size_t)M_TOK * DM * 2 <= WS_PROJ, "act map");
static_assert(WS_PROJ + (size_t)M_TOK * PW * 2 <= WS_P && WS_P + (size_t)4 * M_TOK * DM * 2 <= WS_GSCR && WS_HID + (size_t)M_TOK * FFH * 2 <= WS_GSCR && WS_GSCR + (size_t)256 * 262144 <= WS_END, "act map 2");
constexpr size_t WSET_BYTES = WS_NAR - WS_WGLU;
static_assert(WS_WSET2 + WSET_BYTES <= WS_END, "second weight set");
constexpr int KSPLIT = 8;
constexpr int CW_TMO = 0, CW_BAR = 4096, CW_Q = 16384;
constexpr int LDS_BYTES = 147456, LDS_MISC = 131072, LDS_BIAS = 131072 + 256;
constexpr int N_PHASES = 2 + 9 * NLAYER;

__device__ const unsigned char T5_BUCKET[128] = {0,1,2,3,4,5,6,7,8,9,10,11,12,13,14,15,16,16,16,17,17,18,18,18,19,19,19,20,20,20,20,21,21,21,21,22,22,22,22,22,23,23,23,23,23,23,24,24,24,24,24,24,25,25,25,25,25,25,25,26,26,26,26,26,26,26,26,27,27,27,27,27,27,27,27,27,27,28,28,28,28,28,28,28,28,28,28,29,29,29,29,29,29,29,29,29,29,29,29,30,30,30,30,30,30,30,30,30,30,30,30,30,30,31,31,31,31,31,31,31,31,31,31,31,31,31,31,31};

#define XB_TMO      128
#define XB_XCNT(j)  (256  + 64 * (j))
#define XB_XSUB(j)  (1280 + 64 * (j))
#define XB_XGEN(j)  (2304 + 64 * (j))
#define XB_TOP      3328
#define XB_TOPGEN   3392
#define XCD_BAR_WORDS 3456
#define XB_SPIN_CAP (1u << 22)
__device__ __forceinline__ unsigned xb_ld(unsigned* p)              { return __hip_atomic_load(p, __ATOMIC_RELAXED, __HIP_MEMORY_SCOPE_AGENT); }
__device__ __forceinline__ unsigned xb_add(unsigned* p, unsigned v) { return __hip_atomic_fetch_add(p, v, __ATOMIC_RELAXED, __HIP_MEMORY_SCOPE_AGENT); }
__device__ __forceinline__ unsigned xb_xcc_id() { return (unsigned)__builtin_amdgcn_s_getreg((3 << 11) | 20) & 0xFu; }
#define XB_SPIN(cond, bar) do { unsigned _sp = 0; while (cond) { __builtin_amdgcn_s_sleep(1); \
    if ((++_sp & 255u) == 0u) { if (xb_ld(&(bar)[XB_TMO])) break; if (_sp > XB_SPIN_CAP) { atomicAdd(&(bar)[XB_TMO], 1u); break; } } } } while (0)
struct XcdBarrier { unsigned* bar; unsigned x; volatile LAS unsigned* st; };
__device__ __forceinline__ XcdBarrier xcd_barrier_post(unsigned* bar, volatile LAS unsigned* st) {
    XcdBarrier b; b.bar = bar; b.x = xb_xcc_id(); b.st = st;
    if (threadIdx.x == 0) (void)xb_add(&bar[XB_XCNT(b.x)], 1u);
    return b;
}
__device__ __forceinline__ void xcd_barrier_complete(unsigned* bar, unsigned x, unsigned& nloc, unsigned& nx) {
    const unsigned G = gridDim.x * gridDim.y * gridDim.z;
    unsigned sum, cnt, mine, sp = 0u;
    for (;;) {
        sum = 0u; cnt = 0u; mine = 0u;
#pragma unroll
        for (unsigned j = 0; j < 16; ++j) { const unsigned c = xb_ld(&bar[XB_XCNT(j)]); sum += c; cnt += (c > 0u) ? 1u : 0u; mine = (j == x) ? c : mine; }
        if (sum == G) break;
        __builtin_amdgcn_s_sleep(1);
        if ((++sp & 255u) == 0u) { if (xb_ld(&bar[XB_TMO])) break; if (sp > XB_SPIN_CAP) { atomicAdd(&bar[XB_TMO], 1u); break; } }
    }
    nloc = mine > 0u ? mine : 1u; nx = cnt > 0u ? cnt : 1u;
}
#ifndef XB_SCOPE
#define XB_SCOPE "agent"
#endif
__device__ __forceinline__ void xcd_barrier(const XcdBarrier& b) {
    asm volatile("s_waitcnt vmcnt(0)" ::: "memory");
    __syncthreads();
    if (threadIdx.x == 0) {
        unsigned* bar = b.bar;
        __builtin_amdgcn_s_waitcnt(0);
        unsigned nloc = b.st[0], nx = b.st[1];
        if (nloc == 0u) { xcd_barrier_complete(bar, b.x, nloc, nx); b.st[0] = nloc; b.st[1] = nx; }
#ifdef PROBE_WG_RELEASE
        __builtin_amdgcn_fence(__ATOMIC_RELEASE, XB_SCOPE); asm volatile("s_waitcnt vmcnt(0)" ::: "memory");
#endif
        const unsigned old = xb_add(&bar[XB_XSUB(b.x)], 1u);
        const unsigned gen = old / nloc;
        if (old + 1u == (gen + 1u) * nloc) {
            __builtin_amdgcn_fence(__ATOMIC_RELEASE, XB_SCOPE);
            asm volatile("s_waitcnt vmcnt(0)" ::: "memory");
            const unsigned og = xb_add(&bar[XB_TOP], 1u);
            const unsigned tg = og / nx;
            if (og + 1u == (tg + 1u) * nx) xb_add(&bar[XB_TOPGEN], 1u);
            else XB_SPIN(xb_ld(&bar[XB_TOPGEN]) == tg, bar);
            __builtin_amdgcn_fence(__ATOMIC_ACQUIRE, XB_SCOPE);
            xb_add(&bar[XB_XGEN(b.x)], 1u);
            asm volatile("s_waitcnt vmcnt(0)" ::: "memory");
        } else {
            XB_SPIN(xb_ld(&bar[XB_XGEN(b.x)]) == gen, bar);
            __builtin_amdgcn_fence(__ATOMIC_ACQUIRE, XB_SCOPE);
            asm volatile("s_waitcnt vmcnt(0)" ::: "memory");
        }
    }
    __syncthreads();
}

namespace pg8 {
__device__ __forceinline__ void tile_map(int nM, int nN, int L, int& pm, int& pn) {
    const int nwg = nM * nN; int wgid = L;
    { const int q = nwg / NXCD, r = nwg % NXCD, xcd = wgid % NXCD, off = wgid / NXCD; wgid = (xcd < r ? xcd * (q + 1) : r * (q + 1) + (xcd - r) * q) + off; }
    const int nig = WGM * nN, gid = wgid / nig, fm = gid * WGM, gsz = (nM - fm) < WGM ? (nM - fm) : WGM;
    pm = fm + ((wgid % nig) % gsz); pn = (wgid % nig) / gsz;
}
struct SchedPlain { int nM, nN, G, c, nt;
    __device__ __forceinline__ bool next(int i, Unit& u) const { const long L = (long)i * G + c; if (L >= (long)nM * nN) return false; tile_map(nM, nN, (int)L, u.pm, u.pn); u.acol = 0; u.z = 0; u.bcol = 0; u.kind = 0; u.nt = nt; return true; }
    __device__ __forceinline__ void a_ready(const Unit&) const {} __device__ __forceinline__ void done(const Unit&) const {} };
struct SchedGate { int nM, G, c;
    __device__ __forceinline__ bool next(int i, Unit& u) const { const long T = (long)(i >> 3) * G + c; if (T >= (long)nM * 8) return false; int pm, pn; tile_map(nM, 8, (int)T, pm, pn); const int z = (i >> 1) & 3, isg = i & 1;
        u.pm = pm; u.z = z; u.kind = isg ? 0 : 1; u.pn = isg ? z * 8 + pn : pn; u.acol = isg ? 0 : 512 * z; u.bcol = isg ? 0 : 512 * z; u.nt = isg ? 32 : 8; return true; }
    __device__ __forceinline__ void a_ready(const Unit&) const {} __device__ __forceinline__ void done(const Unit&) const {} };

__device__ __forceinline__ u32x4 pack8(const f32x4& a, const f32x4& b) { u32x4 w; w.x = cvt_pk_bf16(a[0], a[1]); w.y = cvt_pk_bf16(a[2], a[3]); w.z = cvt_pk_bf16(b[0], b[1]); w.w = cvt_pk_bf16(b[2], b[3]); return w; }
__device__ __forceinline__ void unpack8(const u32x4& w, f32x4& a, f32x4& b) {
    a[0] = __uint_as_float(w.x << 16); a[1] = __uint_as_float(w.x & 0xffff0000u); a[2] = __uint_as_float(w.y << 16); a[3] = __uint_as_float(w.y & 0xffff0000u);
    b[0] = __uint_as_float(w.z << 16); b[1] = __uint_as_float(w.z & 0xffff0000u); b[2] = __uint_as_float(w.w << 16); b[3] = __uint_as_float(w.w & 0xffff0000u); }
__device__ __forceinline__ float sigm(float x) { return __builtin_amdgcn_rcpf(1.0f + __builtin_amdgcn_exp2f(-1.4426950408889634f * x)); }

struct EpiPlain {
    static constexpr bool PERM = true, AFTER_DRAIN = false;
    bf16_t* O; int ldc; int colmask; size_t zstride;
    __device__ __forceinline__ void operator()(const f32x4 (&acc)[2][2][4][2], const Unit& u, int wr_, int wc_, int fr_, int fq_) const {
        const int tid = OPAQUE_TID, wid_ = __builtin_amdgcn_readfirstlane(tid >> 6), wr = wid_ >> 2, wc = wid_ & 3, fr = tid & 15, fq = (tid & 63) >> 4;
        const int row0 = u.pm * BM + wr * 64 + fr, col0 = (u.pn & colmask) * BM + wc * 32 + 8 * fq; bf16_t* base = O + (size_t)u.z * zstride;
#pragma unroll
        for (int ai = 0; ai < 2; ++ai)
#pragma unroll
            for (int m = 0; m < 4; ++m) { bf16_t* rowp = base + (size_t)(row0 + ai * HALF + m * 16) * ldc + col0;
#pragma unroll
                for (int bj = 0; bj < 2; ++bj) *(u32x4*)(rowp + bj * HALF) = pack8(acc[ai][bj][m][0], acc[ai][bj][m][1]); }
    }
};
struct EpiProj {
    static constexpr bool PERM = true, AFTER_DRAIN = false;
    bf16_t* P; float* NAR;
    __device__ __forceinline__ void operator()(const f32x4 (&acc)[2][2][4][2], const Unit& u, int wr_, int wc_, int fr_, int fq_) const {
        const int tid = OPAQUE_TID, wid_ = __builtin_amdgcn_readfirstlane(tid >> 6), wr = wid_ >> 2, wc = wid_ & 3, fr = tid & 15, fq = (tid & 63) >> 4;
        const int row0 = u.pm * BM + wr * 64 + fr;
        if (u.pn < 22) { const int col0 = u.pn * BM + wc * 32 + 8 * fq;
            const float sc = (u.pn < 2) ? 0.125f * LOG2E : 1.0f;
#pragma unroll
            for (int ai = 0; ai < 2; ++ai)
#pragma unroll
                for (int m = 0; m < 4; ++m) { bf16_t* rowp = P + (size_t)(row0 + ai * HALF + m * 16) * PW + col0;
#pragma unroll
                    for (int bj = 0; bj < 2; ++bj) *(u32x4*)(rowp + bj * HALF) = pack8(acc[ai][bj][m][0] * sc, acc[ai][bj][m][1] * sc); }
        } else if (wc == 0 && fq < 3) {
#pragma unroll
            for (int ai = 0; ai < 2; ++ai)
#pragma unroll
                for (int m = 0; m < 4; ++m) { float* np = NAR + (size_t)(row0 + ai * HALF + m * 16) * NWP + 8 * fq; *(f32x4*)np = acc[ai][0][m][0]; *(f32x4*)(np + 4) = acc[ai][0][m][1]; }
        }
    }
};
struct EpiGlu {
    static constexpr bool PERM = true, AFTER_DRAIN = false;
    const bf16_t* Z; const float* bias; bf16_t* O;
    __device__ __forceinline__ void operator()(const f32x4 (&acc)[2][2][4][2], const Unit& u, int wr_, int wc_, int fr_, int fq_) const {
        const int tid = OPAQUE_TID, wid_ = __builtin_amdgcn_readfirstlane(tid >> 6), wr = wid_ >> 2, wc = wid_ & 3, fr = tid & 15, fq = (tid & 63) >> 4;
        const int row0 = u.pm * BM + wr * 64 + fr, col0 = u.pn * BM + wc * 32 + 8 * fq;
#pragma unroll
        for (int bj = 0; bj < 2; ++bj) { const int c = col0 + bj * HALF; const f32x4 b0 = *(const f32x4*)(bias + c), b1 = *(const f32x4*)(bias + c + 4);
#pragma unroll
            for (int ai = 0; ai < 2; ++ai)
#pragma unroll
                for (int m = 0; m < 4; ++m) { const size_t row = (size_t)(row0 + ai * HALF + m * 16); f32x4 z0, z1; unpack8(*(const u32x4*)(Z + row * 512 + c), z0, z1);
                    f32x4 v0 = acc[ai][bj][m][0] + b0, v1 = acc[ai][bj][m][1] + b1;
#pragma unroll
                    for (int j = 0; j < 4; ++j) { v0[j] = z0[j] * sigm(v0[j]); v1[j] = z1[j] * sigm(v1[j]); }
                    *(u32x4*)(O + row * OW + 1536 + c) = pack8(v0, v1); } }
    }
};
struct EpiGate {
    static constexpr bool PERM = true, AFTER_DRAIN = false;
    const float* bias; bf16_t* scr; bf16_t* MG;
    __device__ __forceinline__ void operator()(const f32x4 (&acc)[2][2][4][2], const Unit& u, int wr_, int wc_, int fr_, int fq_) const {
        const int tid = OPAQUE_TID, wid_ = __builtin_amdgcn_readfirstlane(tid >> 6), wr = wid_ >> 2, wc = wid_ & 3, fr = tid & 15, fq = (tid & 63) >> 4;
        bf16_t* ps = scr; bf16_t* ms = scr + 65536;
        if (u.kind == 1) {
#pragma unroll
            for (int bj = 0; bj < 2; ++bj)
#pragma unroll
                for (int q = 0; q < 8; ++q) *(u32x4*)(ps + ((size_t)(q * 2 + bj) * 512 + tid) * 8) = pack8(acc[q >> 2][bj][q & 3][0], acc[q >> 2][bj][q & 3][1]);
            return;
        }
        const int z = u.z, col0 = (u.pn & 7) * BM + wc * 32 + 8 * fq;
        const float* bz = bias + z * DM; GAS char* MGp = (GAS char*)uptr(MG + (size_t)(u.pm * BM) * DM);
        const unsigned voff = (unsigned)((wr * 64 + fr) * DM + col0) * 2u;
#pragma unroll
        for (int bj = 0; bj < 2; ++bj) { const int c = col0 + bj * HALF; const f32x4 b0 = *(const f32x4*)(bz + c), b1 = *(const f32x4*)(bz + c + 4);
#pragma unroll
            for (int qh = 0; qh < 2; ++qh) {
                u32x4 pv[4], sv[4];
#pragma unroll
                for (int qq = 0; qq < 4; ++qq) { const int q = qh * 4 + qq; pv[qq] = *(const u32x4*)(ps + ((size_t)(q * 2 + bj) * 512 + tid) * 8); if (z > 0) sv[qq] = *(const u32x4*)(ms + ((size_t)(q * 2 + bj) * 512 + tid) * 8); }
#pragma unroll
                for (int qq = 0; qq < 4; ++qq) { const int q = qh * 4 + qq, ai = q >> 2, m = q & 3; f32x4 p0, p1; unpack8(pv[qq], p0, p1);
                    f32x4 v0 = acc[ai][bj][m][0] + b0, v1 = acc[ai][bj][m][1] + b1;
#pragma unroll
                    for (int j = 0; j < 4; ++j) { v0[j] = p0[j] * sigm(v0[j]); v1[j] = p1[j] * sigm(v1[j]); }
                    if (z > 0) { f32x4 s0, s1; unpack8(sv[qq], s0, s1); v0 += s0; v1 += s1; }
                    if (z < 3) *(u32x4*)(ms + ((size_t)(q * 2 + bj) * 512 + tid) * 8) = pack8(v0, v1);
                    else *(GAS u32x4*)(MGp + voff + (unsigned)((ai * HALF + m * 16) * DM + bj * HALF) * 2u) = pack8(v0, v1); }
                asm volatile("" ::: "memory");
            }
        }
    }
};
struct EpiSwiglu {
    static constexpr bool PERM = true, AFTER_DRAIN = false;
    bf16_t* Hd;
    __device__ __forceinline__ void operator()(const f32x4 (&acc)[2][2][4][2], const Unit& u, int wr_, int wc_, int fr_, int fq_) const {
        const int tid = OPAQUE_TID, wid_ = __builtin_amdgcn_readfirstlane(tid >> 6), wr = wid_ >> 2, wc = wid_ & 3, fr = tid & 15, fq = (tid & 63) >> 4;
        const int row0 = u.pm * BM + wr * 64 + fr, col0 = u.pn * HALF + wc * 32 + 8 * fq;
#pragma unroll
        for (int ai = 0; ai < 2; ++ai)
#pragma unroll
            for (int m = 0; m < 4; ++m) { f32x4 v0, v1;
#pragma unroll
                for (int j = 0; j < 4; ++j) { const float a0 = acc[ai][0][m][0][j], a1 = acc[ai][0][m][1][j]; v0[j] = a0 * sigm(a0) * acc[ai][1][m][0][j]; v1[j] = a1 * sigm(a1) * acc[ai][1][m][1][j]; }
                *(u32x4*)(Hd + (size_t)(row0 + ai * HALF + m * 16) * FFH + col0) = pack8(v0, v1); }
    }
};
}

struct Args { const float* in[28]; float* out; unsigned char* ws; int ph_lo, ph_hi; };
enum { I_X = 0, I_C, I_ADAW, I_ADAB, I_NORMG, I_WIN, I_RELB, I_DLAM, I_MLCONV, I_MLGB, I_GLAWA2, I_GLABA, I_S5ARE, I_S5AIM, I_S5DT, I_S5BRE, I_S5BIM, I_S5CRE, I_S5CIM, I_S5D, I_GLUW, I_GLUB, I_WBR, I_WGATE, I_BGATE, I_WOUT, I_FFIN, I_FFOUT };

typedef const __attribute__((address_space(4))) unsigned char* kaptr_t;
__device__ __forceinline__ kaptr_t ka_base() { kaptr_t p = (kaptr_t)__builtin_amdgcn_kernarg_segment_ptr(); asm volatile("" : "+s"(p)); return p; }
__device__ __forceinline__ const float* INP(int i) { return *(const float* const __attribute__((address_space(4)))*)(ka_base() + 8 * i); }
__device__ __forceinline__ float* OUTP() { return *(float* const __attribute__((address_space(4)))*)(ka_base() + 224); }
__device__ __forceinline__ unsigned char* WSB() { return *(unsigned char* const __attribute__((address_space(4)))*)(ka_base() + 232); }
static_assert(sizeof(Args) == 248, "Args layout");
template <class RowMap>
__device__ __forceinline__ void conv_item(const float* __restrict__ W, int K, int N, bf16_t* __restrict__ WT, int ldk, int koff, const RowMap& rm, LAS float* scr, int item, int lane) {
    const int nblk = (N + 31) / 32, kb = item / nblk, nb = item % nblk, k0 = 64 * kb, n0 = 32 * nb;
    const int nn = n0 + 4 * (lane & 7); const bool okn = nn < N;
    f32x4 v[8];
#pragma unroll
    for (int i = 0; i < 8; ++i) v[i] = okn ? *(const f32x4*)(W + (size_t)(k0 + (lane >> 3) + 8 * i) * N + nn) : (f32x4){0.f, 0.f, 0.f, 0.f};
#pragma unroll
    for (int i = 0; i < 8; ++i) { LAS float* s = scr + ((lane >> 3) + 8 * i) * 33 + 4 * (lane & 7); s[0] = v[i][0]; s[1] = v[i][1]; s[2] = v[i][2]; s[3] = v[i][3]; }
    asm volatile("s_waitcnt lgkmcnt(0)" ::: "memory");
    const int c = lane & 7;
#pragma unroll
    for (int j = 0; j < 4; ++j) { const int n = (lane >> 3) + 8 * j; const LAS float* s = scr + (8 * c) * 33 + n;
        u32x4 o; o.x = pk2(s[0 * 33], s[1 * 33]); o.y = pk2(s[2 * 33], s[3 * 33]); o.z = pk2(s[4 * 33], s[5 * 33]); o.w = pk2(s[6 * 33], s[7 * 33]);
        if (n0 + n < N) *(u32x4*)(WT + (size_t)rm(n0 + n) * ldk + koff + k0 + 8 * c) = o; }
    asm volatile("s_waitcnt lgkmcnt(0)" ::: "memory");
}
struct RmIdent { int off; __device__ __forceinline__ int operator()(int n) const { return off + n; } };
struct RmWin { __device__ __forceinline__ int operator()(int n) const { return n < 3584 ? n : (n < 3592 ? 5632 + (n - 3584) : (n < 5128 ? n - 8 : (n < 5144 ? 5640 + (n - 5128) : n - 24))); } };
struct RmFfi { __device__ __forceinline__ int operator()(int n) const { const int g = n >= FFH, j = g ? n - FFH : n; return (j >> 7) * 256 + g * 128 + (j & 127); } };

__device__ __forceinline__ void convert_layer(int l, LDSP lds, int wg, int G, bool with_s5) {
    const int tid_ = OPAQUE_TID, lane = tid_ & 63, gw = wg * 8 + __builtin_amdgcn_readfirstlane(tid_ >> 6), NGW = G * 8, gtid = wg * 512 + tid_, NT = G * 512;
    unsigned char* ws = WSB() + ((l & 1) ? (WS_WSET2 - WS_WGLU) : 0);
    LAS float* scr = (LAS float*)(lds + (tid_ >> 6) * 16384);
    bf16_t* Win = (bf16_t*)(ws + WS_WIN); bf16_t* Wg = (bf16_t*)(ws + WS_WG); bf16_t* Wb = (bf16_t*)(ws + WS_WB); bf16_t* Wo = (bf16_t*)(ws + WS_WOUT); bf16_t* Wfi = (bf16_t*)(ws + WS_WFI); bf16_t* Wfo = (bf16_t*)(ws + WS_WFO); bf16_t* Wglu = (bf16_t*)(ws + WS_WGLU);
    constexpr int I_IN = 32 * 177, I_G1 = 32 * 64, I_G = 4 * I_G1, I_B1 = 8 * 64, I_B = 4 * I_B1, I_O = 32 * 64, I_FI = 32 * 352, I_FO = 88 * 64, I_GL = 8 * 16;
    constexpr int NIT = I_IN + I_G + I_B + I_O + I_FI + I_FO + I_GL;
    struct Dec { const float* W; bf16_t* WT; int N, ldk, koff, kind, off, r; };
    auto decode = [&](int it) { Dec d; int r = it;
        if (r < I_IN) { d = Dec{INP(I_WIN) + (size_t)l * DM * 5656, Win, 5656, DM, 0, 1, 0, r}; return d; } r -= I_IN;
        if (r < I_G) { const int z = r / I_G1; d = Dec{INP(I_WGATE) + ((size_t)l * 4 + z) * DM * DM, Wg, DM, DM, 0, 0, z * DM, r % I_G1}; return d; } r -= I_G;
        if (r < I_B) { const int z = r / I_B1; d = Dec{INP(I_WBR) + ((size_t)l * 4 + z) * 512 * DM, Wb, DM, DM, 512 * z, 0, 0, r % I_B1}; return d; } r -= I_B;
        if (r < I_O) { d = Dec{INP(I_WOUT) + (size_t)l * DM * DM, Wo, DM, DM, 0, 0, 0, r}; return d; } r -= I_O;
        if (r < I_FI) { d = Dec{INP(I_FFIN) + (size_t)l * DM * 2 * FFH, Wfi, 2 * FFH, DM, 0, 2, 0, r}; return d; } r -= I_FI;
        if (r < I_FO) { d = Dec{INP(I_FFOUT) + (size_t)l * FFH * DM, Wfo, DM, FFH, 0, 0, 0, r}; return d; } r -= I_FO;
        d = Dec{INP(I_GLUW) + (size_t)l * 512 * 512, Wglu, 512, 512, 0, 0, 0, r}; return d; };
    f32x4 v[8];
#define CONV_LOAD(D) { const int nblk_ = ((D).N + 31) / 32, k0_ = 64 * ((D).r / nblk_), nn_ = 32 * ((D).r % nblk_) + 4 * (lane & 7); const bool okn_ = nn_ < (D).N; \
        _Pragma("unroll") for (int i = 0; i < 8; ++i) v[i] = okn_ ? *(const f32x4*)((D).W + (size_t)(k0_ + (lane >> 3) + 8 * i) * (D).N + nn_) : (f32x4){0.f, 0.f, 0.f, 0.f}; }
    int it = gw; Dec cur{}; if (it < NIT) { cur = decode(it); CONV_LOAD(cur); }
    for (; it < NIT; it += NGW) {
#pragma unroll
        for (int i = 0; i < 8; ++i) { LAS float* s = scr + ((lane >> 3) + 8 * i) * 33 + 4 * (lane & 7); s[0] = v[i][0]; s[1] = v[i][1]; s[2] = v[i][2]; s[3] = v[i][3]; }
        Dec nxt = cur; if (it + NGW < NIT) { nxt = decode(it + NGW); CONV_LOAD(nxt); }
        asm volatile("s_waitcnt lgkmcnt(0)" ::: "memory");
        const int nblk = (cur.N + 31) / 32, k0 = 64 * (cur.r / nblk), n0 = 32 * (cur.r % nblk), c = lane & 7;
#pragma unroll
        for (int j = 0; j < 4; ++j) { const int n = (lane >> 3) + 8 * j; const LAS float* s = scr + (8 * c) * 33 + n;
            u32x4 o; o.x = pk2(s[0 * 33], s[1 * 33]); o.y = pk2(s[2 * 33], s[3 * 33]); o.z = pk2(s[4 * 33], s[5 * 33]); o.w = pk2(s[6 * 33], s[7 * 33]);
            const int ng = n0 + n; const int row = cur.kind == 0 ? cur.off + ng : (cur.kind == 1 ? RmWin{}(ng) : RmFfi{}(ng));
            if (ng < cur.N) *(u32x4*)(cur.WT + (size_t)row * cur.ldk + cur.koff + k0 + 8 * c) = o; }
        asm volatile("s_waitcnt lgkmcnt(0)" ::: "memory");
        cur = nxt;
    }
#undef CONV_LOAD
    for (int i = gtid; i < 232 * 256; i += NT) ((u32x4*)(Win + (size_t)5656 * DM))[i] = (u32x4){0u, 0u, 0u, 0u};
    ws = WSB();
    if (with_s5 && gtid < 2048) s5_prep_item(gtid, INP(I_S5ARE) + l * 2048, INP(I_S5AIM) + l * 2048, INP(I_S5DT) + l * 32, INP(I_S5BRE) + (size_t)l * 32768, INP(I_S5BIM) + (size_t)l * 32768,
                                  INP(I_S5CRE) + (size_t)l * 32768, INP(I_S5CIM) + (size_t)l * 32768, (float*)(ws + WS_S5T), (float*)(ws + WS_S5T + 16384), S5_LC, (bf16_t*)(ws + WS_S5T + 65536), (bf16_t*)(ws + WS_S5T + 65536 + 262144));
}

__device__ __forceinline__ void mod_partials(LDSP lds, int wg, int G) {
    LAS float* cs = (LAS float*)lds;
    const int tid = OPAQUE_TID;
    for (int it = wg; it < KSPLIT * NLAYER * 6; it += G) {
        const int ks = it / (NLAYER * 6), l = (it / 6) % NLAYER, cg = it % 6;
        __syncthreads();
        for (int i = tid; i < BATCH * 256; i += 512) { const int b = i >> 8, k = ks * 256 + (i & 255); const float c = INP(I_C)[b * DM + k]; cs[i] = c * sigmoidf_(c); }
        __syncthreads();
        const float* wp = INP(I_ADAW) + ((size_t)l * DM + ks * 256) * (6 * DM) + cg * DM + 4 * tid;
        f32x4 s[BATCH];
#pragma unroll
        for (int b = 0; b < BATCH; ++b) s[b] = (f32x4){0.f, 0.f, 0.f, 0.f};
#pragma unroll 16
        for (int k = 0; k < 256; ++k) { const f32x4 w = *(const f32x4*)(wp + (size_t)k * (6 * DM));
#pragma unroll
            for (int b = 0; b < BATCH; ++b) s[b] += w * cs[b * 256 + k]; }
        float* mp = (float*)(WSB() + WS_MODP);
#pragma unroll
        for (int b = 0; b < BATCH; ++b) *(f32x4*)(mp + (((size_t)ks * NLAYER + l) * BATCH + b) * (6 * DM) + cg * DM + 4 * tid) = s[b];
    }
}
__device__ __forceinline__ f32x4 mod_vec(int l, int b, int idx, int tid) {
    f32x4 s = *(const f32x4*)(INP(I_ADAB) + (size_t)l * 6 * DM + idx * DM + 4 * tid);
    const float* mp = (const float*)(WSB() + WS_MODP);
#pragma unroll
    for (int ks = 0; ks < KSPLIT; ++ks) s += *(const f32x4*)(mp + (((size_t)ks * NLAYER + l) * BATCH + b) * (6 * DM) + idx * DM + 4 * tid);
    return s;
}
__device__ __forceinline__ void norm_phase(LDSP lds, int wg, int G, const void* xin_, int xin_bf, void* xout_, int xout_bf, const bf16_t* ysrc, int l_res, int i_gate, int i_ga, bf16_t* hout, int l_h, int i_scale, int i_shift, int i_gb) {
    LAS f32x4* VA = (LAS f32x4*)lds; LAS f32x4* VB = (LAS f32x4*)(lds + 8192); LAS f32x4* VC = (LAS f32x4*)(lds + 16384);
    const int tid = OPAQUE_TID, lane = tid & 63, wave = tid >> 6;
    for (int ci = wg; ci < M_TOK / 128; ci += G) {
        const int chunk = (G == 256 && M_TOK / 128 == 256) ? ((ci & 7) * 32 + (ci >> 3)) : ci;
        const int b = (chunk * 128) / SEQ;
        __syncthreads();
        if (ysrc) VA[tid] = mod_vec(l_res, b, i_gate, tid) * *(const f32x4*)(INP(I_NORMG) + ((size_t)l_res * 4 + i_ga) * DM + 4 * tid);
        if (hout) { VB[tid] = (mod_vec(l_h, b, i_scale, tid) + 1.0f) * *(const f32x4*)(INP(I_NORMG) + ((size_t)l_h * 4 + i_gb) * DM + 4 * tid); VC[tid] = mod_vec(l_h, b, i_shift, tid); }
        __syncthreads();
        u32x2 xb[8], yb[8];
#define NP_LOAD(ROW) { const size_t rw_ = (ROW); \
            _Pragma("unroll") for (int j = 0; j < 8; ++j) { if (xin_bf) xb[j] = *((const u32x2*)((const bf16_t*)xin_ + rw_ * DM) + lane + 64 * j); \
                if (ysrc) yb[j] = *((const u32x2*)(ysrc + rw_ * DM) + lane + 64 * j); } }
        NP_LOAD((size_t)chunk * 128 + wave);
        for (int r = wave; r < 128; r += 8) {
            const size_t row = (size_t)chunk * 128 + r;
            f32x4 x[8], y[8];
#pragma unroll
            for (int j = 0; j < 8; ++j) {
                if (xin_bf) { const u32x2 w = xb[j]; x[j][0] = __uint_as_float(w.x << 16); x[j][1] = __uint_as_float(w.x & 0xffff0000u); x[j][2] = __uint_as_float(w.y << 16); x[j][3] = __uint_as_float(w.y & 0xffff0000u); }
                else x[j] = *((const f32x4*)((const float*)xin_ + row * DM) + lane + 64 * j);
                if (ysrc) { const u32x2 w = yb[j]; y[j][0] = __uint_as_float(w.x << 16); y[j][1] = __uint_as_float(w.x & 0xffff0000u); y[j][2] = __uint_as_float(w.y << 16); y[j][3] = __uint_as_float(w.y & 0xffff0000u); } }
            sched_fence();
            if (r + 8 < 128) NP_LOAD(row + 8);
            if (ysrc) {
                float ss = 0.f;
#pragma unroll
                for (int j = 0; j < 8; ++j) ss += (y[j][0] * y[j][0] + y[j][1] * y[j][1]) + (y[j][2] * y[j][2] + y[j][3] * y[j][3]);
                ss = wave_sum_f(ss); const float rn = 1.0f / sqrtf(ss * (1.0f / DM) + RMS_EPS);
#pragma unroll
                for (int j = 0; j < 8; ++j) { x[j] += y[j] * rn * VA[lane + 64 * j];
                    if (xout_bf) { u32x2 w; w.x = pk2(x[j][0], x[j][1]); w.y = pk2(x[j][2], x[j][3]); *((u32x2*)((bf16_t*)xout_ + row * DM) + lane + 64 * j) = w; }
                    else *((f32x4*)((float*)xout_ + row * DM) + lane + 64 * j) = x[j]; }
            }
            if (hout) {
                float ss = 0.f;
#pragma unroll
                for (int j = 0; j < 8; ++j) ss += (x[j][0] * x[j][0] + x[j][1] * x[j][1]) + (x[j][2] * x[j][2] + x[j][3] * x[j][3]);
                ss = wave_sum_f(ss); const float rn = 1.0f / sqrtf(ss * (1.0f / DM) + RMS_EPS);
#pragma unroll
                for (int j = 0; j < 8; ++j) { const f32x4 hv = x[j] * rn * VB[lane + 64 * j] + VC[lane + 64 * j]; u32x2 w; w.x = pk2(hv[0], hv[1]); w.y = pk2(hv[2], hv[3]);
                    *((u32x2*)(hout + row * DM) + lane + 64 * j) = w; }
            }
        }
    }
}

#undef NP_LOAD
#ifndef REP_G1
#define REP_G1 1
#endif
#ifndef REP_A
#define REP_A 1
#endif
#ifndef REP_B
#define REP_B 1
#endif
#ifndef REP_MIX
#define REP_MIX 1
#endif
#ifndef REP_G2
#define REP_G2 1
#endif
#ifndef REP_G3
#define REP_G3 1
#endif
#ifndef REP_G4
#define REP_G4 1
#endif
#ifndef REP_G5
#define REP_G5 1
#endif
#ifndef REP_G6
#define REP_G6 1
#endif
#ifndef REP_G7
#define REP_G7 1
#endif
#ifndef DBL_ATT
#define DBL_ATT 1
#endif
#ifndef DBL_S5
#define DBL_S5 1
#endif
#ifndef DBL_P1
#define DBL_P1 1
#endif
#ifndef DBL_P3
#define DBL_P3 1
#endif
#ifndef S5_STATIC
#define S5_STATIC 0
#endif
#ifndef PROBE_ITEMS
#define PROBE_ITEMS 15
#endif
#ifndef MX_ML
#define MX_ML 1
#endif
#ifndef MX_GLA
#define MX_GLA 1
#endif
#ifndef MX_S5
#define MX_S5 1
#endif
#ifndef MX_ATT
#define MX_ATT 1
#endif
#ifndef PH_G1
#define PH_G1 1
#endif
#ifndef PH_MIX
#define PH_MIX 1
#endif
#ifndef PH_G2
#define PH_G2 1
#endif
#ifndef PH_G3
#define PH_G3 1
#endif
#ifndef PH_G4
#define PH_G4 1
#endif
#ifndef PH_G5
#define PH_G5 1
#endif
#ifndef PH_N2
#define PH_N2 1
#endif
#ifndef PH_G6
#define PH_G6 1
#endif
#ifndef PH_G7
#define PH_G7 1
#endif
#ifndef PH_N3
#define PH_N3 1
#endif
__global__ void __launch_bounds__(512, 2) fwd_kernel(Args a) {
    extern __shared__ __attribute__((aligned(16))) unsigned char lds_raw[];
    LDSP lds = (LDSP)lds_raw;
    const int G = gridDim.x, wg = blockIdx.x;
#define ws WSB()
#define ctl ((unsigned*)(WSB() + WS_CTL))
    volatile LAS unsigned* MISC = (volatile LAS unsigned*)(lds + LDS_MISC);
    if (threadIdx.x < 64) MISC[threadIdx.x] = 0u;
    __syncthreads();
    XcdBarrier bar = xcd_barrier_post(ctl + CW_BAR, MISC);
    const int lo = a.ph_lo, hi = a.ph_hi;
    int ph = 0;
#define IN(k) (lo <= (k) && (k) < hi)
#ifndef NBARPASS
#define NBARPASS 1
#endif
#define GRID_SYNC() do { _Pragma("unroll") for (int bp_ = 0; bp_ < NBARPASS; ++bp_) xcd_barrier(bar); } while (0)
#define SEAM(k) do { if (IN(k) && IN((k) + 1)) GRID_SYNC(); } while (0)
#define Hb ((bf16_t*)(ws + WS_H))
#define PROJ ((bf16_t*)(ws + WS_PROJ))
#define NAR ((float*)(ws + WS_NAR))
#define OALL ((bf16_t*)(ws + WS_OALL))
#define Zb ((bf16_t*)(ws + WS_Z))
#define Pb ((bf16_t*)(ws + WS_P))
#define MG ((bf16_t*)(ws + WS_MERGED))
#define MIXB ((bf16_t*)(ws + WS_MIXB))
#define Yb ((bf16_t*)(ws + WS_Y))
#define HID ((bf16_t*)(ws + WS_HID))
#define XB ((bf16_t*)(ws + WS_XB))

    if (IN(ph)) { mod_partials(lds, wg, G); __syncthreads(); convert_layer(0, lds, wg, G, true);
#ifdef PROBE_NAN_FILL
        { u32x4* p_ = (u32x4*)(ws + WS_NAR); const size_t n_ = (WS_END - WS_NAR) / 16; for (size_t i_ = (size_t)wg * 512 + threadIdx.x; i_ < n_; i_ += (size_t)G * 512) p_[i_] = (u32x4){0x7FC07FC0u, 0x7FC07FC0u, 0x7FC07FC0u, 0x7FC07FC0u}; }
#endif
    }
    SEAM(ph); ++ph;
    if (IN(ph)) norm_phase(lds, wg, G, INP(I_X), 0, nullptr, 0, nullptr, 0, 0, 0, Hb, 0, 1, 0, 0);
    SEAM(ph); ++ph;

    for (int l = 0; l < NLAYER; ++l) {
#define wsw (ws + ((l & 1) ? (WS_WSET2 - WS_WGLU) : 0))
        if (IN(ph) && PH_G1) for (int rep = 0; rep < REP_G1; ++rep) { pg8::Gemm g{Hb, (const bf16_t*)(wsw + WS_WIN), DM, DM, DM, nullptr, nullptr}; pg8::SchedPlain S{NMT, NPROJ / 256, G, wg, DM / 64}; pg8::EpiProj E{PROJ, NAR};
            pg8::gemm_phase<pg8::EpiProj, pg8::SchedPlain, true, true>((PG8_LAS unsigned char*)lds, g, S, E);
            { constexpr int NU = NMT * (NPROJ / 256); const int busy = NU % G; if (l + 1 < NLAYER && busy != 0 && wg >= busy) { __syncthreads(); convert_layer(l + 1, lds, wg - busy, G - busy, false); } } }
        SEAM(ph); ++ph;
        if (IN(ph) && PH_MIX) for (int rep = 0; rep < REP_MIX; ++rep) {
            const int tid = OPAQUE_TID, lane = tid & 63, wave = __builtin_amdgcn_readfirstlane(tid >> 6);
            LAS float* biasT = (LAS float*)(lds + LDS_BIAS);
            if (tid < 512) { const int h = tid >> 7, d = tid & 127; biasT[tid] = INP(I_RELB)[T5_BUCKET[d] * 4 + h] * LOG2E; }
            const float* dl = INP(I_DLAM) + l * 256;
            const float s1 = wave_sum_f(dl[lane] * dl[64 + lane]), s2 = wave_sum_f(dl[128 + lane] * dl[192 + lane]);
            const float lam_init = 0.8f - 0.6f * __expf(-0.3f * (float)l), lam = __expf(s1) - __expf(s2) + lam_init;
            __syncthreads();
            float* MLST = (float*)(ws + WS_P); float* MLST2 = (float*)(ws + WS_P + 68 * MiB); float* GLST = (float*)(ws + WS_P + 136 * MiB); float* GLST2 = (float*)(ws + WS_P + 170 * MiB);
            static_assert((size_t)BATCH * 4 * NCH * ML_SO_BYTES <= 68 * MiB && (size_t)BATCH * 4 * NCH * GLA_P1_BYTES <= 34 * MiB, "state records");
            constexpr int NIT = BATCH * 4 * NCH;
            float* S5ST = (float*)(ws + WS_P + 204 * MiB);
            constexpr int NS5P1 = BATCH * 4 * (S5_NC - 1), NS5P3 = BATCH * 4 * S5_NC;
            for (int ra_ = 0; ra_ < REP_A; ++ra_) {
                unsigned* qa = ctl + CW_Q + 64 * (l + 4 * rep) + 32 + 8 * ra_;
                unsigned qn = 0; if (tid == 0) qn = __hip_atomic_fetch_add(qa, 1u, __ATOMIC_RELAXED, __HIP_MEMORY_SCOPE_AGENT);
                for (;;) {
                    if (tid == 0) { MISC[16] = qn; qn = __hip_atomic_fetch_add(qa, 1u, __ATOMIC_RELAXED, __HIP_MEMORY_SCOPE_AGENT); }
                    __syncthreads();
                    const int item = (int)MISC[16];
                    if (item >= NS5P1 + 2 * NIT) break;
                    if (item < NS5P1) { const int j = item, c = j % (S5_NC - 1), gb = (j / (S5_NC - 1)) & 3, b = j / (4 * (S5_NC - 1));
                        s5_chunk<1>(lds + wave * S5_WAVE_LDS, PROJ, (const float*)(ws + WS_S5T), (const float*)(ws + WS_S5T + 16384), (const bf16_t*)(ws + WS_S5T + 65536), (const bf16_t*)(ws + WS_S5T + 65536 + 262144),
                                    INP(I_S5D) + l * 512, S5ST, Zb, b, gb * 8 + wave, c); }
                    else { const int it = item - NS5P1;
                        if (it < NIT) mlstm_chunk<1>(lds, PROJ, NAR, INP(I_MLCONV) + l * 4096, INP(I_MLGB) + l * 8, MLST, OALL, (it / NCH) >> 2, (it / NCH) & 3, it % NCH);
                        else { const int j = it - NIT; gla_chunk<1>(lds, PROJ, NAR, INP(I_GLAWA2) + l * 4096, INP(I_GLABA) + l * 256, GLST, OALL, (j / NCH) >> 2, (j / NCH) & 3, j % NCH); } }
                    __syncthreads();
                }
            }
            GRID_SYNC();
            for (int rb_ = 0; rb_ < REP_B; ++rb_) {
            { constexpr int NQ_ML = BATCH * 4 * 4096, NQ = NQ_ML + BATCH * 4 * 2048; const int per = ((NQ + G - 1) / G + 63) & ~63;
              for (int t_ = tid; t_ < per; t_ += 512) { const int q = wg * per + t_;
                if (q < NQ_ML) mlstm_scan_e((float*)((char*)MLST + (size_t)(q >> 12) * NCH * ML_SO_BYTES), (float*)((char*)MLST2 + (size_t)(q >> 12) * NCH * ML_SO_BYTES), (q & 4095) * 4);
                else if (q < NQ) { const int v = q - NQ_ML; gla_scan_e((float*)((char*)GLST + (size_t)(v >> 11) * NCH * GLA_P1_BYTES), (float*)((char*)GLST2 + (size_t)(v >> 11) * NCH * GLA_SO_BYTES), (v & 2047) * 4); } } }
            }
            GRID_SYNC();
            constexpr unsigned NATT = BATCH * 4 * (SEQ / 128);
            if ((S5_STATIC == 1 || S5_STATIC == 2) && wg >= 32 && wg < 32 + BATCH * 4) { const int pair = (wg - 32) * 8 + wave; s5_wave(lds + wave * S5_WAVE_LDS, PROJ, (const float*)(ws + WS_S5T), (const bf16_t*)(ws + WS_S5T + 65536), (const bf16_t*)(ws + WS_S5T + 65536 + 262144),
                                                                                      INP(I_S5D) + l * 512, Zb, pair >> 5, pair & 31); __syncthreads(); }
            if (S5_STATIC == 3) { for (int j = wg; j < (int)NS5P3; j += G) { const int c = j % S5_NC, gb = (j / S5_NC) & 3, b = j / (4 * S5_NC);
                    s5_chunk<3>(lds + wave * S5_WAVE_LDS, PROJ, (const float*)(ws + WS_S5T), (const float*)(ws + WS_S5T + 16384), (const bf16_t*)(ws + WS_S5T + 65536), (const bf16_t*)(ws + WS_S5T + 65536 + 262144),
                                INP(I_S5D) + l * 512, S5ST, Zb, b, gb * 8 + wave, c); __syncthreads(); } }
            unsigned qnext = 0; if (tid == 0) qnext = __hip_atomic_fetch_add(ctl + CW_Q + 64 * (l + 4 * rep), 1u, __ATOMIC_RELAXED, __HIP_MEMORY_SCOPE_AGENT);
            for (;;) {
                if (tid == 0) { MISC[16] = qnext; qnext = __hip_atomic_fetch_add(ctl + CW_Q + 64 * (l + 4 * rep), 1u, __ATOMIC_RELAXED, __HIP_MEMORY_SCOPE_AGENT); }
                __syncthreads();
                const unsigned item = MISC[16] + (S5_STATIC ? NS5P3 : 0);
                if (item >= NS5P3 + NATT + 2 * NIT) break;
                if (item < NS5P3) { if (!S5_STATIC) { const int j = (int)item, c = j % S5_NC, gb = (j / S5_NC) & 3, b = j / (4 * S5_NC);
                    s5_chunk<3>(lds + wave * S5_WAVE_LDS, PROJ, (const float*)(ws + WS_S5T), (const float*)(ws + WS_S5T + 16384), (const bf16_t*)(ws + WS_S5T + 65536), (const bf16_t*)(ws + WS_S5T + 65536 + 262144),
                                INP(I_S5D) + l * 512, S5ST, Zb, b, gb * 8 + wave, c); } }
                else if (item < NS5P3 + NATT) { const int a_ = (int)(item - NS5P3), qb = (SEQ / 128 - 1) - a_ / (BATCH * 4), bh = a_ % (BATCH * 4); for (int dd_ = 0; dd_ < DBL_ATT; ++dd_) attn_unit(lds, biasT, PROJ, OALL, lam, lam_init, bh >> 2, bh & 3, qb); }
                else { const int j = (int)(item - NS5P3 - NATT);
                    for (int dd_ = 0; dd_ < DBL_P3; ++dd_) if (j < NIT) mlstm_chunk<3>(lds, PROJ, NAR, INP(I_MLCONV) + l * 4096, INP(I_MLGB) + l * 8, MLST2, OALL, (j / NCH) >> 2, (j / NCH) & 3, j % NCH);
                    else { const int k = j - NIT; gla_chunk<3>(lds, PROJ, NAR, INP(I_GLAWA2) + l * 4096, INP(I_GLABA) + l * 256, GLST2, OALL, (k / NCH) >> 2, (k / NCH) & 3, k % NCH); } }
                __syncthreads();
            }
        }
        SEAM(ph); ++ph;
        if (IN(ph) && PH_G2) for (int rep = 0; rep < REP_G2; ++rep) { pg8::Gemm g{Zb, (const bf16_t*)(wsw + WS_WGLU), 512, 512, 512, nullptr, nullptr}; pg8::SchedPlain S{NMT, 2, G, wg, 512 / 64}; pg8::EpiGlu E{Zb, INP(I_GLUB) + l * 512, OALL};
            pg8::gemm_phase<pg8::EpiGlu, pg8::SchedPlain, true, true>((PG8_LAS unsigned char*)lds, g, S, E); }
        SEAM(ph); ++ph;
        if (IN(ph) && PH_G4) for (int rep = 0; rep < REP_G4; ++rep) { pg8::Gemm g{Hb, (const bf16_t*)(wsw + WS_WG), DM, DM, DM, OALL, (const bf16_t*)(wsw + WS_WB)}; pg8::SchedGate S{NMT, G, wg};
            pg8::EpiGate E{INP(I_BGATE) + (size_t)l * 4 * DM, (bf16_t*)(ws + WS_GSCR) + (size_t)wg * 131072, MG};
            pg8::gemm_phase<pg8::EpiGate, pg8::SchedGate, true, true>((PG8_LAS unsigned char*)lds, g, S, E); }
        SEAM(ph); ++ph;
        if (IN(ph) && PH_G5) for (int rep = 0; rep < REP_G5; ++rep) {
#ifdef PROBE_DELAY_G5
            if (wg >= 32 && wg < 48) { const unsigned long long t0_ = __builtin_amdgcn_s_memrealtime(); while (__builtin_amdgcn_s_memrealtime() - t0_ < 40000ull) __builtin_amdgcn_s_sleep(8); }
#endif
 pg8::Gemm g{MG, (const bf16_t*)(wsw + WS_WOUT), DM, DM, DM, nullptr, nullptr}; pg8::SchedPlain S{NMT, 8, G, wg, DM / 64}; pg8::EpiPlain E{MIXB, DM, 0xffff, 0};
            pg8::gemm_phase<pg8::EpiPlain, pg8::SchedPlain, true, true>((PG8_LAS unsigned char*)lds, g, S, E); }
        SEAM(ph); ++ph;
        if (IN(ph) && PH_N2) {
#ifdef PROBE_DUP_N2
            norm_phase(lds, wg, G, l == 0 ? (const void*)INP(I_X) : (const void*)XB, l != 0, (float*)(ws + WS_P), 0, MIXB, l, 2, 1, (bf16_t*)(ws + WS_P + 256 * MiB), l, 4, 3, 2); __syncthreads();
#endif
            norm_phase(lds, wg, G, l == 0 ? (const void*)INP(I_X) : (const void*)XB, l != 0, XB, 1, MIXB, l, 2, 1, Hb, l, 4, 3, 2); }
        SEAM(ph); ++ph;
        if (IN(ph) && PH_G6) for (int rep = 0; rep < REP_G6; ++rep) { pg8::Gemm g{Hb, (const bf16_t*)(wsw + WS_WFI), DM, DM, DM, nullptr, nullptr}; pg8::SchedPlain S{NMT, 2 * FFH / 256, G, wg, DM / 64}; pg8::EpiSwiglu E{HID};
            pg8::gemm_phase<pg8::EpiSwiglu, pg8::SchedPlain, true, true>((PG8_LAS unsigned char*)lds, g, S, E); }
        SEAM(ph); ++ph;
        if (IN(ph) && PH_G7) for (int rep = 0; rep < REP_G7; ++rep) { pg8::Gemm g{HID, (const bf16_t*)(wsw + WS_WFO), FFH, FFH, FFH, nullptr, nullptr}; pg8::SchedPlain S{NMT, 8, G, wg, FFH / 64}; pg8::EpiPlain E{Yb, DM, 0xffff, 0};
            pg8::gemm_phase<pg8::EpiPlain, pg8::SchedPlain, true, true>((PG8_LAS unsigned char*)lds, g, S, E); }
        SEAM(ph); ++ph;
        if (IN(ph) && PH_N3) { norm_phase(lds, wg, G, XB, 1, (l + 1 < NLAYER) ? (void*)XB : (void*)OUTP(), (l + 1 < NLAYER), Yb, l, 5, 3, (l + 1 < NLAYER) ? Hb : nullptr, l + 1, 1, 0, 0);
            if (l + 1 < NLAYER) { constexpr int NU = NMT * (NPROJ / 256);
                if (NU % G == 0) { __syncthreads(); convert_layer(l + 1, lds, wg, G, true); }
                else { const int gtid_ = wg * 512 + OPAQUE_TID; unsigned char* ws_ = WSB();
                    if (gtid_ < 2048) s5_prep_item(gtid_, INP(I_S5ARE) + (l + 1) * 2048, INP(I_S5AIM) + (l + 1) * 2048, INP(I_S5DT) + (l + 1) * 32, INP(I_S5BRE) + (size_t)(l + 1) * 32768, INP(I_S5BIM) + (size_t)(l + 1) * 32768,
                                                   INP(I_S5CRE) + (size_t)(l + 1) * 32768, INP(I_S5CIM) + (size_t)(l + 1) * 32768, (float*)(ws_ + WS_S5T), (float*)(ws_ + WS_S5T + 16384), S5_LC, (bf16_t*)(ws_ + WS_S5T + 65536), (bf16_t*)(ws_ + WS_S5T + 65536 + 262144)); } } }
        SEAM(ph); ++ph;
    }
#undef wsw
#undef IN
#undef SEAM
#undef GRID_SYNC
#undef ws
#undef ctl
#undef Hb
#undef PROJ
#undef NAR
#undef OALL
#undef Zb
#undef Pb
#undef MG
#undef MIXB
#undef Yb
#undef HID
#undef XB
}

#ifndef ONE_LAUNCH
#define ONE_LAUNCH 1
#endif
extern "C" void kernel_launch(void* const* d_in, const int* in_sizes, int n_in, void* d_out, int out_size, void* d_ws, size_t ws_size, hipStream_t stream) {
    static int grid = 0;
    if (grid == 0) {
        if (n_in != 28 || in_sizes[0] != M_TOK * DM || out_size != M_TOK * DM || ws_size < WS_END) { fprintf(stderr, "kernel_launch: unexpected shapes/workspace (n_in %d, ws %zu < %zu)\n", n_in, ws_size, (size_t)WS_END); grid = -1; return; }
        int dev = 0, cus = 0, per_cu = 0;
        if (hipGetDevice(&dev) != hipSuccess || hipDeviceGetAttribute(&cus, hipDeviceAttributeMultiprocessorCount, dev) != hipSuccess) { grid = -1; return; }
        if (hipFuncSetAttribute((const void*)fwd_kernel, hipFuncAttributeMaxDynamicSharedMemorySize, LDS_BYTES) != hipSuccess) { fprintf(stderr, "kernel_launch: hipFuncSetAttribute failed\n"); grid = -1; return; }
        if (hipOccupancyMaxActiveBlocksPerMultiprocessor(&per_cu, (const void*)fwd_kernel, 512, LDS_BYTES) != hipSuccess || per_cu < 1) fprintf(stderr, "kernel_launch: occupancy query says %d\n", per_cu);
        (void)hipGetLastError();
        grid = cus;
        if (grid > 256) grid = 256;
    }
    if (grid < 0) return;
    if (hipMemsetAsync((char*)d_ws + WS_CTL, 0, CTL_ZERO_BYTES, stream) != hipSuccess) return;
    Args a{};
    for (int i = 0; i < 28; ++i) a.in[i] = (const float*)d_in[i];
    a.out = (float*)d_out; a.ws = (unsigned char*)d_ws;
#if ONE_LAUNCH
    a.ph_lo = 0; a.ph_hi = N_PHASES;
    hipLaunchKernelGGL(fwd_kernel, dim3(grid), dim3(512), LDS_BYTES, stream, a);
#ifdef PROBE_TWICE
    (void)hipMemsetAsync((char*)d_ws + WS_CTL, 0, CTL_ZERO_BYTES, stream);
    hipLaunchKernelGGL(fwd_kernel, dim3(grid), dim3(512), LDS_BYTES, stream, a);
#endif
#else
    for (int p = 0; p < N_PHASES; ++p) { a.ph_lo = p; a.ph_hi = p + 1; hipLaunchKernelGGL(fwd_kernel, dim3(grid), dim3(512), LDS_BYTES, stream, a); }
#endif
}
```
